# Optimizing an MI355X kernel written in HIP

```python
import jax, jax.numpy as jnp
from jax import lax
import numpy as np

D_MODEL = 1024
BATCH = 4
SEQ = 8192
DEPTH = 2

GRID_W = 64
HEAD_DIM = 64
ROPE_THETA = 10000.0
PLE_DIM = 256
NORM_EPS = 1e-6
NEG_INF = -1e30
Q_BLOCK = 128

A_HEADS = 4
A_Q_RANK = 256
A_KV_RANK = 128
A_NOPE = 64
A_ROPE = 32
A_V = 64
B_HEADS = 4
B_KV_HEADS = 2
C_PATTERNS = ((128, 1), (512, 4), (2048, 16))
C_HEADS_PER_GROUP = 4
C_BLOCK = 64
D_HEADS = 4
D_KV_HEADS = 2
D_HALF_WINDOW = 128
D_BLOCK = 128

N_BRANCHES = 4
BRANCH_WIDTH = 256

A_COLS = A_Q_RANK + A_KV_RANK + A_ROPE
B_COLS = (B_HEADS + 2 * B_KV_HEADS) * HEAD_DIM
C_COLS = len(C_PATTERNS) * 3 * C_HEADS_PER_GROUP * HEAD_DIM
D_COLS = (D_HEADS + 2 * D_KV_HEADS) * HEAD_DIM
GATE_COLS = N_BRANCHES * D_MODEL
IN_COLS = A_COLS + B_COLS + C_COLS + D_COLS + GATE_COLS
SPLIT_POINTS = (A_COLS, A_COLS + B_COLS, A_COLS + B_COLS + C_COLS, A_COLS + B_COLS + C_COLS + D_COLS)

D_FF = 4096
N_EXPERTS = 8
TOP_K = 2
MOE_FF = 3584
MOE_BLOCK = 128
N_DENSE = (DEPTH + 1) // 2
N_MOE = DEPTH // 2

kernel_name = "hybrid_gated_parallel_mixers_encoder"


def rms_norm(x, g):
    xf = x.astype(jnp.float32)
    y = xf * lax.rsqrt(jnp.mean(xf * xf, axis=-1, keepdims=True) + NORM_EPS)
    return (y * g.astype(jnp.float32)).astype(x.dtype)


def rope_tables(pos, dim):
    half = dim // 2
    inv = jnp.power(ROPE_THETA, -jnp.arange(half, dtype=jnp.float32) / half)
    ang = pos.astype(jnp.float32)[:, None] * inv[None, :]
    return jnp.cos(ang), jnp.sin(ang)


def apply_rope(x, cos, sin):
    half = x.shape[-1] // 2
    x1 = x[..., :half].astype(jnp.float32)
    x2 = x[..., half:].astype(jnp.float32)
    c = cos[:, None, :]
    s = sin[:, None, :]
    return jnp.concatenate([x1 * c - x2 * s, x2 * c + x1 * s], axis=-1).astype(x.dtype)


def axial_rope(x, row_tab, col_tab):
    half = x.shape[-1] // 2
    return jnp.concatenate([apply_rope(x[..., :half], *row_tab), apply_rope(x[..., half:], *col_tab)], axis=-1)


def dense_attention(q, k, v):
    bsz, seq, n_heads, dq = q.shape
    n_kv = k.shape[2]
    rep = n_heads // n_kv
    dv = v.shape[-1]
    nb = seq // Q_BLOCK
    qb = q.reshape(bsz, nb, Q_BLOCK, n_kv, rep, dq).transpose(1, 0, 2, 3, 4, 5)
    scale = dq ** -0.5

    def block(qblk):
        s = jnp.einsum('bqgrd,bkgd->bgrqk', qblk, k).astype(jnp.float32) * scale
        p = jax.nn.softmax(s, axis=-1).astype(v.dtype)
        return jnp.einsum('bgrqk,bkgd->bqgrd', p, v)

    o = lax.map(block, qb)
    return o.transpose(1, 0, 2, 3, 4, 5).reshape(bsz, seq, n_heads, dv)


def banded_attention(q, k, v, half_w, blk, sink):
    bsz, length, n_heads, dim = q.shape
    n_kv = k.shape[2]
    rep = n_heads // n_kv
    nb = -(-length // blk)
    lp = nb * blk
    qp = jnp.pad(q, ((0, 0), (0, lp - length), (0, 0), (0, 0)))
    kv_pad = ((0, 0), (half_w, lp - length + half_w), (0, 0), (0, 0))
    kp = jnp.pad(k, kv_pad)
    vp = jnp.pad(v, kv_pad)
    kw = blk + 2 * half_w
    idx = jnp.arange(nb)[:, None] * blk + jnp.arange(kw)[None, :]
    kb = kp[:, idx]
    vb = vp[:, idx]
    qb = qp.reshape(bsz, nb, blk, n_kv, rep, dim)
    s = jnp.einsum('bnqgrd,bnkgd->bngrqk', qb, kb).astype(jnp.float32) * (dim ** -0.5)
    qpos = jnp.arange(nb)[:, None] * blk + jnp.arange(blk)[None, :]
    kpos = idx - half_w
    valid = ((jnp.abs(qpos[:, :, None] - kpos[:, None, :]) <= half_w)
             & (kpos[:, None, :] >= 0) & (kpos[:, None, :] < length))
    s = jnp.where(valid[None, :, None, None], s, NEG_INF)
    m = jnp.max(s, axis=-1)
    if sink is not None:
        sink_logit = sink.astype(jnp.float32).reshape(n_kv, rep)[None, None, :, :, None]
        m = jnp.maximum(m, sink_logit)
    e = jnp.exp(s - m[..., None])
    l = jnp.sum(e, axis=-1)
    if sink is not None:
        l = l + jnp.exp(sink_logit - m)
    o = jnp.einsum('bngrqk,bnkgd->bnqgrd', e.astype(v.dtype), vb).astype(jnp.float32)
    o = o / jnp.transpose(l, (0, 1, 4, 2, 3))[..., None]
    o = o.reshape(bsz, lp, n_heads, dim)[:, :length].astype(q.dtype)
    lse = jnp.transpose(m + jnp.log(l), (0, 1, 4, 2, 3)).reshape(bsz, lp, n_heads)[:, :length]
    return o, lse


def dilated_attention(q, k, v, window, dilation):
    bsz, seq, n_heads, dim = q.shape
    ls = seq // dilation

    def to_classes(x):
        return x.reshape(bsz, ls, dilation, n_heads, dim).transpose(0, 2, 1, 3, 4).reshape(bsz * dilation, ls, n_heads, dim)

    o, lse = banded_attention(to_classes(q), to_classes(k), to_classes(v), window // (2 * dilation), C_BLOCK, None)
    o = o.reshape(bsz, dilation, ls, n_heads, dim).transpose(0, 2, 1, 3, 4).reshape(bsz, seq, n_heads, dim)
    lse = lse.reshape(bsz, dilation, ls, n_heads).transpose(0, 2, 1, 3).reshape(bsz, seq, n_heads)
    return o, lse


def token_mixers(h, tabs, w_in, a_qa_g, a_kva_g, a_w_uq, a_w_ukv, b_q_g, b_k_g, d_sink, w_branch, w_out):
    bsz, seq, _ = h.shape
    rope_a, rope_row, rope_col, rope_full = tabs
    z = h @ w_in
    z_a, z_b, z_c, z_d, z_gate = jnp.split(z, list(SPLIT_POINTS), axis=-1)

    c_q, c_kv, k_r = jnp.split(z_a, [A_Q_RANK, A_Q_RANK + A_KV_RANK], axis=-1)
    q_a = (rms_norm(c_q, a_qa_g) @ a_w_uq).reshape(bsz, seq, A_HEADS, A_NOPE + A_ROPE)
    q_a = jnp.concatenate([q_a[..., :A_NOPE], apply_rope(q_a[..., A_NOPE:], *rope_a)], axis=-1)
    kv_a = (rms_norm(c_kv, a_kva_g) @ a_w_ukv).reshape(bsz, seq, A_HEADS, A_NOPE + A_V)
    k_rope = apply_rope(k_r[:, :, None, :], *rope_a)
    k_a = jnp.concatenate([kv_a[..., :A_NOPE], jnp.broadcast_to(k_rope, (bsz, seq, A_HEADS, A_ROPE))], axis=-1)
    o_a = dense_attention(q_a, k_a, kv_a[..., A_NOPE:])

    q_b, k_b, v_b = jnp.split(z_b, [B_HEADS * HEAD_DIM, (B_HEADS + B_KV_HEADS) * HEAD_DIM], axis=-1)
    q_b = axial_rope(rms_norm(q_b.reshape(bsz, seq, B_HEADS, HEAD_DIM), b_q_g), rope_row, rope_col)
    k_b = axial_rope(rms_norm(k_b.reshape(bsz, seq, B_KV_HEADS, HEAD_DIM), b_k_g), rope_row, rope_col)
    o_b = dense_attention(q_b, k_b, v_b.reshape(bsz, seq, B_KV_HEADS, HEAD_DIM))

    zc = z_c.reshape(bsz, seq, len(C_PATTERNS), 3, C_HEADS_PER_GROUP, HEAD_DIM)
    outs, lses = [], []
    for gi, (win, dil) in enumerate(C_PATTERNS):
        og, lg = dilated_attention(apply_rope(zc[:, :, gi, 0], *rope_full), apply_rope(zc[:, :, gi, 1], *rope_full),
                                   zc[:, :, gi, 2], win, dil)
        outs.append(og)
        lses.append(lg)
    alpha = jax.nn.softmax(jnp.stack(lses, axis=0), axis=0)
    o_c = jnp.einsum('gbsh,gbshd->bshd', alpha, jnp.stack(outs, axis=0).astype(jnp.float32)).astype(h.dtype)

    q_d, k_d, v_d = jnp.split(z_d, [D_HEADS * HEAD_DIM, (D_HEADS + D_KV_HEADS) * HEAD_DIM], axis=-1)
    q_d = apply_rope(q_d.reshape(bsz, seq, D_HEADS, HEAD_DIM), *rope_full)
    k_d = apply_rope(k_d.reshape(bsz, seq, D_KV_HEADS, HEAD_DIM), *rope_full)
    o_d, _ = banded_attention(q_d, k_d, v_d.reshape(bsz, seq, D_KV_HEADS, HEAD_DIM), D_HALF_WINDOW, D_BLOCK, d_sink)

    gates = jax.nn.sigmoid(z_gate.astype(jnp.float32)).astype(h.dtype).reshape(bsz, seq, N_BRANCHES, D_MODEL)
    merged = jnp.zeros((bsz, seq, D_MODEL), h.dtype)
    for n, o in enumerate((o_a, o_b, o_c, o_d)):
        merged = merged + gates[:, :, n] * (o.reshape(bsz, seq, BRANCH_WIDTH) @ w_branch[n])
    return merged @ w_out


def swiglu(h, wg, wu, wd):
    return (jax.nn.silu(h @ wg) * (h @ wu)) @ wd


def moe_swiglu(h, w_router, b_router, wg, wu, wd):
    bsz, seq, dm = h.shape
    n_tok = bsz * seq
    xf = h.reshape(n_tok, dm)
    logits = (xf @ w_router).astype(jnp.float32) + b_router.astype(jnp.float32)
    top_v, top_e = lax.top_k(logits, TOP_K)
    gate = jax.nn.softmax(top_v, axis=-1)
    n_asg = n_tok * TOP_K
    e_flat = top_e.reshape(n_asg)
    tok_flat = jnp.repeat(jnp.arange(n_tok, dtype=jnp.int32), TOP_K)
    g_flat = gate.reshape(n_asg)
    order = jnp.argsort(e_flat)
    e_s, tok_s, g_s = e_flat[order], tok_flat[order], g_flat[order]
    counts = jnp.bincount(e_flat, length=N_EXPERTS)
    start = jnp.cumsum(counts) - counts
    padded = ((counts + MOE_BLOCK - 1) // MOE_BLOCK) * MOE_BLOCK
    pend = jnp.cumsum(padded)
    pstart = pend - padded
    dest = pstart[e_s] + (jnp.arange(n_asg) - start[e_s])
    nb = -(-n_asg // MOE_BLOCK) + N_EXPERTS
    n_rows = nb * MOE_BLOCK
    buf_tok = jnp.zeros((n_rows,), jnp.int32).at[dest].set(tok_s)
    buf_g = jnp.zeros((n_rows,), jnp.float32).at[dest].set(g_s)
    blk_e = jnp.clip(jnp.searchsorted(pend, jnp.arange(nb) * MOE_BLOCK, side='right'), 0, N_EXPERTS - 1)
    xb = xf[buf_tok].reshape(nb, MOE_BLOCK, dm)

    def expert_block(args):
        xblk, e = args
        return swiglu(xblk, wg[e], wu[e], wd[e])

    yb = lax.map(expert_block, (xb, blk_e)).reshape(n_rows, dm)
    out = jnp.zeros((n_tok, dm), h.dtype).at[buf_tok].add(yb * buf_g[:, None].astype(h.dtype))
    return out.reshape(bsz, seq, dm)


def setup_inputs(seed: int = 0) -> dict:
    key = jax.random.key(seed)
    ks = iter(jax.random.split(key, 32))
    f32 = jnp.float32

    def w(shape, fan_in):
        return jax.random.normal(next(ks), shape, f32) * (fan_in ** -0.5)

    def gain(shape):
        return 1.0 + 0.05 * jax.random.normal(next(ks), shape, f32)

    return {
        "x": jax.random.normal(next(ks), (BATCH, SEQ, D_MODEL), f32),
        "p": jax.random.normal(next(ks), (DEPTH, BATCH, SEQ, PLE_DIM), f32),
        "w_in": w((DEPTH, D_MODEL, IN_COLS), D_MODEL),
        "a_qa_g": gain((DEPTH, A_Q_RANK)),
        "a_kva_g": gain((DEPTH, A_KV_RANK)),
        "a_w_uq": w((DEPTH, A_Q_RANK, A_HEADS * (A_NOPE + A_ROPE)), A_Q_RANK),
        "a_w_ukv": w((DEPTH, A_KV_RANK, A_HEADS * (A_NOPE + A_V)), A_KV_RANK),
        "b_q_g": gain((DEPTH, HEAD_DIM)),
        "b_k_g": gain((DEPTH, HEAD_DIM)),
        "d_sink": 0.5 * jax.random.normal(next(ks), (DEPTH, D_HEADS), f32),
        "w_branch": w((DEPTH, N_BRANCHES, BRANCH_WIDTH, D_MODEL), BRANCH_WIDTH),
        "w_out": w((DEPTH, D_MODEL, D_MODEL), D_MODEL),
        "mix_pre_g": gain((DEPTH, D_MODEL)),
        "mix_post_g": gain((DEPTH, D_MODEL)),
        "ffn_pre_g": gain((DEPTH, D_MODEL)),
        "ffn_post_g": gain((DEPTH, D_MODEL)),
        "ffn_w_gate": w((N_DENSE, D_MODEL, D_FF), D_MODEL),
        "ffn_w_up": w((N_DENSE, D_MODEL, D_FF), D_MODEL),
        "ffn_w_down": w((N_DENSE, D_FF, D_MODEL), D_FF),
        "router_w": w((N_MOE, D_MODEL, N_EXPERTS), D_MODEL),
        "router_b": 0.01 * jax.random.normal(next(ks), (N_MOE, N_EXPERTS), f32),
        "moe_w_gate": w((N_MOE, N_EXPERTS, D_MODEL, MOE_FF), D_MODEL),
        "moe_w_up": w((N_MOE, N_EXPERTS, D_MODEL, MOE_FF), D_MODEL),
        "moe_w_down": w((N_MOE, N_EXPERTS, MOE_FF, D_MODEL), MOE_FF),
        "ple_w_proj": w((DEPTH, PLE_DIM, D_MODEL), PLE_DIM),
        "ple_w_gate": w((DEPTH, D_MODEL, D_MODEL), D_MODEL),
        "ple_post_g": gain((DEPTH, D_MODEL)),
    }


def reference(x, p, w_in, a_qa_g, a_kva_g, a_w_uq, a_w_ukv, b_q_g, b_k_g, d_sink, w_branch, w_out,
              mix_pre_g, mix_post_g, ffn_pre_g, ffn_post_g, ffn_w_gate, ffn_w_up, ffn_w_down,
              router_w, router_b, moe_w_gate, moe_w_up, moe_w_down, ple_w_proj, ple_w_gate, ple_post_g):
    seq = x.shape[1]
    rows = seq // GRID_W
    pos = jnp.arange(seq, dtype=jnp.int32)
    row_idx = jnp.repeat(jnp.arange(rows, dtype=jnp.int32), GRID_W)
    col_idx = jnp.tile(jnp.arange(GRID_W, dtype=jnp.int32), rows)
    tabs = (rope_tables(pos, A_ROPE), rope_tables(row_idx, HEAD_DIM // 2),
            rope_tables(col_idx, HEAD_DIM // 2), rope_tables(pos, HEAD_DIM))

    for i in range(DEPTH):
        h = rms_norm(x, mix_pre_g[i])
        mix = token_mixers(h, tabs, w_in[i], a_qa_g[i], a_kva_g[i], a_w_uq[i], a_w_ukv[i],
                           b_q_g[i], b_k_g[i], d_sink[i], w_branch[i], w_out[i])
        x = x + rms_norm(mix, mix_post_g[i])

        h = rms_norm(x, ffn_pre_g[i])
        j = i // 2
        if i % 2 == 0:
            f = swiglu(h, ffn_w_gate[j], ffn_w_up[j], ffn_w_down[j])
        else:
            f = moe_swiglu(h, router_w[j], router_b[j], moe_w_gate[j], moe_w_up[j], moe_w_down[j])
        x = x + rms_norm(f, ffn_post_g[i])

        gate = jax.nn.sigmoid((x @ ple_w_gate[i]).astype(jnp.float32)).astype(x.dtype)
        e = (p[i] @ ple_w_proj[i]) * gate
        x = x + rms_norm(e, ple_post_g[i])
    return x
```

```cpp
#include <hip/hip_runtime.h>
#include <cstdio>
#include <cstdint>
#include <type_traits>

#define LAS __attribute__((address_space(3)))
#define GAS __attribute__((address_space(1)))
typedef unsigned short bf16_t;
typedef short bf16x8 __attribute__((ext_vector_type(8)));
typedef short s16x4 __attribute__((ext_vector_type(4)));
typedef float f32x4 __attribute__((ext_vector_type(4)));
typedef float f32x16 __attribute__((ext_vector_type(16)));
typedef unsigned u32x4 __attribute__((ext_vector_type(4)));
typedef unsigned u32x2 __attribute__((ext_vector_type(2)));

#ifndef PHMASK
#define PHMASK 0xFFFFFFFFu
#endif
#define PHEN(i) (((PHMASK) >> (i)) & 1u)
#ifndef DUPMASK
#define DUPMASK 0u
#endif
#define DUPREP(i) for (int rep_ = 0; rep_ < 1 + (int)(((DUPMASK) >> (i)) & 1u); ++rep_)
#ifndef MK_PER_PHASE
#define MK_PER_PHASE 0
#endif

constexpr int DM = 1024, BATCH = 4, SEQ = 8192, DEPTH = 2, M = BATCH * SEQ;
constexpr int ZP = 3840;
constexpr int ZC_B = 416, ZC_C = 928, ZC_D = 3232, ZN = 3744, IN_COLS = 7840;
constexpr int DFF = 4096, MFF = 3584, NE = 8;
constexpr float NORM_EPS = 1e-6f;
constexpr float LOG2E = 1.4426950408889634f;
constexpr int MOE_MAXT = 264;
constexpr int MOE_C0 = MOE_MAXT, MOE_CH = MOE_MAXT, MOE_NCH = 1;

constexpr size_t MiB = 1u << 20;
constexpr size_t WS_CTL = 0, CTL_ZERO_BYTES = 2 * MiB;
constexpr size_t WS_ROWTOK = 1 * MiB;
constexpr size_t WS_COS16 = 2 * MiB, WS_SIN16 = WS_COS16 + 512 * 1024, WS_COS32 = 3 * MiB, WS_SIN32 = 4 * MiB;
constexpr size_t WS_TI_E = 5 * MiB, WS_TI_P0 = WS_TI_E + 128 * 1024, WS_TI_P1 = WS_TI_P0 + 128 * 1024, WS_TI_G0 = WS_TI_P1 + 128 * 1024, WS_TI_G1 = WS_TI_G0 + 128 * 1024;
constexpr size_t WS_TOKROW = 6 * MiB, WS_ROWG = WS_TOKROW + 256 * 1024, WS_WGBASE = 7 * MiB;
constexpr size_t WS_WIN = 8 * MiB, WIN_L = (size_t)ZP * DM * 2;
constexpr size_t WS_WG = 23 * MiB, WG_L = 8 * MiB;
constexpr size_t WS_WB = 39 * MiB, WB_L = 2 * MiB;
constexpr size_t WS_WOUT = 43 * MiB, WOUT_L = 2 * MiB;
constexpr size_t WS_WPG = 47 * MiB, WPG_L = 2 * MiB;
constexpr size_t WS_WP = 51 * MiB, WP_L = 512 * 1024;
constexpr size_t WS_WUQ = 52 * MiB, WUQ_L = 256 * 1024;
constexpr size_t WS_WUKV = WS_WUQ + 512 * 1024, WUKV_L = 256 * 1024;
constexpr size_t WS_FGU = 53 * MiB, WS_FD = 69 * MiB;
constexpr size_t WS_PBF = 77 * MiB;
constexpr size_t A0 = 93 * MiB;
constexpr size_t WS_H = A0, WS_Z = 157 * MiB, WS_QA = 397 * MiB, WS_KA = 421 * MiB, WS_VA = 445 * MiB, WS_OCAT = 461 * MiB, WS_OCG = 525 * MiB, OCG_G = 16 * MiB, WS_LG = 573 * MiB, LG_G = 512 * 1024;
constexpr size_t WS_H8 = 600 * MiB;
constexpr int FP8_GATE_LAYER = 1;
constexpr bool FP8_PLE = true;
constexpr size_t WS_XB8_DENSE = 397 * MiB, WS_XB8_MOE = 157 * MiB;
constexpr bool FP8_DENSE_DOWN = true;
constexpr bool FP8_GATE0 = true;
__host__ __device__ constexpr bool gate_fp8(int l) { return l == FP8_GATE_LAYER || (l == 0 && FP8_GATE0); }
constexpr int FP8_IN_LAYER = 1;
constexpr size_t WS_PB = 157 * MiB, WS_MERGED = 525 * MiB, WS_MIX = A0, WS_H2 = 461 * MiB;
constexpr size_t WS_HID = 157 * MiB, WS_FB = 525 * MiB, WS_XB = A0, WS_PP = 461 * MiB;
constexpr size_t WS_MGU = 157 * MiB, MGU_E = 7 * MiB, WS_MD = 269 * MiB, MD_E = 7 * MiB / 2, WS_Y = 325 * MiB, WS_XG = A0, WS_HIDC = A0;
constexpr size_t OUT_HALF = (size_t)M * DM * 2;
constexpr size_t MOEW_MD = OUT_HALF, MOEW_GU = OUT_HALF + 8 * MD_E, WS_MGU_HI = WS_FGU;
constexpr int MOE_ESPLIT = 5;
static_assert(MOEW_GU + MOE_ESPLIT * MGU_E <= 2 * OUT_HALF && WS_MGU_HI + (NE - MOE_ESPLIT) * MGU_E <= WS_PBF, "expert weight copies");
constexpr size_t WS_XSLOT = 644 * MiB, XSLOT_B = 2 * MiB;
constexpr size_t WS_END = 648 * MiB;
static_assert(WS_HIDC + (size_t)MOE_CH * 256 * MFF <= WS_Y, "hidden (fp8)");
static_assert(WS_Y + (size_t)MOE_MAXT * 256 * DM * 2 <= WS_H2, "y");
constexpr int CW_CNT = 64;
constexpr int CW_BAR = 4096;
constexpr int CW_PANEL = 16384;

__device__ __forceinline__ unsigned cvt_pk_bf16(float lo, float hi) { unsigned r; asm volatile("v_cvt_pk_bf16_f32 %0, %1, %2" : "=v"(r) : "v"(lo), "v"(hi)); return r; }
__device__ __forceinline__ float bf_lo(unsigned u) { return __uint_as_float(u << 16); }
__device__ __forceinline__ float bf_hi(unsigned u) { return __uint_as_float(u & 0xffff0000u); }
__device__ __forceinline__ u32x4 pack8(const float (&v)[8]) { u32x4 w; w.x = cvt_pk_bf16(v[0], v[1]); w.y = cvt_pk_bf16(v[2], v[3]); w.z = cvt_pk_bf16(v[4], v[5]); w.w = cvt_pk_bf16(v[6], v[7]); return w; }
__device__ __forceinline__ void unpack8(const u32x4 w, float (&v)[8]) { v[0] = bf_lo(w.x); v[1] = bf_hi(w.x); v[2] = bf_lo(w.y); v[3] = bf_hi(w.y); v[4] = bf_lo(w.z); v[5] = bf_hi(w.z); v[6] = bf_lo(w.w); v[7] = bf_hi(w.w); }
__device__ __forceinline__ float sigmoidf_(float x) { return __builtin_amdgcn_rcpf(1.0f + __builtin_amdgcn_exp2f(-x * LOG2E)); }
__device__ __forceinline__ float wave_sum(float v) {
#pragma unroll
    for (int o = 1; o < 64; o <<= 1) v += __shfl_xor(v, o);
    return v;
}
__device__ __forceinline__ unsigned cvt4_fp8(float a, float b, float c, float d) { int w = 0; w = __builtin_amdgcn_cvt_pk_fp8_f32(a, b, w, false); w = __builtin_amdgcn_cvt_pk_fp8_f32(c, d, w, true); return (unsigned)w; }
#define LDS_WAIT() asm volatile("s_waitcnt lgkmcnt(0)" ::: "memory")
#define VM_WAIT() asm volatile("s_waitcnt vmcnt(0)" ::: "memory")

#define XB_TMO      128
#define XB_XCNT(j)  (256  + 64 * (j))
#define XB_XSUB(j)  (1280 + 64 * (j))
#define XB_XGEN(j)  (2304 + 64 * (j))
#define XB_TOP      3328
#define XB_TOPGEN   3392
#define XCD_BAR_WORDS 3456
#define XB_SPIN_CAP (1u << 18)
__device__ __forceinline__ unsigned xb_ld(unsigned* p)              { return __hip_atomic_load(p, __ATOMIC_RELAXED, __HIP_MEMORY_SCOPE_AGENT); }
__device__ __forceinline__ unsigned xb_add(unsigned* p, unsigned v) { return __hip_atomic_fetch_add(p, v, __ATOMIC_RELAXED, __HIP_MEMORY_SCOPE_AGENT); }
__device__ __forceinline__ unsigned xb_xcc_id() { return (unsigned)__builtin_amdgcn_s_getreg((3 << 11) | 20) & 0xFu; }
#define XB_SPIN(cond, bar) do { unsigned _sp = 0; while (cond) { __builtin_amdgcn_s_sleep(1); \
    if ((++_sp & 255u) == 0u) { if (xb_ld(&(bar)[XB_TMO])) break; if (_sp > XB_SPIN_CAP) { atomicAdd(&(bar)[XB_TMO], 1u); break; } } } } while (0)
struct XcdBarrier { unsigned* bar; unsigned x; volatile LAS unsigned* st; };
__device__ __forceinline__ XcdBarrier xcd_barrier_post(unsigned* bar, volatile LAS unsigned* st) {
    XcdBarrier b; b.bar = bar; b.x = xb_xcc_id(); b.st = st;
    if (threadIdx.x == 0) (void)xb_add(&bar[XB_XCNT(b.x)], 1u);
    return b;
}
__device__ __forceinline__ void xcd_barrier_complete(unsigned* bar, unsigned x, unsigned& nloc, unsigned& nx) {
    const unsigned G = gridDim.x * gridDim.y * gridDim.z;
    unsigned sum, cnt, mine, sp = 0u;
    for (;;) {
        sum = 0u; cnt = 0u; mine = 0u;
#pragma unroll
        for (unsigned j = 0; j < 16; ++j) { const unsigned c = xb_ld(&bar[XB_XCNT(j)]); sum += c; cnt += (c > 0u) ? 1u : 0u; mine = (j == x) ? c : mine; }
        if (sum == G) break;
        __builtin_amdgcn_s_sleep(1);
        if ((++sp & 255u) == 0u) { if (xb_ld(&bar[XB_TMO])) break; if (sp > XB_SPIN_CAP) { atomicAdd(&bar[XB_TMO], 1u); break; } }
    }
    nloc = mine > 0u ? mine : 1u; nx = cnt > 0u ? cnt : 1u;
}
__device__ __forceinline__ void xcd_barrier(const XcdBarrier& b) {
    asm volatile("s_waitcnt vmcnt(0)" ::: "memory");
    __syncthreads();
    if (threadIdx.x == 0) {
        unsigned* bar = b.bar;
        __builtin_amdgcn_s_waitcnt(0);
        unsigned nloc = b.st[0], nx = b.st[1];
        if (nloc == 0u) { xcd_barrier_complete(bar, b.x, nloc, nx); b.st[0] = nloc; b.st[1] = nx; }
        const unsigned old = xb_add(&bar[XB_XSUB(b.x)], 1u);
        const unsigned gen = old / nloc;
        if (old + 1u == (gen + 1u) * nloc) {
            __builtin_amdgcn_fence(__ATOMIC_RELEASE, "agent");
            asm volatile("s_waitcnt vmcnt(0)" ::: "memory");
            const unsigned og = xb_add(&bar[XB_TOP], 1u);
            const unsigned tg = og / nx;
            if (og + 1u == (tg + 1u) * nx) xb_add(&bar[XB_TOPGEN], 1u);
            else XB_SPIN(xb_ld(&bar[XB_TOPGEN]) == tg, bar);
            __builtin_amdgcn_fence(__ATOMIC_ACQUIRE, "agent");
            xb_add(&bar[XB_XGEN(b.x)], 1u);
            asm volatile("s_waitcnt vmcnt(0)" ::: "memory");
        } else {
            XB_SPIN(xb_ld(&bar[XB_XGEN(b.x)]) == gen, bar);
            __builtin_amdgcn_fence(__ATOMIC_ACQUIRE, "agent");
            asm volatile("s_waitcnt vmcnt(0)" ::: "memory");
        }
    }
    __syncthreads();
}

namespace pg8 {
constexpr int BM = 256, BK = 64, HALF = 128, HTB = HALF * BK * 2, STAGE_BYTES = 8 * HTB, NXCD = 8, WGM = 8;
__host__ __device__ __forceinline__ int lds_byte(int r, int c) { const int st = (r >> 4) * 2 + (c >> 5), rr = r & 15, cc = c & 31, ob = rr * 64 + cc * 2; return st * 1024 + (ob ^ (((ob >> 9) & 1) << 5)); }
__host__ __device__ __forceinline__ void stage_rc(int b, int& R, int& C) { const int st = b / 1024, sb = b % 1024, swz = sb ^ (((sb >> 9) & 1) << 5); R = (st >> 1) * 16 + swz / 64; C = (st & 1) * 32 + (swz % 64) / 2; }
__host__ __device__ __forceinline__ int perm32(int rho) { const int n = rho >> 4, i = rho & 15; return 8 * (i >> 2) + 4 * n + (i & 3); }

struct Unit { int pm, pn, aux; long aoff, boff; };
struct Gemm { const bf16_t* A; const bf16_t* Bt; int lda, ldb, K; const int* rowtok = nullptr; };

__device__ __forceinline__ bool grid_map(long L, int nM, int nN, int& pm, int& pn) {
    const int nwg = nM * nN; if (L >= nwg) return false;
    int wgid = (int)L; { const int q = nwg / NXCD, r = nwg % NXCD, xcd = wgid % NXCD, off = wgid / NXCD; wgid = (xcd < r ? xcd * (q + 1) : r * (q + 1) + (xcd - r) * q) + off; }
    const int nig = WGM * nN, gid = wgid / nig, fm = gid * WGM, gsz = (nM - fm) < WGM ? (nM - fm) : WGM;
    pm = fm + ((wgid % nig) % gsz); pn = (wgid % nig) / gsz; return true;
}
struct GridOrder {
    int nM, nN, G, c, lda, ldb, esz; int rev = 0;
    __device__ __forceinline__ bool next(int i, Unit& u) const {
        if (!grid_map((long)i * G + c, nM, nN, u.pm, u.pn)) return false;
        if (rev) u.pm = nM - 1 - u.pm;
        u.aux = 0; u.aoff = (long)u.pm * BM * lda * esz; u.boff = (long)u.pn * BM * ldb * esz; return true; }
};
struct BranchOrder {
    int G, c;
    __device__ __forceinline__ bool next(int i, Unit& u) const {
        if (!grid_map((long)i * G + c, M / BM, 16, u.pm, u.pn)) return false;
        u.aux = 0; u.aoff = (long)u.pm * BM * DM * 2 + (long)(u.pn >> 2) * 512; u.boff = (long)u.pn * BM * 256 * 2; return true; }
};
struct GateOrder {
    int G, c;
    __device__ __forceinline__ bool next(int i, Unit& u) const {
        int pc; if (!grid_map((long)(i >> 2) * G + c, M / BM, 4, u.pm, pc)) return false;
        u.pn = (i & 3) * 4 + pc; u.aux = 0; u.aoff = (long)u.pm * BM * DM * 2; u.boff = (long)u.pn * BM * DM * 2; return true; }
};
struct PanelOrder {
    int G, vcu, lda, ldb, esz;
    __device__ __forceinline__ bool next(int i, Unit& u) const {
        const int per = G >> 2, pm = i * per + (vcu >> 2); if ((vcu >> 2) >= per || pm >= M / BM) return false;
        u.pm = pm; u.pn = vcu & 3; u.aux = 0; u.aoff = (long)pm * BM * lda * esz; u.boff = (long)u.pn * BM * ldb * esz; return true; }
};
struct MoeOrder {
    int nT, tile0, nN, G, c, lda, ldb, esz; long estride; int tend[NE]; int esplit = NE; long edelta = 0; int rev = 0;
    __device__ __forceinline__ bool next(int i, Unit& u) const {
        if (!grid_map((long)i * G + c, nT, nN, u.pm, u.pn)) return false;
        if (rev) u.pm = nT - 1 - u.pm;
        const int tile = tile0 + u.pm; int e = 0;
#pragma unroll
        for (int j = 0; j < NE - 1; ++j) e += (tile >= tend[j]) ? 1 : 0;
        u.aux = tile; u.aoff = (long)u.pm * BM * lda * esz; u.boff = (long)e * estride + (e >= esplit ? edelta : 0L) + (long)u.pn * BM * ldb * esz; return true; }
};

template <class T, class = void> struct has_probe : std::false_type {};
template <class T> struct has_probe<T, std::void_t<decltype(T::PROBE)>> : std::true_type {};
template <class T, class = void> struct has_prep : std::false_type {};
template <class T> struct has_prep<T, std::void_t<decltype(T::PREP)>> : std::true_type {};
template <class T, class = void> struct has_gate2 : std::false_type {};
template <class T> struct has_gate2<T, std::void_t<decltype(T::GATE2)>> : std::true_type {};
template <class T, class = void> struct has_normx : std::false_type {};
template <class T> struct has_normx<T, std::void_t<decltype(T::NORMX)>> : std::true_type {};
__device__ __forceinline__ void panel_exchange(const f32x4 (&acc)[2][2][4][2], float* slots, unsigned* cnt, int pm, int pn, int wr, int wc, int fr, int fq, float (&rs)[2][4]) {
#pragma unroll
    for (int ai = 0; ai < 2; ++ai)
#pragma unroll
        for (int m = 0; m < 4; ++m) { float q = 0.f;
#pragma unroll
            for (int bj = 0; bj < 2; ++bj)
#pragma unroll
                for (int n = 0; n < 2; ++n) { const f32x4 a = acc[ai][bj][m][n]; q += (a[0] * a[0] + a[1] * a[1]) + (a[2] * a[2] + a[3] * a[3]); }
            auto s1 = __builtin_amdgcn_permlane16_swap(__float_as_uint(q), __float_as_uint(q), false, false); q = __uint_as_float(s1[0]) + __uint_as_float(s1[1]);
            auto s2 = __builtin_amdgcn_permlane32_swap(__float_as_uint(q), __float_as_uint(q), false, false); q = __uint_as_float(s2[0]) + __uint_as_float(s2[1]);
            if (fq == 0) __hip_atomic_store(slots + (size_t)(pm * 256 + ai * HALF + wr * 64 + m * 16 + fr) * 16 + pn * 4 + wc, q, __ATOMIC_RELAXED, __HIP_MEMORY_SCOPE_AGENT); }
    asm volatile("s_waitcnt vmcnt(0)\n\ts_barrier" ::: "memory");
    unsigned* c = cnt + pm * 16;
    if (wr == 0 && wc == 0) {
        if (fr + 16 * fq == 0) __hip_atomic_fetch_add(c, 1u, __ATOMIC_RELAXED, __HIP_MEMORY_SCOPE_AGENT);
        for (unsigned sp = 0; sp < (1u << 20); ++sp) {
            if ((unsigned)__builtin_amdgcn_readfirstlane(__hip_atomic_load(c, __ATOMIC_RELAXED, __HIP_MEMORY_SCOPE_AGENT)) >= 4u) break;
            __builtin_amdgcn_s_sleep(1); } }
    asm volatile("s_waitcnt vmcnt(0)\n\ts_barrier" ::: "memory");
#pragma unroll
    for (int ai = 0; ai < 2; ++ai) { u32x4 w[4][4];
#pragma unroll
        for (int m = 0; m < 4; ++m) { const float* sl = slots + (size_t)(pm * 256 + ai * HALF + wr * 64 + m * 16 + fr) * 16;
#pragma unroll
            for (int k = 0; k < 4; ++k) asm volatile("global_load_dwordx4 %0, %1, off offset:%c2 sc1" : "=&v"(w[m][k]) : "v"(sl), "i"(k * 16) : "memory"); }
        asm volatile("s_waitcnt vmcnt(0)" : "+v"(w[0][0]), "+v"(w[0][1]), "+v"(w[0][2]), "+v"(w[0][3]), "+v"(w[1][0]), "+v"(w[1][1]), "+v"(w[1][2]), "+v"(w[1][3]),
                                            "+v"(w[2][0]), "+v"(w[2][1]), "+v"(w[2][2]), "+v"(w[2][3]), "+v"(w[3][0]), "+v"(w[3][1]), "+v"(w[3][2]), "+v"(w[3][3]) :: "memory");
#pragma unroll
        for (int m = 0; m < 4; ++m) { float tot = 0.f;
#pragma unroll
            for (int k = 0; k < 4; ++k) { tot += __uint_as_float(w[m][k].x); tot += __uint_as_float(w[m][k].y); tot += __uint_as_float(w[m][k].z); tot += __uint_as_float(w[m][k].w); }
            rs[ai][m] = rsqrtf(tot * (1.0f / 1024.0f) + NORM_EPS); } }
}
template <class T, class = void> struct has_staged8 : std::false_type {};
template <class T> struct has_staged8<T, std::void_t<decltype(T::STAGED8)>> : std::true_type {};
template <class T, class = void> struct has_staged4 : std::false_type {};
template <class T> struct has_staged4<T, std::void_t<decltype(T::STAGED4)>> : std::true_type {};
template <class T, class = void> struct has_staged : std::false_type {};
template <class T> struct has_staged<T, std::void_t<decltype(T::STAGED)>> : std::true_type {};
constexpr int EPI_STG_OFF = 131072 + 1024, EPI_STG_WAVE = 2048;
struct EpiLd { f32x4 a, b; };
template <class F> struct Epi8 {
    static constexpr bool PERM = true;
    F f;
    template <bool STORE = true>
    __device__ __forceinline__ void run(f32x4 (&acc)[2][2][4][2], const Unit& u, int wr, int wc, int fr0, int fq0, LAS unsigned char* stg) const {
        int fr = fr0, fq = fq0; asm volatile("" : "+v"(fr), "+v"(fq));
        if constexpr (has_normx<F>::value) {
#define EPI_ROW(ai_, m_) ((ai_) * HALF + wr * 64 + (m_) * 16 + fr)
#define EPI_COL(bj_) ((bj_) * HALF + wc * 32 + 8 * fq)
#define EPI_GETV(ai_, bj_, m_) const f32x4 a_ = acc[ai_][bj_][m_][0], b_ = acc[ai_][bj_][m_][1]; float v[8] = {a_[0], a_[1], a_[2], a_[3], b_[0], b_[1], b_[2], b_[3]}
#define EPI_PUTV(ai_, bj_, m_) acc[ai_][bj_][m_][0] = (f32x4){v[0], v[1], v[2], v[3]}; acc[ai_][bj_][m_][1] = (f32x4){v[4], v[5], v[6], v[7]}
#pragma unroll
            for (int am = 0; am < 4; ++am) { const int ai = am >> 1, m0 = (am & 1) * 2; EpiLd w[2][2];
#pragma unroll
                for (int mm = 0; mm < 2; ++mm)
#pragma unroll
                    for (int bj = 0; bj < 2; ++bj) w[mm][bj] = f.tload(u, EPI_ROW(ai, m0 + mm), EPI_COL(bj));
#pragma unroll
                for (int mm = 0; mm < 2; ++mm)
#pragma unroll
                    for (int bj = 0; bj < 2; ++bj) { const int m = m0 + mm; EPI_GETV(ai, bj, m); f.tval(u, EPI_ROW(ai, m), EPI_COL(bj), v, w[mm][bj]); EPI_PUTV(ai, bj, m); } }
            float rs[2][4];
            panel_exchange(acc, f.slotp(0), f.cntp(0), u.pm, u.pn, wr, wc, fr, fq, rs);
            asm volatile("" : "+v"(fr), "+v"(fq));
            if constexpr (F::NORMX == 2) {
                f32x4 g[2][2];
#pragma unroll
                for (int bj = 0; bj < 2; ++bj) f.gains(u, EPI_COL(bj), 1, g[bj][0], g[bj][1]);
#pragma unroll
                for (int am = 0; am < 4; ++am) { const int ai = am >> 1, m0 = (am & 1) * 2; EpiLd w[2][2];
#pragma unroll
                    for (int mm = 0; mm < 2; ++mm)
#pragma unroll
                        for (int bj = 0; bj < 2; ++bj) w[mm][bj] = f.mload(u, EPI_ROW(ai, m0 + mm), EPI_COL(bj));
#pragma unroll
                    for (int mm = 0; mm < 2; ++mm)
#pragma unroll
                        for (int bj = 0; bj < 2; ++bj) { const int m = m0 + mm; EPI_GETV(ai, bj, m); f.mid(u, EPI_ROW(ai, m), EPI_COL(bj), v, rs[ai][m], w[mm][bj], g[bj][0], g[bj][1]); EPI_PUTV(ai, bj, m); } }
                panel_exchange(acc, f.slotp(1), f.cntp(1), u.pm, u.pn, wr, wc, fr, fq, rs);
                asm volatile("" : "+v"(fr), "+v"(fq));
            }
            { f32x4 g[2][2];
#pragma unroll
              for (int bj = 0; bj < 2; ++bj) f.gains(u, EPI_COL(bj), 2, g[bj][0], g[bj][1]);
#pragma unroll
              for (int am = 0; am < 4; ++am) { const int ai = am >> 1, m0 = (am & 1) * 2; EpiLd w[2][2];
#pragma unroll
                  for (int mm = 0; mm < 2; ++mm)
#pragma unroll
                      for (int bj = 0; bj < 2; ++bj) w[mm][bj] = f.fload(u, EPI_ROW(ai, m0 + mm), EPI_COL(bj));
#pragma unroll
                  for (int mm = 0; mm < 2; ++mm)
#pragma unroll
                      for (int bj = 0; bj < 2; ++bj) { const int m = m0 + mm; EPI_GETV(ai, bj, m); f.finish(u, EPI_ROW(ai, m), EPI_COL(bj), v, rs[ai][m], w[mm][bj], g[bj][0], g[bj][1]); } } }
#undef EPI_ROW
#undef EPI_COL
#undef EPI_GETV
#undef EPI_PUTV
            return;
        }
        if constexpr (has_gate2<F>::value) {
#pragma unroll
            for (int ai = 0; ai < 2; ++ai) { u32x4 pw[4][2];
#pragma unroll
                for (int m = 0; m < 4; ++m) f.loadp(u, ai, m, wr, wc, fr, fq, pw[m][0], pw[m][1]);
#pragma unroll
                for (int m = 0; m < 4; ++m) { const f32x4 a0 = acc[ai][0][m][0], b0 = acc[ai][0][m][1], a1 = acc[ai][1][m][0], b1 = acc[ai][1][m][1];
                    float v0[8] = {a0[0], a0[1], a0[2], a0[3], b0[0], b0[1], b0[2], b0[3]}, v1[8] = {a1[0], a1[1], a1[2], a1[3], b1[0], b1[1], b1[2], b1[3]};
                    f.pair(u, ai, m, wr, wc, fr, fq, v0, v1, pw[m][0], pw[m][1]); } }
            return;
        }
        if constexpr (has_staged8<F>::value) {
            const int lane = fr + 16 * fq;
#pragma unroll
            for (int ai = 0; ai < 2; ++ai)
#pragma unroll
                for (int bj = 0; bj < 2; ++bj)
#pragma unroll
                    for (int mp = 0; mp < 2; ++mp) { const int row0 = ai * HALF + wr * 64 + mp * 32, cb = bj * HALF + wc * 32;
#pragma unroll
                        for (int mm = 0; mm < 2; ++mm) { const f32x4 a = acc[ai][bj][2 * mp + mm][0], b = acc[ai][bj][2 * mp + mm][1];
                            float v[8] = {a[0], a[1], a[2], a[3], b[0], b[1], b[2], b[3]};
                            *(LAS u32x2*)(stg + ((mm * 16 + fr) * 4 + fq) * 8) = f.pack8b(u, row0 + mm * 16 + fr, cb + 8 * fq, v); }
                        { const int lrow = lane >> 1, hf = lane & 1; const u32x4 w = *(const LAS u32x4*)(stg + lrow * 32 + hf * 16);
                          *(u32x4*)f.dst(u, row0 + lrow, cb + 16 * hf) = w; } }
            return;
        }
        if constexpr (has_staged4<F>::value) {
            const int lane = fr + 16 * fq;
#pragma unroll
            for (int ai = 0; ai < 2; ++ai)
#pragma unroll
                for (int bj = 0; bj < 2; ++bj) { const int row0 = ai * HALF + wr * 64, cb = bj * HALF + wc * 32;
#pragma unroll
                    for (int m = 0; m < 4; ++m) { const f32x4 a = acc[ai][bj][m][0], b = acc[ai][bj][m][1];
                        float v[8] = {a[0], a[1], a[2], a[3], b[0], b[1], b[2], b[3]};
                        *(LAS unsigned*)(stg + ((m * 16 + fr) * 4 + fq) * 4) = f.pack4b(u, row0 + m * 16 + fr, cb + 8 * fq, v); }
                    { const u32x4 w = *(const LAS u32x4*)(stg + lane * 16);
                      *(u32x4*)f.dst(u, row0 + lane, cb) = w; } }
            return;
        }
        if constexpr (has_staged<F>::value && has_prep<F>::value) {
            const int lane = fr + 16 * fq;
            EpiLd cur[2], nxt[2];
#pragma unroll
            for (int mm = 0; mm < 2; ++mm) cur[mm] = f.prep(u, wr * 64 + mm * 16 + fr, wc * 32 + 8 * fq);
#pragma unroll
            for (int k = 0; k < 8; ++k) { const int ai = k >> 2, bj = (k >> 1) & 1, mp = k & 1, row0 = ai * HALF + wr * 64 + mp * 32, cb = bj * HALF + wc * 32;
#pragma unroll
                for (int mm = 0; mm < 2; ++mm) { const f32x4 a = acc[ai][bj][2 * mp + mm][0], b = acc[ai][bj][2 * mp + mm][1];
                    float v[8] = {a[0], a[1], a[2], a[3], b[0], b[1], b[2], b[3]};
                    *(LAS u32x4*)(stg + ((mm * 16 + fr) * 4 + fq) * 16) = f.pack(u, row0 + mm * 16 + fr, cb + 8 * fq, v, cur[mm]); }
                if (k + 1 < 8) { const int k1 = k + 1, ai1 = k1 >> 2, bj1 = (k1 >> 1) & 1, mp1 = k1 & 1;
#pragma unroll
                    for (int mm = 0; mm < 2; ++mm) nxt[mm] = f.prep(u, ai1 * HALF + wr * 64 + mp1 * 32 + mm * 16 + fr, bj1 * HALF + wc * 32 + 8 * fq); }
#pragma unroll
                for (int ps = 0; ps < 2; ++ps) { const int lrow = ps * 16 + (lane >> 2), ch = lane & 3;
                    const u32x4 w = *(const LAS u32x4*)(stg + (lrow * 4 + ch) * 16);
                    *(u32x4*)f.dst(u, row0 + lrow, cb + 8 * ch) = w; }
                cur[0] = nxt[0]; cur[1] = nxt[1]; }
            return;
        }
        if constexpr (has_staged<F>::value && !has_prep<F>::value) {
            const int lane = fr + 16 * fq;
#pragma unroll
            for (int ai = 0; ai < 2; ++ai)
#pragma unroll
                for (int bj = 0; bj < 2; ++bj)
#pragma unroll
                    for (int mp = 0; mp < 2; ++mp) { const int row0 = ai * HALF + wr * 64 + mp * 32, cb = bj * HALF + wc * 32;
#pragma unroll
                        for (int mm = 0; mm < 2; ++mm) { const f32x4 a = acc[ai][bj][2 * mp + mm][0], b = acc[ai][bj][2 * mp + mm][1];
                            float v[8] = {a[0], a[1], a[2], a[3], b[0], b[1], b[2], b[3]};
                            *(LAS u32x4*)(stg + ((mm * 16 + fr) * 4 + fq) * 16) = f.pack(u, row0 + mm * 16 + fr, cb + 8 * fq, v); }
#pragma unroll
                        for (int ps = 0; ps < 2; ++ps) { const int lrow = ps * 16 + (lane >> 2), ch = lane & 3;
                            const u32x4 w = *(const LAS u32x4*)(stg + (lrow * 4 + ch) * 16);
                            if constexpr (STORE) *(u32x4*)f.dst(u, row0 + lrow, cb + 8 * ch) = w; else asm volatile("" :: "v"(w)); } }
            return;
        }
#pragma unroll
        for (int ai = 0; ai < 2; ++ai)
#pragma unroll
            for (int m = 0; m < 4; ++m) { const int row = ai * HALF + wr * 64 + m * 16 + fr;
#pragma unroll
                for (int bj = 0; bj < 2; ++bj) { const f32x4 a = acc[ai][bj][m][0], b = acc[ai][bj][m][1];
                    float v[8] = {a[0], a[1], a[2], a[3], b[0], b[1], b[2], b[3]};
                    f(u, row, bj * HALF + wc * 32 + 8 * fq, v); } }
    }
    __device__ __forceinline__ void operator()(f32x4 (&acc)[2][2][4][2], const Unit& u, int wr, int wc, int fr, int fq, LAS unsigned char* stg) const { run<true>(acc, u, wr, wc, fr, fq, stg); }
};

typedef int v8i32 __attribute__((ext_vector_type(8)));
template <class Epi, class Sched, bool FP8 = false, bool AG = false>
__device__ __forceinline__ void gemm_phase(LAS unsigned char* lds, const Gemm g, const Sched& S, const Epi& E) {
    int tid_ = threadIdx.x; asm volatile("" : "+v"(tid_));
    const int tid = tid_, wid = __builtin_amdgcn_readfirstlane(tid >> 6), lane = tid & 63, wr = wid >> 2, wc = wid & 3, fr = lane & 15, fq = lane >> 4;
    int K_ = g.K; asm volatile("" : "+s"(K_));
    const int K = K_, nt = FP8 ? K / (2 * BK) : K / BK;
    unsigned voffA[2], voffB[2];
#pragma unroll
    for (int i = 0; i < 2; ++i) { int R, C; stage_rc(tid * 16 + i * 8192, R, C); const int Rb = Epi::PERM ? ((R & ~31) + perm32(R & 31)) : R;
        voffA[i] = FP8 ? (unsigned)(R * g.lda + C * 2) : (unsigned)(R * g.lda + C) * 2u; voffB[i] = FP8 ? (unsigned)(Rb * g.ldb + C * 2) : (unsigned)(Rb * g.ldb + C) * 2u; }
    const size_t kstep = (size_t)(BK * 2);
    const size_t hstepA = (size_t)HALF * g.lda * (FP8 ? 1 : 2), hstepB = (size_t)HALF * g.ldb * (FP8 ? 1 : 2);
    const unsigned ldsw = (unsigned)wid * 1024u;
    const int aoff = FP8 ? lds_byte(wr * 64 + fr, fq * 16) : lds_byte(wr * 64 + fr, fq * 8), boff = FP8 ? lds_byte(wc * 32 + fr, fq * 16) : lds_byte(wc * 32 + fr, fq * 8);
    constexpr int KOFF = FP8 ? 16 : 1024;
#define PG8_SA(b, h) (((b) * 2 + (h)) * HTB)
#define PG8_SB(b, h) ((4 + (b) * 2 + (h)) * HTB)
#define PG8_STAGE(bufoff, gbase, voff) do { _Pragma("unroll") for (int _i = 0; _i < 2; ++_i) \
        __builtin_amdgcn_global_load_lds((const unsigned*)((const char*)(gbase) + (voff)[_i]), (LAS unsigned*)(lds + (bufoff) + ldsw + _i * 8192), 16, 0, 0); } while (0)
    unsigned tokA[2], tokN[2];
#define PG8_AGLOAD(un, tk) do { int t_ = tid; asm volatile("" : "+v"(t_)); _Pragma("unroll") for (int _i = 0; _i < 2; ++_i) { int R_, C_; stage_rc(t_ * 16 + _i * 8192, R_, C_); const int* rt_ = g.rowtok + (un).aux * 256 + R_; \
        tk[_i] = (unsigned)rt_[0] | ((unsigned)rt_[HALF] << 16); } } while (0)
#define PG8_STAGE_A(b, h, kptr, nx) do { if constexpr (AG) { int t_ = tid; asm volatile("" : "+v"(t_)); int R_, C_; stage_rc(t_ * 16, R_, C_);       \
          _Pragma("unroll") for (int _i = 0; _i < 2; ++_i) { const unsigned tk_ = (nx) ? tokN[_i] : tokA[_i]; \
            const unsigned vo_ = ((h) ? (tk_ >> 16) : (tk_ & 0xffffu)) * (unsigned)g.lda + (unsigned)(C_ * 2); \
            __builtin_amdgcn_global_load_lds((const unsigned*)((const char*)(kptr) + vo_), (LAS unsigned*)(lds + PG8_SA(b, h) + ldsw + _i * 8192), 16, 0, 0); } } \
        else PG8_STAGE(PG8_SA(b, h), (kptr) + (h) * hstepA, voffA); } while (0)
#define PG8_LDA(dst, b, h) do { _Pragma("unroll") for (int m = 0; m < 4; ++m) _Pragma("unroll") for (int k = 0; k < 2; ++k) dst[m][k] = *(const LAS bf16x8*)(lds + PG8_SA(b, h) + aoff + m * 2048 + k * KOFF); } while (0)
#define PG8_LDB(dst, b, h) do { _Pragma("unroll") for (int n = 0; n < 2; ++n) _Pragma("unroll") for (int k = 0; k < 2; ++k) dst[n][k] = *(const LAS bf16x8*)(lds + PG8_SB(b, h) + boff + n * 2048 + k * KOFF); } while (0)
#define PG8_CAT(x) __builtin_bit_cast(v8i32, __builtin_shufflevector((x)[0], (x)[1], 0, 1, 2, 3, 4, 5, 6, 7, 8, 9, 10, 11, 12, 13, 14, 15))
#define PG8_MMA(ai, bj, At, Bt) do { __builtin_amdgcn_s_setprio(1); _Pragma("unroll") for (int m = 0; m < 4; ++m) _Pragma("unroll") for (int n = 0; n < 2; ++n) { \
        if constexpr (FP8) { const v8i32 b8_ = PG8_CAT(Bt[n]), a8_ = PG8_CAT(At[m]); asm volatile("v_mfma_f32_16x16x128_f8f6f4 %0, %1, %2, %0" : "+v"(acc[ai][bj][m][n]) : "v"(b8_), "v"(a8_)); } \
        else { _Pragma("unroll") for (int k = 0; k < 2; ++k) acc[ai][bj][m][n] = __builtin_amdgcn_mfma_f32_16x16x32_bf16(Bt[n][k], At[m][k], acc[ai][bj][m][n], 0, 0, 0); } } \
        PG8_XMFMA(At, Bt); __builtin_amdgcn_s_setprio(0); } while (0)
#if defined(GEMM_XMFMA)
#define PG8_XMFMA(At, Bt) do { if constexpr (!FP8) { _Pragma("unroll") for (int x_ = 0; x_ < 4; ++x_) xacc_ = __builtin_amdgcn_mfma_f32_16x16x32_bf16(Bt[0][0], At[x_][0], xacc_, 0, 0, 0); asm volatile("" : "+v"(xacc_)); } } while (0)
#else
#define PG8_XMFMA(At, Bt) do { } while (0)
#endif
#define PG8_WAIT_V(n) asm volatile("s_waitcnt vmcnt(" #n ")" ::: "memory")
#define PG8_WAIT_L(n) asm volatile("s_waitcnt lgkmcnt(" #n ")" ::: "memory")
#define PG8_BAR __builtin_amdgcn_s_barrier()
#define PG8_SCHED __builtin_amdgcn_sched_barrier(0)
    Unit cur, nxt; int ui = 0;
    if (!S.next(0, cur)) return;
    f32x4 acc[2][2][4][2];
#pragma unroll
    for (int a = 0; a < 2; ++a)
#pragma unroll
        for (int b = 0; b < 2; ++b)
#pragma unroll
            for (int m = 0; m < 4; ++m)
#pragma unroll
                for (int n = 0; n < 2; ++n) acc[a][b][m][n] = (f32x4){0.f, 0.f, 0.f, 0.f};
    bf16x8 At[4][2], B0[2][2], B1[2][2];
#if defined(GEMM_XMFMA)
    f32x4 xacc_ = (f32x4){0.f, 0.f, 0.f, 0.f};
#endif
    const char* cA = (const char*)g.A + (AG ? 0 : cur.aoff); const char* cB = (const char*)g.Bt + cur.boff;
    if constexpr (AG) { static_assert(!AG || FP8, "gathered A: fp8 rows"); PG8_AGLOAD(cur, tokA); }
    PG8_STAGE(PG8_SB(0, 0), cB, voffB); PG8_STAGE(PG8_SB(0, 1), cB + hstepB, voffB); PG8_STAGE_A(0, 0, cA, false); PG8_STAGE_A(0, 1, cA, false);
    if (wr == 1) PG8_BAR;
    PG8_WAIT_V(2); PG8_BAR;
    PG8_STAGE(PG8_SB(1, 0), cB + kstep, voffB); PG8_STAGE_A(1, 0, cA + kstep, false); PG8_STAGE(PG8_SB(1, 1), cB + hstepB + kstep, voffB);
    PG8_WAIT_V(6); PG8_BAR;
    for (;;) {
        const bool has_next = S.next(ui + 1, nxt);
        const char* nA = (has_next && !AG) ? (const char*)g.A + nxt.aoff : cA; const char* nB = has_next ? (const char*)g.Bt + nxt.boff : cB;
        if constexpr (AG) { if (has_next) PG8_AGLOAD(nxt, tokN); else { tokN[0] = tokA[0]; tokN[1] = tokA[1]; } }
        for (int t = 0; t < nt; t += 2) {
            const bool last = (t == nt - 2);
            const char* a1 = cA + (size_t)(t + 1) * kstep;
            const char* a2 = last ? nA : cA + (size_t)(t + 2) * kstep; const char* b2 = last ? nB : cB + (size_t)(t + 2) * kstep;
            const char* a3 = a2 + kstep; const char* b3 = b2 + kstep;
            PG8_LDB(B0, 0, 0); PG8_LDB(B1, 0, 1); PG8_SCHED; PG8_LDA(At, 0, 0); PG8_STAGE_A(1, 1, a1, false);
            PG8_WAIT_V(8); PG8_WAIT_L(0); PG8_BAR; PG8_MMA(0, 0, At, B0); PG8_MMA(0, 1, At, B1); PG8_BAR; PG8_SCHED;
            PG8_LDA(At, 0, 1); PG8_STAGE(PG8_SB(0, 0), b2, voffB); PG8_STAGE(PG8_SB(0, 1), b2 + hstepB, voffB); PG8_STAGE_A(0, 0, a2, last);
            PG8_WAIT_V(8); PG8_WAIT_L(0); PG8_BAR; PG8_MMA(1, 0, At, B0); PG8_MMA(1, 1, At, B1); PG8_BAR; PG8_SCHED;
            PG8_LDB(B0, 1, 0); PG8_LDB(B1, 1, 1); PG8_SCHED; PG8_LDA(At, 1, 0); PG8_STAGE_A(0, 1, a2, last);
            PG8_WAIT_V(8); PG8_WAIT_L(0); PG8_BAR; PG8_MMA(0, 0, At, B0); PG8_MMA(0, 1, At, B1); PG8_BAR; PG8_SCHED;
            PG8_LDA(At, 1, 1); PG8_STAGE(PG8_SB(1, 0), b3, voffB); PG8_STAGE(PG8_SB(1, 1), b3 + hstepB, voffB); PG8_STAGE_A(1, 0, a3, last);
            PG8_WAIT_V(8); PG8_WAIT_L(0); PG8_BAR; PG8_MMA(1, 0, At, B0); PG8_MMA(1, 1, At, B1); PG8_BAR; PG8_SCHED;
        }
        if (wr == 0) PG8_BAR;
        if constexpr (FP8) asm volatile("s_nop 15\n\ts_nop 15" ::: "memory");
        E(acc, cur, wr, wc, fr, fq, lds + EPI_STG_OFF + wid * EPI_STG_WAVE);
#if defined(EPI_NOSTORE_REP)
        if constexpr (has_probe<decltype(E.f)>::value) E.template run<false>(acc, cur, wr, wc, fr, fq, lds + EPI_STG_OFF + wid * EPI_STG_WAVE);
#endif
#if defined(EPI_STORE_REP)
        if constexpr (has_probe<decltype(E.f)>::value) E.template run<true>(acc, cur, wr, wc, fr, fq, lds + EPI_STG_OFF + wid * EPI_STG_WAVE);
#endif
        if (!has_next) break;
#pragma unroll
        for (int a = 0; a < 2; ++a)
#pragma unroll
            for (int b = 0; b < 2; ++b)
#pragma unroll
                for (int m = 0; m < 4; ++m)
#pragma unroll
                    for (int n = 0; n < 2; ++n) acc[a][b][m][n] = (f32x4){0.f, 0.f, 0.f, 0.f};
        cur = nxt; cA = nA; cB = nB; ++ui;
        if constexpr (AG) { tokA[0] = tokN[0]; tokA[1] = tokN[1]; }
        if (wr == 1) PG8_BAR;
    }
    PG8_WAIT_V(0);
    PG8_BAR;
#undef PG8_SA
#undef PG8_SB
#undef PG8_STAGE
#undef PG8_STAGE_A
#undef PG8_AGLOAD
#undef PG8_LDA
#undef PG8_LDB
#undef PG8_MMA
#undef PG8_XMFMA
#undef PG8_CAT
#undef PG8_WAIT_V
#undef PG8_WAIT_L
#undef PG8_BAR
#undef PG8_SCHED
}
}

__device__ __forceinline__ bool z_is_rope_col(int n, bool& isq) {
    if (n >= ZC_D) { const int r = n - ZC_D; isq = r < 256; return r < 384; }
    if (n >= ZC_C) { const int r = (n - ZC_C) % 768; isq = r < 256; return r < 512; }
    isq = false; return false;
}
__device__ __forceinline__ int z_map(int n) { bool q; if (!z_is_rope_col(n, q)) return n; const int d = (n - ZC_C) & 63; return n - d + ((d < 32) ? 2 * d : 2 * (d - 32) + 1); }

using pg8::Unit;
using pg8::EpiLd;
struct FStore {
    static constexpr int PROBE = 1;
    static constexpr int STAGED = 1;
    bf16_t* dstp; int ld;
    __device__ __forceinline__ u32x4 pack(const Unit&, int, int, float (&v)[8]) const { return pack8(v); }
    __device__ __forceinline__ bf16_t* dst(const Unit& u, int row, int c8) const { return dstp + (size_t)(u.pm * 256 + row) * ld + u.pn * 256 + c8; }
    __device__ __forceinline__ void operator()(const Unit& u, int row, int c8, float (&v)[8]) const {
        __builtin_nontemporal_store(pack8(v), (u32x4*)(dstp + (size_t)(u.pm * 256 + row) * ld + u.pn * 256 + c8)); }
};
struct FIn {
    static constexpr int STAGED = 1;
    bf16_t* z; const float* c32; const float* s32; float wsc;
    static constexpr int PREP = 1;
    __device__ __forceinline__ EpiLd prep(const Unit& u, int row, int c8) const {
        const int col = u.pn * 256 + c8, r = u.pm * 256 + row; bool isq; EpiLd w; w.a = (f32x4){0.f, 0.f, 0.f, 0.f}; w.b = w.a;
        if (z_is_rope_col(col, isq)) { const int t = r & (SEQ - 1), i0 = ((col - ZC_C) & 63) >> 1; w.a = *(const f32x4*)(c32 + t * 32 + i0); w.b = *(const f32x4*)(s32 + t * 32 + i0); }
        return w; }
    __device__ __forceinline__ u32x4 pack(const Unit& u, int row, int c8, float (&v)[8], const EpiLd& w) const {
        const int col = u.pn * 256 + c8; bool isq;
#pragma unroll
        for (int i = 0; i < 8; ++i) v[i] *= wsc;
        if (z_is_rope_col(col, isq)) { const f32x4 c = w.a, s = w.b; const float sc = isq ? 0.125f * LOG2E : 1.0f;
#pragma unroll
            for (int p = 0; p < 4; ++p) { const float x1 = v[2 * p], x2 = v[2 * p + 1]; v[2 * p] = (x1 * c[p] - x2 * s[p]) * sc; v[2 * p + 1] = (x2 * c[p] + x1 * s[p]) * sc; } }
        return pack8(v); }
    __device__ __forceinline__ bf16_t* dst(const Unit& u, int row, int c8) const { return z + (size_t)(u.pm * 256 + row) * ZP + u.pn * 256 + c8; }
    __device__ __forceinline__ void operator()(const Unit& u, int row, int c8, float (&v)[8]) const { *(u32x4*)dst(u, row, c8) = pack(u, row, c8, v, prep(u, row, c8)); }
};
struct FStoreS {
    bf16_t* dst; int ld; float sc;
    __device__ __forceinline__ void operator()(const Unit& u, int row, int c8, float (&v)[8]) const {
#pragma unroll
        for (int i = 0; i < 8; ++i) v[i] *= sc;
        *(u32x4*)(dst + (size_t)(u.pm * 256 + row) * ld + u.pn * 256 + c8) = pack8(v); }
};
struct FSilu8 {
    static constexpr int STAGED4 = 1;
    unsigned char* hid; int ld; float sc;
    __device__ __forceinline__ unsigned pack4b(const Unit&, int, int, float (&v)[8]) const {
        float h[4];
#pragma unroll
        for (int i = 0; i < 4; ++i) { const float g = v[2 * i] * sc; h[i] = g * sigmoidf_(g) * (v[2 * i + 1] * sc); }
        return cvt4_fp8(h[0], h[1], h[2], h[3]); }
    __device__ __forceinline__ unsigned char* dst(const Unit& u, int row, int c8) const { return hid + (size_t)(u.pm * 256 + row) * ld + ((u.pn * 256 + c8) >> 1); }
    __device__ __forceinline__ void operator()(const Unit& u, int row, int c8, float (&v)[8]) const { *(unsigned*)dst(u, row, c8) = pack4b(u, row, c8, v); }
};
__device__ __forceinline__ int gate_map(int nn) { const int n = nn >> 10, ch = nn & 1023; return ((ch >> 6) << 8) + ((n >> 1) << 7) + (((ch >> 4) & 3) << 5) + ((((n & 1) << 1) + ((ch >> 3) & 1)) << 3) + (ch & 7); }
__device__ __forceinline__ size_t pfrag_off(int pm, int pn, int wave, int ai, int m, int half, int lane) { return ((size_t)((((((pm * 16 + pn) * 8 + wave) * 2 + ai) * 4 + m) * 2 + half) * 64 + lane)) * 8; }
struct FStoreP {
    bf16_t* P;
    __device__ __forceinline__ void operator()(const Unit& u, int row, int c8, float (&v)[8]) const {
        const int n = u.pn >> 2, c = (u.pn & 3) * 256 + c8, ai = row >> 7, wr = (row >> 6) & 1, m = (row >> 4) & 3, fr = row & 15;
        *(u32x4*)(P + pfrag_off(u.pm, c >> 6, wr * 4 + ((c >> 4) & 3), ai, m, n >> 1, fr + 16 * ((n & 1) * 2 + ((c >> 3) & 1)))) = pack8(v); }
};
struct FGate {
    static constexpr int GATE2 = 1;
    const bf16_t* P; bf16_t* mg; float sc;
    __device__ __forceinline__ void operator()(const Unit&, int, int, float (&)[8]) const {}
    __device__ __forceinline__ void loadp(const Unit& u, int ai, int m, int wr, int wc, int fr, int fq, u32x4& w0, u32x4& w1) const {
        const bf16_t* pf = P + pfrag_off(u.pm, u.pn, wr * 4 + wc, ai, m, 0, fr + 16 * fq); w0 = *(const u32x4*)pf; w1 = *(const u32x4*)(pf + 512); }
    __device__ __forceinline__ void pair(const Unit& u, int ai, int m, int wr, int wc, int fr, int fq, float (&v0)[8], float (&v1)[8], const u32x4 w0, const u32x4 w1) const {
        const size_t r = (size_t)(u.pm * 256 + ai * 128 + wr * 64 + m * 16 + fr); const int ch = u.pn * 64 + wc * 16 + (fq & 1) * 8;
        float p0[8], p1[8]; unpack8(w0, p0); unpack8(w1, p1);
        const float nsc = -sc * LOG2E;
#pragma unroll
        for (int i = 0; i < 8; ++i) v0[i] = __builtin_amdgcn_rcpf(1.0f + __builtin_amdgcn_exp2f(v0[i] * nsc)) * p0[i] + __builtin_amdgcn_rcpf(1.0f + __builtin_amdgcn_exp2f(v1[i] * nsc)) * p1[i];
        float t[4];
#pragma unroll
        for (int i = 0; i < 4; ++i) { auto b = __builtin_amdgcn_permlane32_swap(__float_as_uint(v0[i]), __float_as_uint(v0[i + 4]), false, false); t[i] = __uint_as_float(b[0]) + __uint_as_float(b[1]); }
        u32x2 o; o.x = cvt_pk_bf16(t[0], t[1]); o.y = cvt_pk_bf16(t[2], t[3]);
        *(u32x2*)(mg + r * DM + ch + (fq >> 1) * 4) = o; }
};
struct FSilu {
    static constexpr int STAGED8 = 1;
    bf16_t* hid; int ld;
    __device__ __forceinline__ u32x2 pack8b(const Unit&, int, int, float (&v)[8]) const {
        float h[4];
#pragma unroll
        for (int i = 0; i < 4; ++i) h[i] = v[2 * i] * sigmoidf_(v[2 * i]) * v[2 * i + 1];
        u32x2 w; w.x = cvt_pk_bf16(h[0], h[1]); w.y = cvt_pk_bf16(h[2], h[3]); return w; }
    __device__ __forceinline__ bf16_t* dst(const Unit& u, int row, int c8) const { return hid + (size_t)(u.pm * 256 + row) * ld + ((u.pn * 256 + c8) >> 1); }
    __device__ __forceinline__ void operator()(const Unit& u, int row, int c8, float (&v)[8]) const { *(u32x2*)dst(u, row, c8) = pack8b(u, row, c8, v); }
};
struct FRowScale {
    static constexpr int STAGED = 1;
    bf16_t* y; const float* rowg; float sc;
    static constexpr int PREP = 1;
    __device__ __forceinline__ EpiLd prep(const Unit& u, int row, int) const { EpiLd w; w.a = (f32x4){rowg[(size_t)(u.aux * 256 + row)], 0.f, 0.f, 0.f}; w.b = w.a; return w; }
    __device__ __forceinline__ u32x4 pack(const Unit&, int, int, float (&v)[8], const EpiLd& w) const { const float g = w.a[0] * sc;
#pragma unroll
        for (int i = 0; i < 8; ++i) v[i] *= g;
        return pack8(v); }
    __device__ __forceinline__ bf16_t* dst(const Unit& u, int row, int c8) const { return y + (size_t)(u.aux * 256 + row) * DM + u.pn * 256 + c8; }
    __device__ __forceinline__ void operator()(const Unit& u, int row, int c8, float (&v)[8]) const {
        const size_t r = (size_t)(u.aux * 256 + row); const float g = rowg[r] * sc;
#pragma unroll
        for (int i = 0; i < 8; ++i) v[i] *= g;
        *(u32x4*)(y + r * DM + u.pn * 256 + c8) = pack8(v); }
};
struct FPle {
    bf16_t* pp; float sc;
    __device__ __forceinline__ void operator()(const Unit& u, int row, int c8, float (&v)[8]) const {
        bf16_t* p = pp + (size_t)(u.pm * 256 + row) * DM + u.pn * 256 + c8;
        float q[8]; unpack8(*(const u32x4*)p, q);
#pragma unroll
        for (int i = 0; i < 8; ++i) q[i] *= sigmoidf_(v[i] * sc);
        *(u32x4*)p = pack8(q); }
};
#define EPI_OFF() ((size_t)(u.pm * 256 + row) * DM + u.pn * 256 + c8)
#define EPI_ACC_MEMBERS \
    __device__ __forceinline__ float* slotp(int k) const { return (float*)(ws + WS_XSLOT + (size_t)k * XSLOT_B); } \
    __device__ __forceinline__ unsigned* cntp(int k) const { return (unsigned*)ws + CW_PANEL + (ci + k) * 4096; } \
    __device__ __forceinline__ void operator()(const Unit&, int, int, float (&)[8]) const {}
__device__ __forceinline__ EpiLd epi_ld16(const bf16_t* p) { EpiLd w; w.a = __builtin_bit_cast(f32x4, *(const u32x4*)p); w.b = w.a; return w; }
__device__ __forceinline__ EpiLd epi_none() { EpiLd w; w.a = (f32x4){0.f, 0.f, 0.f, 0.f}; w.b = w.a; return w; }
__device__ __forceinline__ void epi_gain(const float* g, int col, f32x4& ga, f32x4& gb) { ga = *(const f32x4*)(g + col); gb = *(const f32x4*)(g + col + 4); }
struct FPleOut {
    static constexpr int NORMX = 1;
    unsigned char* ws; const float* g; float* out; int ci; float sc;
    EPI_ACC_MEMBERS
    __device__ __forceinline__ EpiLd tload(const Unit& u, int row, int c8) const { return epi_ld16((const bf16_t*)(ws + WS_PP) + EPI_OFF()); }
    __device__ __forceinline__ void tval(const Unit&, int, int, float (&v)[8], const EpiLd& w) const { float q[8]; unpack8(__builtin_bit_cast(u32x4, w.a), q);
#pragma unroll
        for (int i = 0; i < 8; ++i) v[i] = q[i] * sigmoidf_(v[i] * sc); }
    __device__ __forceinline__ void gains(const Unit& u, int c8, int, f32x4& ga, f32x4& gb) const { epi_gain(g, u.pn * 256 + c8, ga, gb); }
    __device__ __forceinline__ EpiLd fload(const Unit& u, int row, int c8) const { return epi_ld16((const bf16_t*)(ws + WS_XB) + EPI_OFF()); }
    __device__ __forceinline__ void finish(const Unit& u, int row, int c8, float (&v)[8], float rs, const EpiLd& w, f32x4 ga, f32x4 gb) const {
        float x[8]; unpack8(__builtin_bit_cast(u32x4, w.a), x); f32x4 o0, o1;
#pragma unroll
        for (int i = 0; i < 4; ++i) { o0[i] = x[i] + v[i] * rs * ga[i]; o1[i] = x[4 + i] + v[4 + i] * rs * gb[i]; }
        float* o = out + EPI_OFF(); *(f32x4*)o = o0; *(f32x4*)(o + 4) = o1; }
};
template <bool XF32>
struct FMixRes {
    static constexpr int NORMX = 2;
    unsigned char* ws; const float* xf; bf16_t* xs; const float* g1; const float* g2; int ci;
    EPI_ACC_MEMBERS
    __device__ __forceinline__ EpiLd tload(const Unit&, int, int) const { return epi_none(); }
    __device__ __forceinline__ void tval(const Unit&, int, int, float (&)[8], const EpiLd&) const {}
    __device__ __forceinline__ void gains(const Unit& u, int c8, int stage, f32x4& ga, f32x4& gb) const { epi_gain(stage == 1 ? g1 : g2, u.pn * 256 + c8, ga, gb); }
    __device__ __forceinline__ EpiLd mload(const Unit& u, int row, int c8) const {
        if constexpr (XF32) { EpiLd w; const float* p = xf + EPI_OFF(); w.a = *(const f32x4*)p; w.b = *(const f32x4*)(p + 4); return w; } else return epi_ld16(xs + EPI_OFF()); }
    __device__ __forceinline__ void mid(const Unit& u, int row, int c8, float (&v)[8], float rs, const EpiLd& w, f32x4 ga, f32x4 gb) const {
        float x[8];
        if constexpr (XF32) { x[0] = w.a[0]; x[1] = w.a[1]; x[2] = w.a[2]; x[3] = w.a[3]; x[4] = w.b[0]; x[5] = w.b[1]; x[6] = w.b[2]; x[7] = w.b[3]; } else unpack8(__builtin_bit_cast(u32x4, w.a), x);
#pragma unroll
        for (int i = 0; i < 4; ++i) { v[i] = x[i] + v[i] * rs * ga[i]; v[4 + i] = x[4 + i] + v[4 + i] * rs * gb[i]; }
        *(u32x4*)(xs + EPI_OFF()) = pack8(v); }
    __device__ __forceinline__ EpiLd fload(const Unit&, int, int) const { return epi_none(); }
    __device__ __forceinline__ void finish(const Unit& u, int row, int c8, float (&v)[8], float rs, const EpiLd&, f32x4 ga, f32x4 gb) const {
#pragma unroll
        for (int i = 0; i < 4; ++i) { v[i] *= rs * ga[i]; v[4 + i] *= rs * gb[i]; }
        *(u32x4*)((bf16_t*)(ws + WS_H2) + EPI_OFF()) = pack8(v); }
};
struct FFfnRes {
    static constexpr int NORMX = 1;
    unsigned char* ws; const bf16_t* xs; const float* g; int ci; float sc;
    EPI_ACC_MEMBERS
    __device__ __forceinline__ EpiLd tload(const Unit&, int, int) const { return epi_none(); }
    __device__ __forceinline__ void tval(const Unit&, int, int, float (&v)[8], const EpiLd&) const {
#pragma unroll
        for (int i = 0; i < 8; ++i) v[i] *= sc; }
    __device__ __forceinline__ void gains(const Unit& u, int c8, int, f32x4& ga, f32x4& gb) const { epi_gain(g, u.pn * 256 + c8, ga, gb); }
    __device__ __forceinline__ EpiLd fload(const Unit& u, int row, int c8) const { return epi_ld16(xs + EPI_OFF()); }
    __device__ __forceinline__ void finish(const Unit& u, int row, int c8, float (&v)[8], float rs, const EpiLd& w, f32x4 ga, f32x4 gb) const {
        float x[8]; unpack8(__builtin_bit_cast(u32x4, w.a), x);
#pragma unroll
        for (int i = 0; i < 4; ++i) { v[i] = x[i] + v[i] * rs * ga[i]; v[4 + i] = x[4 + i] + v[4 + i] * rs * gb[i]; }
        const size_t off = EPI_OFF();
        *(u32x4*)((bf16_t*)(ws + WS_XB) + off) = pack8(v);
        if constexpr (FP8_PLE) { u32x2 o; o.x = cvt4_fp8(v[0], v[1], v[2], v[3]); o.y = cvt4_fp8(v[4], v[5], v[6], v[7]); *(u32x2*)(ws + WS_XB8_DENSE + off) = o; } }
};
template <bool HBF, bool H8>
struct FPleRes {
    static constexpr int NORMX = 2;
    unsigned char* ws; bf16_t* xs; const float* g1; const float* g2; int ci; float sc;
    EPI_ACC_MEMBERS
    __device__ __forceinline__ EpiLd tload(const Unit& u, int row, int c8) const { return epi_ld16((const bf16_t*)(ws + WS_PP) + EPI_OFF()); }
    __device__ __forceinline__ void tval(const Unit&, int, int, float (&v)[8], const EpiLd& w) const { float q[8]; unpack8(__builtin_bit_cast(u32x4, w.a), q);
#pragma unroll
        for (int i = 0; i < 8; ++i) v[i] = q[i] * sigmoidf_(v[i] * sc); }
    __device__ __forceinline__ void gains(const Unit& u, int c8, int stage, f32x4& ga, f32x4& gb) const { epi_gain(stage == 1 ? g1 : g2, u.pn * 256 + c8, ga, gb); }
    __device__ __forceinline__ EpiLd mload(const Unit& u, int row, int c8) const { return epi_ld16((const bf16_t*)(ws + WS_XB) + EPI_OFF()); }
    __device__ __forceinline__ void mid(const Unit& u, int row, int c8, float (&v)[8], float rs, const EpiLd& w, f32x4 ga, f32x4 gb) const {
        float x[8]; unpack8(__builtin_bit_cast(u32x4, w.a), x);
#pragma unroll
        for (int i = 0; i < 4; ++i) { v[i] = x[i] + v[i] * rs * ga[i]; v[4 + i] = x[4 + i] + v[4 + i] * rs * gb[i]; }
        *(u32x4*)(xs + EPI_OFF()) = pack8(v); }
    __device__ __forceinline__ EpiLd fload(const Unit&, int, int) const { return epi_none(); }
    __device__ __forceinline__ void finish(const Unit& u, int row, int c8, float (&v)[8], float rs, const EpiLd&, f32x4 ga, f32x4 gb) const {
#pragma unroll
        for (int i = 0; i < 4; ++i) { v[i] *= rs * ga[i]; v[4 + i] *= rs * gb[i]; }
        const size_t off = EPI_OFF();
        if constexpr (HBF) *(u32x4*)((bf16_t*)(ws + WS_H) + off) = pack8(v);
        if constexpr (H8) { u32x2 o; o.x = cvt4_fp8(v[0], v[1], v[2], v[3]); o.y = cvt4_fp8(v[4], v[5], v[6], v[7]); *(u32x2*)(ws + WS_H8 + off) = o; } }
};
#undef EPI_OFF
#undef EPI_ACC_MEMBERS
struct FUq {
    bf16_t* qa; const float* c16; const float* s16; float scale;
    __device__ __forceinline__ void operator()(const Unit& u, int row, int c8, float (&v)[8]) const {
        const int n = u.pn * 256 + c8; if (n >= 384) return;
        const int r = u.pm * 256 + row, pos = r & (SEQ - 1), j = n % 96;
        if (j >= 64) { const int i0 = (j - 64) >> 1; const f32x4 c = *(const f32x4*)(c16 + pos * 16 + i0), s = *(const f32x4*)(s16 + pos * 16 + i0);
#pragma unroll
            for (int p = 0; p < 4; ++p) { const float x1 = v[2 * p], x2 = v[2 * p + 1]; v[2 * p] = x1 * c[p] - x2 * s[p]; v[2 * p + 1] = x2 * c[p] + x1 * s[p]; } }
#pragma unroll
        for (int i = 0; i < 8; ++i) v[i] *= scale;
        *(u32x4*)(qa + (size_t)r * 384 + n) = pack8(v); }
};
struct FUkv {
    bf16_t* ka; bf16_t* va;
    __device__ __forceinline__ void operator()(const Unit& u, int row, int c8, float (&v)[8]) const {
        const int n = u.pn * 256 + c8, h = n >> 7, j = n & 127; const size_t r = (size_t)(u.pm * 256 + row);
        bf16_t* d = (j < 64) ? ka + r * 384 + h * 96 + j : va + r * 256 + h * 64 + (j - 64);
        *(u32x4*)d = pack8(v); }
};

struct AttnDesc { const bf16_t* Q; const bf16_t* K; const bf16_t* V; bf16_t* O; float* lse; int qs, ks, vs, os, lss, q0, L, band; float m0, l0; };
constexpr int ATT_K = 0, ATT_KSLOT = 12288, ATT_V = 3 * ATT_KSLOT, ATT_VSLOT = 8192, ATT_WS = ATT_V + 3 * ATT_VSLOT, ATT_OST = ATT_WS + 8 * 256, ATT_BYTES = ATT_OST + 8 * 4096;
__device__ __forceinline__ int crow(int r, int hi) { return (r & 3) + 8 * (r >> 2) + 4 * hi; }
__device__ __forceinline__ void att_pv(f32x16 (&o)[2], int vb, bf16x8 pa0, bf16x8 pa1, bf16x8 pa2, bf16x8 pa3) {
#pragma unroll
    for (int d0 = 0; d0 < 2; ++d0) { s16x4 lo[4], hi[4];
#pragma unroll
        for (int ks = 0; ks < 4; ++ks) {
            asm volatile("ds_read_b64_tr_b16 %0,%1 offset:%c2" : "=&v"(lo[ks]) : "v"(vb), "i"(d0 * 4096 + ks * 1024) : "memory");
            asm volatile("ds_read_b64_tr_b16 %0,%1 offset:%c2" : "=&v"(hi[ks]) : "v"(vb), "i"(d0 * 4096 + ks * 1024 + 512) : "memory"); }
        asm volatile("s_waitcnt lgkmcnt(0)" ::: "memory"); __builtin_amdgcn_sched_barrier(0);
#define ATT_PK(k) (bf16x8){lo[k][0], lo[k][1], lo[k][2], lo[k][3], hi[k][0], hi[k][1], hi[k][2], hi[k][3]}
        o[d0] = __builtin_amdgcn_mfma_f32_32x32x16_bf16(pa0, ATT_PK(0), o[d0], 0, 0, 0);
        o[d0] = __builtin_amdgcn_mfma_f32_32x32x16_bf16(pa1, ATT_PK(1), o[d0], 0, 0, 0);
        o[d0] = __builtin_amdgcn_mfma_f32_32x32x16_bf16(pa2, ATT_PK(2), o[d0], 0, 0, 0);
        o[d0] = __builtin_amdgcn_mfma_f32_32x32x16_bf16(pa3, ATT_PK(3), o[d0], 0, 0, 0);
#undef ATT_PK
    }
}
template <int DQK>
__device__ __forceinline__ void attn_unit(LAS unsigned char* lds, const AttnDesc u, const bool pre_in, const bool has_next, const AttnDesc un, bf16x8 (&qr)[DQK / 16]) {
    constexpr int ND = DQK / 16, NCH = DQK / 8;
    int tid_ = threadIdx.x; asm volatile("" : "+v"(tid_));
    const int tid = tid_, lane = tid & 63, r32 = lane & 31, hi = lane >> 5, wid = __builtin_amdgcn_readfirstlane(tid >> 6);
    const int qw0 = u.q0 + wid * 32, band = u.band;
    int t_lo = 0, t_hi = u.L / 64 - 1;
    if (band >= 0) { const int a = u.q0 - band; t_lo = a > 0 ? (a >> 6) : 0; const int b = (u.q0 + 255 + band) >> 6; t_hi = b < t_hi ? b : t_hi; }
    static_assert(DQK == 64, "the banded body stages exactly one K piece and one V piece per wave and tile (its counted wait depends on it)");
#define ATT_DMA(t_, slot_) do { const int tt_ = (t_) < t_hi ? (t_) : t_hi;                   \
        const bf16_t* kg_ = u.K + (size_t)(tt_ * 64 + lane) * u.ks; \
        __builtin_amdgcn_global_load_lds((const unsigned*)(kg_ + wid * 8), (LAS unsigned*)(lds + ATT_K + (slot_) * ATT_KSLOT + wid * 1024), 16, 0, 0); \
        const bf16_t* vg_ = u.V + (size_t)(tt_ * 64 + 16 * (wid & 3) + (lane >> 2)) * u.vs + (wid >> 2) * 32 + (lane & 3) * 8; \
        __builtin_amdgcn_global_load_lds((const unsigned*)vg_, (LAS unsigned*)(lds + ATT_V + (slot_) * ATT_VSLOT + wid * 1024), 16, 0, 0); } while (0)
    if (!pre_in) { ATT_DMA(t_lo, 0); ATT_DMA(t_lo + 1, 1);
        const bf16_t* qp = u.Q + (size_t)(qw0 + r32) * u.qs + hi * 8;
#pragma unroll
        for (int d0 = 0; d0 < ND; ++d0) qr[d0] = *(const bf16x8*)(qp + d0 * 16); }
    float m = u.m0, l = (hi == 0) ? u.l0 : 0.f;
    f32x16 o[2];
#pragma unroll
    for (int r = 0; r < 16; ++r) { o[0][r] = 0.f; o[1][r] = 0.f; }
    LAS float* wsf = (LAS float*)(lds + ATT_WS) + wid * 64;
    const int vb0 = (int)(unsigned)(uintptr_t)(lds + ATT_V) + ((lane >> 4) & 1) * 32 + (lane & 3) * 8 + (4 * hi + ((lane & 15) >> 2)) * 64;
    int slot = 0, fslot = 2;
    for (int t = t_lo; t <= t_hi; ++t) {
        asm volatile("s_waitcnt vmcnt(2) lgkmcnt(0)\n\ts_barrier" ::: "memory");
        ATT_DMA(t + 2, fslot);
        const bool active = band < 0 || (t * 64 + 63 >= qw0 - band && t * 64 <= qw0 + 31 + band);
        if (active) {
            const LAS unsigned char* kp = lds + ATT_K + slot * ATT_KSLOT + hi * 1024 + r32 * 16;
            f32x16 p0, p1;
#pragma unroll
            for (int r = 0; r < 16; ++r) { p0[r] = 0.f; p1[r] = 0.f; }
#pragma unroll
            for (int d0 = 0; d0 < ND; ++d0) {
                const bf16x8 b0 = *(const LAS bf16x8*)(kp + d0 * 2048), b1 = *(const LAS bf16x8*)(kp + d0 * 2048 + 512);
                p0 = __builtin_amdgcn_mfma_f32_32x32x16_bf16(b0, qr[d0], p0, 0, 0, 0);
                p1 = __builtin_amdgcn_mfma_f32_32x32x16_bf16(b1, qr[d0], p1, 0, 0, 0); }
            if (band >= 0) { const int kb = t * 64 + 4 * hi - (qw0 + r32);
#pragma unroll
                for (int r = 0; r < 16; ++r) { const int d = kb + (r & 3) + 8 * (r >> 2);
                    if (d > band || d < -band) p0[r] = -INFINITY;
                    if (d + 32 > band || d + 32 < -band) p1[r] = -INFINITY; } }
            float mx = fmaxf(p0[0], p1[0]);
#pragma unroll
            for (int r = 1; r < 16; ++r) mx = fmaxf(mx, fmaxf(p0[r], p1[r]));
            mx = fmaxf(mx, __shfl_xor(mx, 32));
            const float mn = fmaxf(m, mx), alpha = __builtin_amdgcn_exp2f(m - mn);
            m = mn;
            float s = 0.f;
#pragma unroll
            for (int r = 0; r < 16; ++r) { p0[r] = __builtin_amdgcn_exp2f(p0[r] - mn); p1[r] = __builtin_amdgcn_exp2f(p1[r] - mn); s += p0[r] + p1[r]; }
            l = l * alpha + s;
            if (__any(alpha != 1.0f)) {
                if (hi == 0) wsf[r32] = alpha;
#pragma unroll
                for (int r = 0; r < 16; ++r) { const float a = wsf[crow(r, hi)]; o[0][r] *= a; o[1][r] *= a; } }
            u32x4 pw0, pw1, pw2, pw3;
            pw0.x = cvt_pk_bf16(p0[0], p0[1]); pw0.y = cvt_pk_bf16(p0[2], p0[3]); pw0.z = cvt_pk_bf16(p0[4], p0[5]); pw0.w = cvt_pk_bf16(p0[6], p0[7]);
            pw1.x = cvt_pk_bf16(p0[8], p0[9]); pw1.y = cvt_pk_bf16(p0[10], p0[11]); pw1.z = cvt_pk_bf16(p0[12], p0[13]); pw1.w = cvt_pk_bf16(p0[14], p0[15]);
            pw2.x = cvt_pk_bf16(p1[0], p1[1]); pw2.y = cvt_pk_bf16(p1[2], p1[3]); pw2.z = cvt_pk_bf16(p1[4], p1[5]); pw2.w = cvt_pk_bf16(p1[6], p1[7]);
            pw3.x = cvt_pk_bf16(p1[8], p1[9]); pw3.y = cvt_pk_bf16(p1[10], p1[11]); pw3.z = cvt_pk_bf16(p1[12], p1[13]); pw3.w = cvt_pk_bf16(p1[14], p1[15]);
            att_pv(o, vb0 + slot * ATT_VSLOT, __builtin_bit_cast(bf16x8, pw0), __builtin_bit_cast(bf16x8, pw1), __builtin_bit_cast(bf16x8, pw2), __builtin_bit_cast(bf16x8, pw3));
        }
        slot = (slot == 2) ? 0 : slot + 1; fslot = (fslot == 2) ? 0 : fslot + 1;
    }
    asm volatile("s_waitcnt vmcnt(0)" ::: "memory");
    if (has_next) {
        asm volatile("s_waitcnt lgkmcnt(0)\n\ts_barrier" ::: "memory");
        int n_lo = 0, n_hi = un.L / 64 - 1;
        if (un.band >= 0) { const int a = un.q0 - un.band; n_lo = a > 0 ? (a >> 6) : 0; const int b = (un.q0 + 255 + un.band) >> 6; n_hi = b < n_hi ? b : n_hi; }
#pragma unroll
        for (int k = 0; k < 2; ++k) { const int tt_ = (n_lo + k) < n_hi ? (n_lo + k) : n_hi;
            const bf16_t* kg_ = un.K + (size_t)(tt_ * 64 + lane) * un.ks;
            __builtin_amdgcn_global_load_lds((const unsigned*)(kg_ + wid * 8), (LAS unsigned*)(lds + ATT_K + k * ATT_KSLOT + wid * 1024), 16, 0, 0);
            const bf16_t* vg_ = un.V + (size_t)(tt_ * 64 + 16 * (wid & 3) + (lane >> 2)) * un.vs + (wid >> 2) * 32 + (lane & 3) * 8;
            __builtin_amdgcn_global_load_lds((const unsigned*)vg_, (LAS unsigned*)(lds + ATT_V + k * ATT_VSLOT + wid * 1024), 16, 0, 0); }
        const bf16_t* qp = un.Q + (size_t)(un.q0 + wid * 32 + r32) * un.qs + hi * 8;
#pragma unroll
        for (int d0 = 0; d0 < ND; ++d0) qr[d0] = *(const bf16x8*)(qp + d0 * 16);
    }
#undef ATT_DMA
    l += __shfl_xor(l, 32);
    if (hi == 0) wsf[32 + r32] = l;
    LAS bf16_t* stg = (LAS bf16_t*)(lds + ATT_OST) + wid * 2048;
#pragma unroll
    for (int r = 0; r < 16; ++r) { const int orow = crow(r, hi); const float rl = __builtin_amdgcn_rcpf(wsf[32 + orow]);
        stg[orow * 64 + r32] = (bf16_t)cvt_pk_bf16(o[0][r] * rl, 0.f); stg[orow * 64 + 32 + r32] = (bf16_t)cvt_pk_bf16(o[1][r] * rl, 0.f); }
    LDS_WAIT();
#pragma unroll
    for (int i = 0; i < 4; ++i) { const int row = i * 8 + (lane >> 3), ch = lane & 7; const u32x4 v = *(const LAS u32x4*)(stg + row * 64 + ch * 8);
        *(u32x4*)(u.O + (size_t)(qw0 + row) * u.os + ch * 8) = v; }
    if (u.lse != nullptr && hi == 0) u.lse[(size_t)(qw0 + r32) * u.lss] = m + __builtin_amdgcn_logf(l);
    asm volatile("s_waitcnt lgkmcnt(0)\n\ts_barrier" ::: "memory");
}

__device__ __forceinline__ float att_rowmax(const f32x16& a, const f32x16& b) {
    float x = fmaxf(fmaxf(a[0], a[1]), b[0]), y = fmaxf(fmaxf(a[2], a[3]), b[1]); x = fmaxf(fmaxf(x, b[2]), b[3]);
#pragma unroll
    for (int r = 4; r < 16; r += 4) { x = fmaxf(fmaxf(x, a[r]), a[r + 1]); y = fmaxf(fmaxf(y, a[r + 2]), a[r + 3]); x = fmaxf(fmaxf(x, b[r]), b[r + 1]); y = fmaxf(fmaxf(y, b[r + 2]), b[r + 3]); }
    const float mm = fmaxf(x, y);
    auto rr = __builtin_amdgcn_permlane32_swap(__float_as_uint(mm), __float_as_uint(mm), false, false);
    return fmaxf(__uint_as_float(rr[0]), __uint_as_float(rr[1]));
}
template <int DQK>
__device__ __forceinline__ void att_step(f32x16& c0, f32x16& c1, f32x16& n0, f32x16& n1, const bf16x8 (&qr)[DQK / 16], f32x16& negm, f32x16 (&o)[2], float& m, float& l,
                                         const u32x4 (&pwp)[4], u32x4 (&pwn)[4], LAS float* wsf, const LAS unsigned char* kpn, int vbp, int r32, int hi) {
    constexpr int ND = DQK / 16, NS = 2 * ND;
    const float mx = att_rowmax(c0, c1);
    const bool resc = __any(mx > 8.0f);
    if (__builtin_expect(resc, 0)) {
        const float dl = fmaxf(mx, 0.f); m += dl;
#pragma unroll
        for (int r = 0; r < 16; ++r) { c0[r] -= dl; c1[r] -= dl; negm[r] = -m; }
        const float f = __builtin_amdgcn_exp2f(-dl); l *= f;
        if (hi == 0) wsf[r32] = f;
    }
    float sacc = 0.f;
    bf16x8 kf[NS]; s16x4 vlo[8], vhi[8];
    kf[0] = *(const LAS bf16x8*)(kpn); kf[1] = *(const LAS bf16x8*)(kpn + 512);
    asm volatile("ds_read_b64_tr_b16 %0,%1 offset:0" : "=&v"(vlo[0]) : "v"(vbp) : "memory");
    asm volatile("ds_read_b64_tr_b16 %0,%1 offset:512" : "=&v"(vhi[0]) : "v"(vbp) : "memory");
    asm volatile("" : "+v"(c0[0]), "+v"(c0[1]), "+v"(c1[0]), "+v"(c1[1]));
    asm volatile("" : "+v"(kf[0]));
    __builtin_amdgcn_sched_barrier(0);
#pragma unroll
    for (int i = 0; i < 8; ++i) {
        const int q0 = (NS == 8) ? i : (3 * i) / 2, q1 = (NS == 8) ? i + 1 : (3 * (i + 1)) / 2;
#pragma unroll
        for (int q = q0; q < q1; ++q) { const int d0 = q >> 1;
            if ((q & 1) == 0) n0 = __builtin_amdgcn_mfma_f32_32x32x16_bf16(kf[q], qr[d0], d0 == 0 ? negm : n0, 0, 0, 0);
            else              n1 = __builtin_amdgcn_mfma_f32_32x32x16_bf16(kf[q], qr[d0], d0 == 0 ? negm : n1, 0, 0, 0);
            if (q + 2 < NS) kf[q + 2] = *(const LAS bf16x8*)(kpn + ((q + 2) >> 1) * 2048 + ((q + 2) & 1) * 512); }
        { const int ra = 2 * i, rb = 2 * i + 1;
            c0[ra] = __builtin_amdgcn_exp2f(c0[ra]); c0[rb] = __builtin_amdgcn_exp2f(c0[rb]); c1[ra] = __builtin_amdgcn_exp2f(c1[ra]); c1[rb] = __builtin_amdgcn_exp2f(c1[rb]);
            sacc += (c0[ra] + c0[rb]) + (c1[ra] + c1[rb]);
            const unsigned wa = cvt_pk_bf16(c0[ra], c0[rb]), wb = cvt_pk_bf16(c1[ra], c1[rb]);
            if (i < 4) { pwn[0][i] = wa; pwn[2][i] = wb; } else { pwn[1][i - 4] = wa; pwn[3][i - 4] = wb; } }
        { const int newer = ((q0 + 2 < NS) ? 1 : 0) + ((q1 - q0 > 1 && q0 + 3 < NS) ? 1 : 0);
          if (newer == 2) asm volatile("s_waitcnt lgkmcnt(2)" : "+v"(vlo[i]), "+v"(vhi[i]) :: "memory");
          else if (newer == 1) asm volatile("s_waitcnt lgkmcnt(1)" : "+v"(vlo[i]), "+v"(vhi[i]) :: "memory");
          else asm volatile("s_waitcnt lgkmcnt(0)" : "+v"(vlo[i]), "+v"(vhi[i]) :: "memory"); }
        { const bf16x8 vf = (bf16x8){vlo[i][0], vlo[i][1], vlo[i][2], vlo[i][3], vhi[i][0], vhi[i][1], vhi[i][2], vhi[i][3]};
          o[i & 1] = __builtin_amdgcn_mfma_f32_32x32x16_bf16(__builtin_bit_cast(bf16x8, pwp[i >> 1]), vf, o[i & 1], 0, 0, 0); }
        if (i + 1 < 8) { const int j = i + 1;
            asm volatile("ds_read_b64_tr_b16 %0,%1 offset:%c2" : "=&v"(vlo[j]) : "v"(vbp), "i"((j & 1) * 4096 + (j >> 1) * 1024) : "memory");
            asm volatile("ds_read_b64_tr_b16 %0,%1 offset:%c2" : "=&v"(vhi[j]) : "v"(vbp), "i"((j & 1) * 4096 + (j >> 1) * 1024 + 512) : "memory"); }
        asm volatile("" : "+v"(c0[2 * i]), "+v"(c0[2 * i + 1]), "+v"(c1[2 * i]), "+v"(c1[2 * i + 1]), "+v"(sacc));
        if (i + 1 < 8) asm volatile("" : "+v"(c0[2 * i + 2]), "+v"(c0[2 * i + 3]), "+v"(c1[2 * i + 2]), "+v"(c1[2 * i + 3]));
        if (q1 < NS) asm volatile("" : "+v"(kf[q1]));
        __builtin_amdgcn_sched_barrier(0);
    }
    l += sacc;
    if (__builtin_expect(resc, 0)) {
#pragma unroll
        for (int r = 0; r < 16; ++r) { const float a = wsf[crow(r, hi)]; o[0][r] *= a; o[1][r] *= a; }
    }
}
constexpr int ATD_K0 = 0, ATD_V0 = 3 * ATT_KSLOT, ATD_WS = ATD_V0 + 3 * ATT_VSLOT, ATD_OST = ATD_WS + 8 * 256, ATD_BYTES = ATD_OST + 8 * 4096;
template <int DQK>
__device__ __forceinline__ void attn_dense(LAS unsigned char* lds, const AttnDesc u) {
    constexpr int ND = DQK / 16, NCH = DQK / 8;
    int tid_ = threadIdx.x; asm volatile("" : "+v"(tid_));
    const int tid = tid_, lane = tid & 63, r32 = lane & 31, hi = lane >> 5, wid = __builtin_amdgcn_readfirstlane(tid >> 6);
    const int qw0 = u.q0 + wid * 32, NT = u.L / 64;
    const bool two_k = (NCH > 8) && (wid < NCH - 8);
#define ATD_K(t_, slot_) do { const bf16_t* kg_ = u.K + (size_t)((t_) * 64 + lane) * u.ks; \
        __builtin_amdgcn_global_load_lds((const unsigned*)(kg_ + wid * 8), (LAS unsigned*)(lds + ATD_K0 + (slot_) * ATT_KSLOT + wid * 1024), 16, 0, 0); \
        if (two_k) __builtin_amdgcn_global_load_lds((const unsigned*)(kg_ + (wid + 8) * 8), (LAS unsigned*)(lds + ATD_K0 + (slot_) * ATT_KSLOT + (wid + 8) * 1024), 16, 0, 0); } while (0)
#define ATD_V(t_, slot_) do { const bf16_t* vg_ = u.V + (size_t)((t_) * 64 + 16 * (wid & 3) + (lane >> 2)) * u.vs + (wid >> 2) * 32 + (lane & 3) * 8; \
        __builtin_amdgcn_global_load_lds((const unsigned*)vg_, (LAS unsigned*)(lds + ATD_V0 + (slot_) * ATT_VSLOT + wid * 1024), 16, 0, 0); } while (0)
#define ATD_WAITBAR() do { if (two_k) asm volatile("s_waitcnt vmcnt(3) lgkmcnt(0)\n\ts_barrier" ::: "memory"); else asm volatile("s_waitcnt vmcnt(2) lgkmcnt(0)\n\ts_barrier" ::: "memory"); } while (0)
#define ATD_ROT(x) x = (x == 2) ? 0 : x + 1
    ATD_K(0, 0); ATD_V(0, 2);
    bf16x8 qr[ND];
    { const bf16_t* qp = u.Q + (size_t)(qw0 + r32) * u.qs + hi * 8;
#pragma unroll
      for (int d0 = 0; d0 < ND; ++d0) qr[d0] = *(const bf16x8*)(qp + d0 * 16); }
    float m = 0.f, l = 0.f;
    f32x16 o[2], negm, pA0, pA1, pB0, pB1; u32x4 pwA[4], pwB[4];
#pragma unroll
    for (int r = 0; r < 16; ++r) { o[0][r] = 0.f; o[1][r] = 0.f; negm[r] = 0.f; pA0[r] = 0.f; pA1[r] = 0.f; }
#pragma unroll
    for (int k = 0; k < 4; ++k) pwB[k] = (u32x4){0u, 0u, 0u, 0u};
    LAS float* wsf = (LAS float*)(lds + ATD_WS) + wid * 64;
    const int vb0 = (int)(unsigned)(uintptr_t)(lds + ATD_V0) + ((lane >> 4) & 1) * 32 + (lane & 3) * 8 + (4 * hi + ((lane & 15) >> 2)) * 64;
    const LAS unsigned char* kp0 = lds + ATD_K0 + hi * 1024 + r32 * 16;
    asm volatile("s_waitcnt vmcnt(0) lgkmcnt(0)\n\ts_barrier" ::: "memory");
    ATD_K(1, 1); ATD_V(0, 0); ATD_K(2, 2);
#pragma unroll
    for (int d0 = 0; d0 < ND; ++d0) {
        const bf16x8 b0 = *(const LAS bf16x8*)(kp0 + d0 * 2048), b1 = *(const LAS bf16x8*)(kp0 + d0 * 2048 + 512);
        pA0 = __builtin_amdgcn_mfma_f32_32x32x16_bf16(b0, qr[d0], pA0, 0, 0, 0);
        pA1 = __builtin_amdgcn_mfma_f32_32x32x16_bf16(b1, qr[d0], pA1, 0, 0, 0); }
    { const float mx = att_rowmax(pA0, pA1); m = mx;
#pragma unroll
      for (int r = 0; r < 16; ++r) { pA0[r] -= mx; pA1[r] -= mx; negm[r] = -mx; } }
    int kn = 1, kf = 0, vp = 2, vf = 1;
    for (int t = 0; t < NT; t += 2) {
        ATD_WAITBAR();
        { const int tk = t + 3 < NT ? t + 3 : NT - 1, tv = t + 1; ATD_K(tk, kf); ATD_V(tv, vf); }
        att_step<DQK>(pA0, pA1, pB0, pB1, qr, negm, o, m, l, pwB, pwA, wsf, kp0 + kn * ATT_KSLOT, vb0 + vp * ATT_VSLOT, r32, hi);
        ATD_ROT(kn); ATD_ROT(kf); ATD_ROT(vp); ATD_ROT(vf);
        ATD_WAITBAR();
        { const int tk = t + 4 < NT ? t + 4 : NT - 1, tv = t + 2 < NT ? t + 2 : NT - 1; ATD_K(tk, kf); ATD_V(tv, vf); }
        att_step<DQK>(pB0, pB1, pA0, pA1, qr, negm, o, m, l, pwA, pwB, wsf, kp0 + kn * ATT_KSLOT, vb0 + vp * ATT_VSLOT, r32, hi);
        ATD_ROT(kn); ATD_ROT(kf); ATD_ROT(vp); ATD_ROT(vf);
    }
    asm volatile("s_waitcnt vmcnt(0) lgkmcnt(0)\n\ts_barrier" ::: "memory");
    att_pv(o, vb0 + vp * ATT_VSLOT, __builtin_bit_cast(bf16x8, pwB[0]), __builtin_bit_cast(bf16x8, pwB[1]), __builtin_bit_cast(bf16x8, pwB[2]), __builtin_bit_cast(bf16x8, pwB[3]));
#undef ATD_K
#undef ATD_V
#undef ATD_WAITBAR
#undef ATD_ROT
    l += __shfl_xor(l, 32);
    if (hi == 0) wsf[32 + r32] = l;
    LAS bf16_t* stg = (LAS bf16_t*)(lds + ATD_OST) + wid * 2048;
#pragma unroll
    for (int r = 0; r < 16; ++r) { const int orow = crow(r, hi); const float rl = __builtin_amdgcn_rcpf(wsf[32 + orow]);
        stg[orow * 64 + r32] = (bf16_t)cvt_pk_bf16(o[0][r] * rl, 0.f); stg[orow * 64 + 32 + r32] = (bf16_t)cvt_pk_bf16(o[1][r] * rl, 0.f); }
    LDS_WAIT();
#pragma unroll
    for (int i = 0; i < 4; ++i) { const int row = i * 8 + (lane >> 3), ch = lane & 7; const u32x4 v = *(const LAS u32x4*)(stg + row * 64 + ch * 8);
        *(u32x4*)(u.O + (size_t)(qw0 + row) * u.os + ch * 8) = v; }
    asm volatile("s_waitcnt vmcnt(0) lgkmcnt(0)\n\ts_barrier" ::: "memory");
}

__device__ __forceinline__ void load4(const bf16_t* p, float (&v)[4]) { const u32x2 w = *(const u32x2*)p; v[0] = bf_lo(w.x); v[1] = bf_hi(w.x); v[2] = bf_lo(w.y); v[3] = bf_hi(w.y); }
__device__ __forceinline__ void store4(bf16_t* p, const float (&v)[4]) { u32x2 w; w.x = cvt_pk_bf16(v[0], v[1]); w.y = cvt_pk_bf16(v[2], v[3]); *(u32x2*)p = w; }

__device__ __forceinline__ int uq_map(int n) { const int h = n / 96, j = n - h * 96; if (j < 64) return n; const int jj = j - 64; return h * 96 + 64 + 2 * (jj & 15) + (jj >> 4); }
__device__ __forceinline__ void tr_item(const float* W, int ldw, int ncol0, int Nsub, bf16_t* WT, int ldt, int rbase, int rmul, int mode, LAS float* scr, int item, int lane0) {
    int lane = lane0; asm volatile("" : "+v"(lane));
    const int nblk = Nsub / 32, kb = item / nblk, nb = item - kb * nblk, k0 = 64 * kb, n0 = 32 * nb;
    { f32x4 v[8];
#pragma unroll
      for (int i = 0; i < 8; ++i) v[i] = *(const f32x4*)(W + (size_t)(k0 + 8 * i + (lane >> 3)) * ldw + ncol0 + n0 + 4 * (lane & 7));
#pragma unroll
      for (int i = 0; i < 8; ++i) { LAS float* d = scr + (8 * i + (lane >> 3)) * 33 + 4 * (lane & 7); d[0] = v[i][0]; d[1] = v[i][1]; d[2] = v[i][2]; d[3] = v[i][3]; } }
    LDS_WAIT();
    const int c = lane & 7;
#pragma unroll
    for (int j = 0; j < 4; ++j) { const int n = (lane >> 3) + 8 * j; const LAS float* s = scr + (8 * c) * 33 + n;
        u32x4 o; o.x = cvt_pk_bf16(s[0 * 33], s[1 * 33]); o.y = cvt_pk_bf16(s[2 * 33], s[3 * 33]); o.z = cvt_pk_bf16(s[4 * 33], s[5 * 33]); o.w = cvt_pk_bf16(s[6 * 33], s[7 * 33]);
        const int nn = n0 + n, dest = mode == 1 ? uq_map(nn) : (mode == 2 ? gate_map(nn) : (mode == 3 ? z_map(nn) : rbase + nn * rmul));
        *(u32x4*)(WT + (size_t)dest * ldt + k0 + 8 * c) = o; }
    LDS_WAIT();
}

__device__ __forceinline__ void tr_load(const float* W, int ldw, int Nsub, int item, int lane0, f32x4 (&v)[8]) {
    int lane = lane0; asm volatile("" : "+v"(lane));
    const int nblk = Nsub / 32, kb = item / nblk, nb = item - kb * nblk, k0 = 64 * kb, n0 = 32 * nb;
#pragma unroll
    for (int i = 0; i < 8; ++i) v[i] = *(const f32x4*)(W + (size_t)(k0 + 8 * i + (lane >> 3)) * ldw + n0 + 4 * (lane & 7));
}
__device__ __forceinline__ void tr_finish8(const f32x4 (&v)[8], int Nsub, unsigned char* WT, int ldt, int rbase, int rmul, float scale, LAS float* scr, int item, int lane0, int mode = 0) {
    int lane = lane0; asm volatile("" : "+v"(lane));
    const int nblk = Nsub / 32, kb = item / nblk, nb = item - kb * nblk, k0 = 64 * kb, n0 = 32 * nb;
#pragma unroll
    for (int i = 0; i < 8; ++i) { LAS float* d = scr + (8 * i + (lane >> 3)) * 33 + 4 * (lane & 7); d[0] = v[i][0]; d[1] = v[i][1]; d[2] = v[i][2]; d[3] = v[i][3]; }
    LDS_WAIT();
    const int c = lane & 7;
#pragma unroll
    for (int j = 0; j < 4; ++j) { const int n = (lane >> 3) + 8 * j; const LAS float* q = scr + (8 * c) * 33 + n;
        u32x2 o; o.x = cvt4_fp8(q[0 * 33] * scale, q[1 * 33] * scale, q[2 * 33] * scale, q[3 * 33] * scale); o.y = cvt4_fp8(q[4 * 33] * scale, q[5 * 33] * scale, q[6 * 33] * scale, q[7 * 33] * scale);
        const int nn = n0 + n, dest = mode == 1 ? gate_map(nn) : (mode == 2 ? z_map(nn) : rbase + nn * rmul);
        *(u32x2*)(WT + (size_t)dest * ldt + k0 + 8 * c) = o; }
    LDS_WAIT();
}
__device__ __forceinline__ void tr_item8(const float* W, int ldw, int Nsub, unsigned char* WT, int ldt, int rbase, int rmul, float scale, LAS float* scr, int item, int lane, int mode = 0) {
    f32x4 v[8]; tr_load(W, ldw, Nsub, item, lane, v); tr_finish8(v, Nsub, WT, ldt, rbase, rmul, scale, scr, item, lane, mode);
}

template <int ROPE, bool NORM>
__device__ __forceinline__ void head_compute(float (&v)[4], int lane, const f32x4 g, const f32x4 c, const f32x4 s, float scale) {
    const int jj = lane & 15;
    if (NORM) { float ss = (v[0] * v[0] + v[1] * v[1]) + (v[2] * v[2] + v[3] * v[3]);
        ss += __shfl_xor(ss, 1); ss += __shfl_xor(ss, 2); ss += __shfl_xor(ss, 4); ss += __shfl_xor(ss, 8);
        const float rs = rsqrtf(ss * (1.0f / 64.0f) + NORM_EPS);
#pragma unroll
        for (int e = 0; e < 4; ++e) v[e] *= rs * g[e]; }
    if (ROPE != 0) { const bool first = (ROPE == 1) ? ((jj & 4) == 0) : ((jj & 8) == 0);
#pragma unroll
        for (int e = 0; e < 4; ++e) { const float pe = __shfl_xor(v[e], ROPE == 1 ? 4 : 8); v[e] = first ? v[e] * c[e] - pe * s[e] : v[e] * c[e] + pe * s[e]; } }
#pragma unroll
    for (int e = 0; e < 4; ++e) v[e] *= scale;
}

struct PostArgs { bf16_t* z; bf16_t* ka; const float *c16, *s16, *qa_g, *kva_g, *bq_g, *bk_g; };
struct PostRegs { float v[5][4]; f32x4 cax, sax, ckr, skr; };
struct PostGains { f32x4 qa, kva, bq, bk; };
__device__ __forceinline__ PostGains post_gains(const PostArgs a, int lane) { PostGains g; g.qa = *(const f32x4*)(a.qa_g + 4 * lane); g.kva = *(const f32x4*)(a.kva_g + 4 * (lane & 31));
    g.bq = *(const f32x4*)(a.bq_g + 4 * (lane & 15)); g.bk = *(const f32x4*)(a.bk_g + 4 * (lane & 15)); return g; }
__device__ __forceinline__ void post_load(const PostArgs a, int row, int lane, PostRegs& p) {
    const bf16_t* zr = a.z + (size_t)row * ZP; const int t = row & (SEQ - 1), trow = t >> 6, tcol = t & 63, jj = lane & 15; const bool h32 = lane < 32;
#pragma unroll
    for (int i = 0; i < 5; ++i) { p.v[i][0] = 0.f; p.v[i][1] = 0.f; p.v[i][2] = 0.f; p.v[i][3] = 0.f; }
    load4(zr + 4 * lane, p.v[0]);
    if (h32) load4(zr + 256 + 4 * lane, p.v[1]);
    if (lane < 8) load4(zr + 384 + 4 * lane, p.v[2]);
    load4(zr + ZC_B + 4 * lane, p.v[3]);
    if (h32) load4(zr + ZC_B + 256 + 4 * lane, p.v[4]);
    const int pax = (jj < 8) ? trow : tcol;
    p.cax = *(const f32x4*)(a.c16 + pax * 16 + 4 * (jj & 3)); p.sax = *(const f32x4*)(a.s16 + pax * 16 + 4 * (jj & 3));
    p.ckr = *(const f32x4*)(a.c16 + t * 16 + 4 * (lane & 3)); p.skr = *(const f32x4*)(a.s16 + t * 16 + 4 * (lane & 3));
}
__device__ __forceinline__ void post_finish(const PostArgs a, const PostGains& pg, int row, int lane, PostRegs& p) {
    bf16_t* zr = a.z + (size_t)row * ZP; const float QS = 0.125f * LOG2E; const bool h32 = lane < 32;
    float (&v)[5][4] = p.v; const f32x4 cax = p.cax, sax = p.sax, ckr = p.ckr, skr = p.skr;
    { const float ss = wave_sum((v[0][0] * v[0][0] + v[0][1] * v[0][1]) + (v[0][2] * v[0][2] + v[0][3] * v[0][3])); const float rs = rsqrtf(ss * (1.0f / 256.0f) + NORM_EPS); const f32x4 g = pg.qa;
#pragma unroll
      for (int e = 0; e < 4; ++e) v[0][e] *= rs * g[e]; }
    { float ss = (v[1][0] * v[1][0] + v[1][1] * v[1][1]) + (v[1][2] * v[1][2] + v[1][3] * v[1][3]);
      ss += __shfl_xor(ss, 1); ss += __shfl_xor(ss, 2); ss += __shfl_xor(ss, 4); ss += __shfl_xor(ss, 8); ss += __shfl_xor(ss, 16);
      const float rs = rsqrtf(ss * (1.0f / 128.0f) + NORM_EPS); const f32x4 g = pg.kva;
#pragma unroll
      for (int e = 0; e < 4; ++e) v[1][e] *= rs * g[e]; }
    float okr[8];
#pragma unroll
    for (int e = 0; e < 4; ++e) { const float pe = __shfl_xor(v[2][e], 4); okr[2 * e] = v[2][e] * ckr[e] - pe * skr[e]; okr[2 * e + 1] = pe * ckr[e] + v[2][e] * skr[e]; }
    head_compute<1, true>(v[3], lane, pg.bq, cax, sax, QS);
    head_compute<1, true>(v[4], lane, pg.bk, cax, sax, 1.0f);
    store4(zr + 4 * lane, v[0]);
    if (h32) store4(zr + 256 + 4 * lane, v[1]);
    if (lane < 4) { const u32x4 w = pack8(okr); bf16_t* kr = a.ka + (size_t)row * 384 + 64 + 8 * lane;
#pragma unroll
        for (int h = 0; h < 4; ++h) *(u32x4*)(kr + h * 96) = w; }
    store4(zr + ZC_B + 4 * lane, v[3]);
    if (h32) store4(zr + ZC_B + 256 + 4 * lane, v[4]);
}

struct RowsArgs {
    const float* xin; const bf16_t* xin_bf; float* xout; const bf16_t* tsrc; const bf16_t* y; const int* tokrow; const float* gpost;
    bf16_t* hout; const float* gnext; bf16_t* xbout;
    const float* router_b; int* ti_e; int* ti_p0; int* ti_p1; float* ti_g0; float* ti_g1; int do_router; int h_fp8; unsigned char* hout8; unsigned char* xb8out;
};
__device__ __forceinline__ void rows_load(const RowsArgs a, int row, int lane, f32x4 (&x)[4], float (&tv)[4][4]) {
    if (a.xin != nullptr) { const f32x4* xr = (const f32x4*)(a.xin + (size_t)row * DM) + lane;
#pragma unroll
        for (int j = 0; j < 4; ++j) x[j] = xr[64 * j]; }
    else {
#pragma unroll
        for (int j = 0; j < 4; ++j) { float v[4]; load4(a.xin_bf + (size_t)row * DM + 256 * j + 4 * lane, v); x[j] = (f32x4){v[0], v[1], v[2], v[3]}; } }
    if (a.y == nullptr) {
#pragma unroll
        for (int j = 0; j < 4; ++j) load4(a.tsrc + (size_t)row * DM + 256 * j + 4 * lane, tv[j]);
    } else {
        const int r0 = a.tokrow[2 * row], r1 = a.tokrow[2 * row + 1];
#pragma unroll
        for (int j = 0; j < 4; ++j) { float p[4], q[4]; load4(a.y + (size_t)r0 * DM + 256 * j + 4 * lane, p); load4(a.y + (size_t)r1 * DM + 256 * j + 4 * lane, q);
#pragma unroll
            for (int e = 0; e < 4; ++e) tv[j][e] = p[e] + q[e]; }
    }
}
struct RowGains { f32x4 gp[4], gn[4]; };
__device__ __forceinline__ RowGains rows_gains(const RowsArgs a, int lane) { RowGains g;
#pragma unroll
    for (int j = 0; j < 4; ++j) { g.gp[j] = *((const f32x4*)a.gpost + 64 * j + lane); g.gn[j] = (a.gnext != nullptr) ? *((const f32x4*)a.gnext + 64 * j + lane) : (f32x4){0.f, 0.f, 0.f, 0.f}; }
    return g; }
__device__ __forceinline__ void rows_finish(const RowsArgs a, const RowGains& rg, int row, int lane, f32x4 (&x)[4], float (&tv)[4][4], LAS float* wr_lds, LAS int* cnt_lds) {
    float ss = 0.f;
#pragma unroll
    for (int j = 0; j < 4; ++j) ss += (tv[j][0] * tv[j][0] + tv[j][1] * tv[j][1]) + (tv[j][2] * tv[j][2] + tv[j][3] * tv[j][3]);
    const float rs = rsqrtf(wave_sum(ss) * (1.0f / DM) + NORM_EPS);
    float s2 = 0.f;
#pragma unroll
    for (int j = 0; j < 4; ++j) { const f32x4 g = rg.gp[j];
#pragma unroll
        for (int e = 0; e < 4; ++e) { x[j][e] += tv[j][e] * rs * g[e]; s2 += x[j][e] * x[j][e]; } }
    if (a.xout != nullptr) { f32x4* xo = (f32x4*)(a.xout + (size_t)row * DM) + lane;
#pragma unroll
        for (int j = 0; j < 4; ++j) xo[64 * j] = x[j]; }
    if (a.xbout != nullptr) {
#pragma unroll
        for (int j = 0; j < 4; ++j) { const float v[4] = {x[j][0], x[j][1], x[j][2], x[j][3]}; store4(a.xbout + (size_t)row * DM + 256 * j + 4 * lane, v);
            if (a.xb8out != nullptr) *(unsigned*)(a.xb8out + (size_t)row * DM + 256 * j + 4 * lane) = cvt4_fp8(v[0], v[1], v[2], v[3]); }
    }
    if (a.hout != nullptr) {
        const float rs2 = rsqrtf(wave_sum(s2) * (1.0f / DM) + NORM_EPS);
        float lg[NE];
#pragma unroll
        for (int e = 0; e < NE; ++e) lg[e] = 0.f;
#pragma unroll
        for (int j = 0; j < 4; ++j) { const f32x4 g = rg.gn[j]; float v[4];
#pragma unroll
            for (int e = 0; e < 4; ++e) v[e] = x[j][e] * rs2 * g[e];
            if (a.h_fp8) *(unsigned*)((unsigned char*)a.hout + (size_t)row * DM + 256 * j + 4 * lane) = cvt4_fp8(v[0], v[1], v[2], v[3]);
            else store4(a.hout + (size_t)row * DM + 256 * j + 4 * lane, v);
            if (a.hout8 != nullptr) *(unsigned*)(a.hout8 + (size_t)row * DM + 256 * j + 4 * lane) = cvt4_fp8(v[0], v[1], v[2], v[3]);
            if (a.do_router) {
#pragma unroll
                for (int e = 0; e < 4; ++e) { const LAS f32x4* w = (const LAS f32x4*)(wr_lds + (256 * j + 4 * lane + e) * NE); const f32x4 w0 = w[0], w1 = w[1];
                    lg[0] += v[e] * w0[0]; lg[1] += v[e] * w0[1]; lg[2] += v[e] * w0[2]; lg[3] += v[e] * w0[3]; lg[4] += v[e] * w1[0]; lg[5] += v[e] * w1[1]; lg[6] += v[e] * w1[2]; lg[7] += v[e] * w1[3]; } } }
        if (a.do_router) {
#pragma unroll
            for (int e = 0; e < NE; ++e) lg[e] = wave_sum(lg[e]) + a.router_b[e];
            int e0 = 0; float v0 = lg[0];
#pragma unroll
            for (int e = 1; e < NE; ++e) if (lg[e] > v0) { v0 = lg[e]; e0 = e; }
            int e1 = -1; float v1 = -INFINITY;
#pragma unroll
            for (int e = 0; e < NE; ++e) if (e != e0 && lg[e] > v1) { v1 = lg[e]; e1 = e; }
            const float ex = __expf(v1 - v0), g0 = 1.0f / (1.0f + ex), g1 = ex * g0;
            if (lane == 0) { const int p0 = __hip_atomic_fetch_add(cnt_lds + e0, 1, __ATOMIC_RELAXED, __HIP_MEMORY_SCOPE_WORKGROUP), p1 = __hip_atomic_fetch_add(cnt_lds + e1, 1, __ATOMIC_RELAXED, __HIP_MEMORY_SCOPE_WORKGROUP);
                a.ti_e[row] = e0 | (e1 << 8) | ((int)blockIdx.x << 16); a.ti_p0[row] = p0; a.ti_p1[row] = p1; a.ti_g0[row] = g0; a.ti_g1[row] = g1; }
        }
    }
}

constexpr int NWAVES = 8;
constexpr int RING_BYTES = 131072, LDSCTL_OFF = RING_BYTES, MISC_OFF = LDSCTL_OFF + 320, LDS_BYTES = 149504;
constexpr int PH_STRIDE = 25, N_PHASES = 1 + PH_STRIDE * DEPTH;
struct Params { const float* in[27]; float* out; unsigned char* ws; int ph_lo, ph_hi; };

#define IN(k) (lo <= (k) && (k) < hi)
#ifndef SEAMREP
#define SEAMREP 1
#endif
#define SEAM(k) do { if (lo <= (k) && (k) + 1 < hi) { for (int sr_ = 0; sr_ < SEAMREP; ++sr_) xcd_barrier(bar); } } while (0)
#define PH_IDS int tid = threadIdx.x; asm volatile("" : "+v"(tid)); const int lane = tid & 63, wave = __builtin_amdgcn_readfirstlane(tid >> 6), gw = bx * NWAVES + wave; (void)lane; (void)wave; (void)gw;
constexpr int I_IN1 = 16 * 117, I_IN2 = 16 * 128, I_WB = 512, I_WO = 512, I_PG = 512, I_WP = 128, I_UQ = 48, I_UKV = 32;
constexpr int IL = I_IN1 + I_IN2 + I_WB + I_WO + I_PG + I_WP + I_UQ + I_UKV, I_F = 2048, I_UQOFF = IL - I_UQ - I_UKV;
constexpr int W_EARLY = I_IN1 + I_UQ + I_UKV, W_L0REST = IL - W_EARLY, W_ALL = 2 * IL + 3 * I_F;
constexpr int I_E = 16 * 112, MOE_ITEMS = NE * 3 * I_E;
__device__ __forceinline__ void w_layer_item(const Params& P, unsigned char* ws, LAS float* scr, int l, int r, int lane) {
    if (r < I_IN1) { if (l == FP8_IN_LAYER) tr_item8(P.in[2] + (size_t)l * DM * IN_COLS, IN_COLS, ZN, ws + WS_WIN + l * WIN_L, DM, 0, 1, 32.0f, scr, r, lane, 2);
                     else tr_item(P.in[2] + (size_t)l * DM * IN_COLS, IN_COLS, 0, ZN, (bf16_t*)(ws + WS_WIN + l * WIN_L), DM, 0, 1, 3, scr, r, lane); return; } r -= I_IN1;
    if (r < I_IN2) { if (gate_fp8(l)) tr_item8(P.in[2] + (size_t)l * DM * IN_COLS + ZN, IN_COLS, 4096, ws + WS_WG + l * WG_L, DM, 0, 1, 32.0f, scr, r, lane, 1);
                     else tr_item(P.in[2] + (size_t)l * DM * IN_COLS, IN_COLS, ZN, 4096, (bf16_t*)(ws + WS_WG + l * WG_L), DM, 0, 1, 2, scr, r, lane); return; } r -= I_IN2;
    if (r < I_WB) { const int n = r >> 7; tr_item(P.in[10] + (size_t)(l * 4 + n) * 256 * DM, DM, 0, DM, (bf16_t*)(ws + WS_WB + l * WB_L), 256, n * DM, 1, 0, scr, r & 127, lane); return; } r -= I_WB;
    if (r < I_WO) { tr_item(P.in[11] + (size_t)l * DM * DM, DM, 0, DM, (bf16_t*)(ws + WS_WOUT + l * WOUT_L), DM, 0, 1, 0, scr, r, lane); return; } r -= I_WO;
    if (r < I_PG) { if (FP8_PLE) tr_item8(P.in[25] + (size_t)l * DM * DM, DM, DM, ws + WS_WPG + l * WPG_L, DM, 0, 1, 32.0f, scr, r, lane); else tr_item(P.in[25] + (size_t)l * DM * DM, DM, 0, DM, (bf16_t*)(ws + WS_WPG + l * WPG_L), DM, 0, 1, 0, scr, r, lane); return; } r -= I_PG;
    if (r < I_WP) { tr_item(P.in[24] + (size_t)l * 256 * DM, DM, 0, DM, (bf16_t*)(ws + WS_WP + l * WP_L), 256, 0, 1, 0, scr, r, lane); return; } r -= I_WP;
    if (r < I_UQ) { tr_item(P.in[5] + (size_t)l * 256 * 384, 384, 0, 384, (bf16_t*)(ws + WS_WUQ + l * WUQ_L), 256, 0, 1, 1, scr, r, lane); return; } r -= I_UQ;
    tr_item(P.in[6] + (size_t)l * 128 * 512, 512, 0, 512, (bf16_t*)(ws + WS_WUKV + l * WUKV_L), 256, 0, 1, 0, scr, r, lane);
}
__device__ __forceinline__ void w_item(const Params& P, unsigned char* ws, LAS float* scr, int it, int lane) {
    if (it < W_EARLY) { w_layer_item(P, ws, scr, 0, it < I_IN1 ? it : I_UQOFF + (it - I_IN1), lane); return; }
    it -= W_EARLY;
    if (it < W_L0REST) { w_layer_item(P, ws, scr, 0, I_IN1 + it, lane); return; }
    it -= W_L0REST;
    if (it < IL) { w_layer_item(P, ws, scr, 1, it, lane); return; }
    it -= IL;
    if (it < I_F) { tr_item(P.in[16], DFF, 0, DFF, (bf16_t*)(ws + WS_FGU), DM, 0, 2, 0, scr, it, lane); return; } it -= I_F;
    if (it < I_F) { tr_item(P.in[17], DFF, 0, DFF, (bf16_t*)(ws + WS_FGU), DM, 1, 2, 0, scr, it, lane); return; } it -= I_F;
    if (FP8_DENSE_DOWN) tr_item8(P.in[18], DM, DM, ws + WS_FD, DFF, 0, 1, 64.0f, scr, it, lane); else tr_item(P.in[18], DM, 0, DM, (bf16_t*)(ws + WS_FD), DFF, 0, 1, 0, scr, it, lane);
}
__device__ __forceinline__ unsigned char* moe_gu_ptr(const Params& P, unsigned char* ws, int e) { return e < MOE_ESPLIT ? (unsigned char*)P.out + MOEW_GU + (size_t)e * MGU_E : ws + WS_MGU_HI + (size_t)(e - MOE_ESPLIT) * MGU_E; }
__device__ __forceinline__ void moe_load(const Params& P, int lj, int it, int lane, f32x4 (&v)[8]) {
    const int e = it / (3 * I_E); int r = it - e * (3 * I_E);
    if (r < I_E) { tr_load(P.in[21] + ((size_t)lj * NE + e) * DM * MFF, MFF, MFF, r, lane, v); return; } r -= I_E;
    if (r < I_E) { tr_load(P.in[22] + ((size_t)lj * NE + e) * DM * MFF, MFF, MFF, r, lane, v); return; } r -= I_E;
    tr_load(P.in[23] + ((size_t)lj * NE + e) * MFF * DM, DM, DM, r, lane, v);
}
__device__ __forceinline__ void moe_finish(const Params& P, unsigned char* ws, LAS float* scr, int it, int lane, const f32x4 (&v)[8]) {
    const int e = it / (3 * I_E); int r = it - e * (3 * I_E);
    if (r < I_E) { tr_finish8(v, MFF, moe_gu_ptr(P, ws, e), DM, 0, 2, 32.0f, scr, r, lane); return; } r -= I_E;
    if (r < I_E) { tr_finish8(v, MFF, moe_gu_ptr(P, ws, e), DM, 1, 2, 32.0f, scr, r, lane); return; } r -= I_E;
    tr_finish8(v, DM, (unsigned char*)P.out + MOEW_MD + (size_t)e * MD_E, MFF, 0, 1, 64.0f, scr, r, lane);
}
__device__ __forceinline__ void moe_item(const Params& P, unsigned char* ws, LAS float* scr, int lj, int it, int lane) {
    const int e = it / (3 * I_E); int r = it - e * (3 * I_E);
    if (r < I_E) { tr_item8(P.in[21] + ((size_t)lj * NE + e) * DM * MFF, MFF, MFF, moe_gu_ptr(P, ws, e), DM, 0, 2, 32.0f, scr, r, lane); return; } r -= I_E;
    if (r < I_E) { tr_item8(P.in[22] + ((size_t)lj * NE + e) * DM * MFF, MFF, MFF, moe_gu_ptr(P, ws, e), DM, 1, 2, 32.0f, scr, r, lane); return; } r -= I_E;
    tr_item8(P.in[23] + ((size_t)lj * NE + e) * MFF * DM, DM, DM, (unsigned char*)P.out + MOEW_MD + (size_t)e * MD_E, MFF, 0, 1, 64.0f, scr, r, lane);
}

template <int l>
__device__ __forceinline__ void layer_body(const Params P, LAS unsigned char* lds, const XcdBarrier bar, const int lo, const int hi, const int G, const int bx, const int vcu, const int NGW, unsigned char* ws_in, unsigned* ctl) {
    unsigned char* ws = ws_in;
    const float* c16 = (const float*)(ws + WS_COS16); const float* s16 = (const float*)(ws + WS_SIN16);
    const float* c32 = (const float*)(ws + WS_COS32); const float* s32 = (const float*)(ws + WS_SIN32);
    bf16_t* const H = (bf16_t*)(ws + WS_H); bf16_t* const Z = (bf16_t*)(ws + WS_Z);
    bf16_t* const QA = (bf16_t*)(ws + WS_QA); bf16_t* const KA = (bf16_t*)(ws + WS_KA); bf16_t* const VA = (bf16_t*)(ws + WS_VA);
    bf16_t* const OCAT = (bf16_t*)(ws + WS_OCAT);
    bf16_t* const PB = (bf16_t*)(ws + WS_PB); bf16_t* const MERGED = (bf16_t*)(ws + WS_MERGED); bf16_t* const MIX = (bf16_t*)(ws + WS_MIX); bf16_t* const H2 = (bf16_t*)(ws + WS_H2);
    bf16_t* const HID = (bf16_t*)(ws + WS_HID); bf16_t* const FB = (bf16_t*)(ws + WS_FB); bf16_t* const XB = (bf16_t*)(ws + WS_XB); bf16_t* const PP = (bf16_t*)(ws + WS_PP);
    bf16_t* const PBF = (bf16_t*)(ws + WS_PBF);
    bf16_t* const MGU = (bf16_t*)(ws + WS_MGU); bf16_t* const MD = (bf16_t*)(ws + WS_MD); bf16_t* const Y = (bf16_t*)(ws + WS_Y); bf16_t* const XG = (bf16_t*)(ws + WS_XG); bf16_t* const HIDC = (bf16_t*)(ws + WS_HIDC);
    int* const rowtok = (int*)(ws + WS_ROWTOK); int* const tokrow = (int*)(ws + WS_TOKROW); float* const rowg = (float*)(ws + WS_ROWG); int* const wgbase = (int*)(ws + WS_WGBASE);
    int* const ti_e = (int*)(ws + WS_TI_E); int* const ti_p0 = (int*)(ws + WS_TI_P0); int* const ti_p1 = (int*)(ws + WS_TI_P1); float* const ti_g0 = (float*)(ws + WS_TI_G0); float* const ti_g1 = (float*)(ws + WS_TI_G1);

        const int pb = 1 + PH_STRIDE * l; constexpr bool moe = (l & 1) != 0; constexpr int lj = l >> 1;
        const bf16_t* Win_t = (const bf16_t*)(ws + WS_WIN + l * WIN_L); const bf16_t* Wg_t = (const bf16_t*)(ws + WS_WG + l * WG_L);
        const bf16_t* Wb_t = (const bf16_t*)(ws + WS_WB + l * WB_L); const bf16_t* Wout_t = (const bf16_t*)(ws + WS_WOUT + l * WOUT_L);
        const bf16_t* Wpg_t = (const bf16_t*)(ws + WS_WPG + l * WPG_L); const bf16_t* Wp_t = (const bf16_t*)(ws + WS_WP + l * WP_L);
        const bf16_t* Wuq_t = (const bf16_t*)(ws + WS_WUQ + l * WUQ_L); const bf16_t* Wukv_t = (const bf16_t*)(ws + WS_WUKV + l * WUKV_L);

        constexpr int CQ = moe ? 4 : 1, CTOT = moe ? MOE_ITEMS : (l == 0 ? W_ALL - W_EARLY : 0), TQ = moe ? 3 : 8;
        const int m1rem = ((M / 256) * (ZP / 256)) % G, tailw = m1rem ? (G - m1rem) * NWAVES : 0;
        const int CT_A = (tailw * TQ * CQ < CTOT) ? CTOT - tailw * TQ * CQ : 0;
        if (PHEN(1) && IN(pb + 0)) DUPREP(1) {
            if constexpr (l == FP8_IN_LAYER) { pg8::Gemm g{(const bf16_t*)(ws + WS_H8), Win_t, DM, DM, DM}; pg8::GridOrder S{M / 256, ZP / 256, G, bx, DM, DM, 1}; pg8::Epi8<FIn> E{{Z, c32, s32, 1.0f / 32.0f}}; pg8::gemm_phase<pg8::Epi8<FIn>, pg8::GridOrder, true>(lds, g, S, E); }
            else { pg8::Gemm g{H, Win_t, DM, DM, DM}; pg8::GridOrder S{M / 256, ZP / 256, G, bx, DM, DM, 2}; pg8::Epi8<FIn> E{{Z, c32, s32, 1.0f}}; pg8::gemm_phase(lds, g, S, E); }
            if (rep_ == 0 && m1rem != 0 && bx >= m1rem && CTOT > 0) { PH_IDS
                LAS float* tscr = (LAS float*)(lds + wave * 16384); const int tw = (bx - m1rem) * NWAVES + wave;
                for (int b = 0; b < TQ; ++b) {
                    if constexpr (moe) { f32x4 cv_[CQ][8];
#pragma unroll
                        for (int k_ = 0; k_ < CQ; ++k_) { const int it_ = CT_A + (b * CQ + k_) * tailw + tw; moe_load(P, lj, it_ < CTOT ? it_ : CTOT - 1, lane, cv_[k_]); }
#pragma unroll
                        for (int k_ = 0; k_ < CQ; ++k_) { const int it_ = CT_A + (b * CQ + k_) * tailw + tw; if (it_ < CTOT) moe_finish(P, ws, tscr, it_, lane, cv_[k_]); } }
                    else { const int it_ = CT_A + b * tailw + tw; if (it_ < CTOT) w_item(P, ws, tscr, W_EARLY + it_, lane); } } } }
        SEAM(pb + 0);
        if (PHEN(2) && IN(pb + 1)) { PH_IDS
            const PostArgs a{Z, KA, c16, s16, P.in[3] + l * 256, P.in[4] + l * 128, P.in[7] + l * 64, P.in[8] + l * 64};
            const PostGains pg = post_gains(a, lane);
            for (int row = gw; row < M; row += 2 * NGW) { const int row2 = row + NGW; const bool two = row2 < M;
                PostRegs pa, pb; post_load(a, M - 1 - row, lane, pa); if (two) post_load(a, M - 1 - row2, lane, pb);
                post_finish(a, pg, M - 1 - row, lane, pa); if (two) post_finish(a, pg, M - 1 - row2, lane, pb); }
        }
        SEAM(pb + 1);
        if (PHEN(3) && IN(pb + 2)) DUPREP(3) {
            { pg8::Gemm g{Z, Wuq_t, ZP, 256, 256}; pg8::GridOrder S{M / 256, 2, G, bx, ZP, 256, 2}; pg8::Epi8<FUq> E{{QA, c16, s16, 0.10206207261596577f * LOG2E}}; pg8::gemm_phase(lds, g, S, E); }
            { pg8::Gemm g{Z + 256, Wukv_t, ZP, 256, 256}; pg8::GridOrder S{M / 256, 2, G, bx, ZP, 256, 2}; pg8::Epi8<FUkv> E{{KA, VA}}; pg8::gemm_phase(lds, g, S, E); }
        }
        SEAM(pb + 2);
        if (PHEN(4) && IN(pb + 3)) { PH_IDS DUPREP(4) {
            LAS float* cscr = (LAS float*)(lds + ATD_OST + wave * 8448); int cslot = 0;
#define CONV_SLOT() do { if (rep_ == 0 && (cslot == 0 || cslot * CQ * NGW < CT_A)) { \
                if constexpr (moe) { f32x4 cv_[CQ][8]; \
                    _Pragma("unroll") for (int k_ = 0; k_ < CQ; ++k_) { const int it_ = (cslot * CQ + k_) * NGW + gw; moe_load(P, lj, it_ < CT_A ? it_ : (CT_A > 0 ? CT_A - 1 : 0), lane, cv_[k_]); } \
                    _Pragma("unroll") for (int k_ = 0; k_ < CQ; ++k_) { const int it_ = (cslot * CQ + k_) * NGW + gw; if (it_ < CT_A) moe_finish(P, ws, cscr, it_, lane, cv_[k_]); } } \
                else { const int it_ = cslot * NGW + gw; if (it_ < CT_A) w_item(P, ws, cscr, W_EARLY + it_, lane); } \
                if (cslot == 0) { const int gt_ = bx * (NWAVES * 64) + tid, NGT_ = G * NWAVES * 64; const float* pl_ = P.in[1] + (size_t)l * M * 256;        \
                    for (int i_ = gt_; i_ < M * 256 / 8; i_ += NGT_) { const f32x4 a0 = *((const f32x4*)pl_ + 2 * i_), a1 = *((const f32x4*)pl_ + 2 * i_ + 1); const float v_[8] = {a0[0], a0[1], a0[2], a0[3], a1[0], a1[1], a1[2], a1[3]}; *((u32x4*)PBF + i_) = pack8(v_); } } \
                ++cslot; __syncthreads(); } } while (0)
            for (int id = vcu; id < 512; id += G) {
                const int bh = id >> 5, qb = id & 31, b = bh >> 2, h = bh & 3; const size_t r0 = (size_t)b * SEQ;
                AttnDesc d; d.Q = QA + r0 * 384 + h * 96; d.K = KA + r0 * 384 + h * 96; d.V = VA + r0 * 256 + h * 64; d.O = OCAT + r0 * DM + h * 64; d.lse = nullptr;
                d.qs = 384; d.ks = 384; d.vs = 256; d.os = DM; d.lss = 0; d.q0 = qb * 256; d.L = SEQ; d.band = -1; d.m0 = -1e30f; d.l0 = 0.f;
                attn_dense<96>(lds, d); CONV_SLOT(); }
            for (int id = vcu; id < 512; id += G) {
                const int bh = id >> 5, qb = id & 31, b = bh >> 2, h = bh & 3; const size_t r0 = (size_t)b * SEQ;
                AttnDesc d; d.lse = nullptr; d.lss = 0; d.m0 = -1e30f; d.l0 = 0.f;
                d.Q = Z + r0 * ZP + ZC_B + h * 64; d.K = Z + r0 * ZP + ZC_B + 256 + (h >> 1) * 64; d.V = Z + r0 * ZP + ZC_B + 384 + (h >> 1) * 64; d.O = OCAT + r0 * DM + 256 + h * 64;
                d.qs = ZP; d.ks = ZP; d.vs = ZP; d.os = DM; d.q0 = qb * 256; d.L = SEQ; d.band = -1;
                attn_dense<64>(lds, d); CONV_SLOT(); }
            auto mkd = [&](const int id) {
                AttnDesc d; d.lse = nullptr; d.lss = 0; d.m0 = -1e30f; d.l0 = 0.f;
                if (id < 512) { const int bh = id >> 5, qb = id & 31, b = bh >> 2, h = bh & 3; const size_t r0 = (size_t)b * SEQ;
                    d.Q = Z + r0 * ZP + ZC_B + h * 64; d.K = Z + r0 * ZP + ZC_B + 256 + (h >> 1) * 64; d.V = Z + r0 * ZP + ZC_B + 384 + (h >> 1) * 64; d.O = OCAT + r0 * DM + 256 + h * 64;
                    d.qs = ZP; d.ks = ZP; d.vs = ZP; d.os = DM; d.q0 = qb * 256; d.L = SEQ; d.band = -1; }
                else if (id < 2048) { const int cid = id - 512, gi = cid >> 9, rem = cid & 511, b = rem >> 7, h = (rem >> 5) & 3, blk = rem & 31;
                    const int dsh = 2 * gi, dil = 1 << dsh, ls = SEQ >> dsh, bpc = ls >> 8, cls = blk / bpc, ub = blk - cls * bpc; const size_t r0 = (size_t)b * SEQ + cls;
                    const bf16_t* zb = Z + r0 * ZP + ZC_C + gi * 768 + h * 64;
                    d.Q = zb; d.K = zb + 256; d.V = zb + 512; d.O = (bf16_t*)(ws + WS_OCG + gi * OCG_G) + r0 * 256 + h * 64; d.lse = (float*)(ws + WS_LG + gi * LG_G) + r0 * 4 + h;
                    d.qs = dil * ZP; d.ks = dil * ZP; d.vs = dil * ZP; d.os = dil * 256; d.lss = dil * 4; d.q0 = ub * 256; d.L = ls; d.band = 64; }
                else { const int did = id - 2048, bh = did >> 5, qb = did & 31, b = bh >> 2, h = bh & 3; const size_t r0 = (size_t)b * SEQ;
                    d.Q = Z + r0 * ZP + ZC_D + h * 64; d.K = Z + r0 * ZP + ZC_D + 256 + (h >> 1) * 64; d.V = Z + r0 * ZP + ZC_D + 384 + (h >> 1) * 64; d.O = OCAT + r0 * DM + 768 + h * 64;
                    d.qs = ZP; d.ks = ZP; d.vs = ZP; d.os = DM; d.q0 = qb * 256; d.L = SEQ; d.band = 128; d.m0 = P.in[9][l * 4 + h] * LOG2E; d.l0 = 1.f; }
                return d; };
            { bool pre = false; bf16x8 qrs[4];
              for (int id = vcu + 512; id < 2560; id += G) { const bool hn = id + G < 2560; const AttnDesc d = mkd(id), dn = mkd(hn ? id + G : id);
                attn_unit<64>(lds, d, pre, hn, dn, qrs); pre = hn; CONV_SLOT(); } }
            while (rep_ == 0 && (cslot == 0 || cslot * CQ * NGW < CT_A)) CONV_SLOT();
#undef CONV_SLOT
        } }
        SEAM(pb + 3);
        if (PHEN(5) && IN(pb + 4)) { PH_IDS DUPREP(5) {
            for (int row0 = gw; row0 < M; row0 += 4 * NGW) { const int hd = lane >> 4;
                float L[4][3]; u32x2 vr[4][3];
#pragma unroll
                for (int k = 0; k < 4; ++k) { const int row = row0 + k * NGW < M ? row0 + k * NGW : row0;
#pragma unroll
                    for (int g = 0; g < 3; ++g) { L[k][g] = ((const float*)(ws + WS_LG + g * LG_G))[(size_t)row * 4 + hd]; vr[k][g] = *(const u32x2*)((const bf16_t*)(ws + WS_OCG + g * OCG_G) + (size_t)row * 256 + 4 * lane); } }
#pragma unroll
                for (int k = 0; k < 4; ++k) { const int row = row0 + k * NGW; if (row < M) {
                    const float mx = fmaxf(L[k][0], fmaxf(L[k][1], L[k][2])); float w[3], sw = 0.f, o[4] = {0.f, 0.f, 0.f, 0.f};
#pragma unroll
                    for (int g = 0; g < 3; ++g) { w[g] = __builtin_amdgcn_exp2f(L[k][g] - mx); sw += w[g]; }
                    const float inv = 1.0f / sw;
#pragma unroll
                    for (int g = 0; g < 3; ++g) { const float v[4] = {bf_lo(vr[k][g].x), bf_hi(vr[k][g].x), bf_lo(vr[k][g].y), bf_hi(vr[k][g].y)};
#pragma unroll
                        for (int e = 0; e < 4; ++e) o[e] += w[g] * inv * v[e]; }
                    store4(OCAT + (size_t)row * DM + 512 + 4 * lane, o); } } }
        } }
        SEAM(pb + 4);
        if (PHEN(6) && IN(pb + 5)) DUPREP(6) { pg8::Gemm g{OCAT, Wb_t, DM, 256, 256}; pg8::BranchOrder S{G, bx}; pg8::Epi8<FStoreP> E{{PB}}; pg8::gemm_phase(lds, g, S, E); }
        SEAM(pb + 5);
        if (PHEN(7) && IN(pb + 6)) DUPREP(7) {
            if constexpr (gate_fp8(l)) { pg8::Gemm g{(const bf16_t*)(ws + WS_H8), Wg_t, DM, DM, DM}; pg8::GridOrder S{M / 256, 16, G, bx, DM, DM, 1, 1}; pg8::Epi8<FGate> E{{PB, MERGED, 1.0f / 32.0f}}; pg8::gemm_phase<pg8::Epi8<FGate>, pg8::GridOrder, true>(lds, g, S, E); }
            else { pg8::Gemm g{H, Wg_t, DM, DM, DM}; pg8::GridOrder S{M / 256, 16, G, bx, DM, DM, 2}; pg8::Epi8<FGate> E{{PB, MERGED, 1.0f}}; pg8::gemm_phase(lds, g, S, E); } }
        SEAM(pb + 6);
        const bool fuse = (G % 8 == 0);
        if (PHEN(8) && IN(pb + 7)) DUPREP(8) { pg8::Gemm g{MERGED, Wout_t, DM, DM, DM};
            if (fuse && !moe) { pg8::PanelOrder S{G, vcu, DM, DM, 2}; pg8::Epi8<FMixRes<l == 0>> E{{ws, P.in[0], (bf16_t*)P.out, P.in[13] + l * DM, P.in[14] + l * DM, l * 5 + 0}}; pg8::gemm_phase(lds, g, S, E); }
            else { pg8::GridOrder S{M / 256, 4, G, bx, DM, DM, 2}; pg8::Epi8<FStore> E{{MIX, DM}}; pg8::gemm_phase(lds, g, S, E); } }
        SEAM(pb + 7);
        if (PHEN(9) && IN(pb + 8) && !(fuse && !moe)) { PH_IDS
            LAS float* wr_lds = (LAS float*)lds; LAS int* cnt_lds = (LAS int*)(lds + RING_BYTES - 64);
            if (moe) { for (int i = tid; i < DM * NE; i += NWAVES * 64) wr_lds[i] = P.in[19][(size_t)lj * DM * NE + i]; if (tid < NE) cnt_lds[tid] = 0; __syncthreads(); }
            RowsArgs a; a.xb8out = nullptr; a.xin = (l == 0) ? P.in[0] : nullptr; a.xin_bf = (const bf16_t*)P.out; a.xout = nullptr; a.tsrc = MIX; a.y = nullptr; a.tokrow = nullptr; a.gpost = P.in[13] + l * DM;
            a.hout = H2; a.gnext = P.in[14] + l * DM; a.xbout = (bf16_t*)P.out; a.router_b = P.in[20] + lj * NE; a.ti_e = ti_e; a.ti_p0 = ti_p0; a.ti_p1 = ti_p1; a.ti_g0 = ti_g0; a.ti_g1 = ti_g1; a.do_router = moe ? 1 : 0; a.hout8 = nullptr; a.h_fp8 = moe ? 1 : 0;
            DUPREP(9) { if (rep_) { a.xbout = (bf16_t*)(ws + 325 * MiB); a.hout = (bf16_t*)(ws + 325 * MiB); a.do_router = 0; }
            const RowGains rg = rows_gains(a, lane);
            for (int row = gw; row < M; row += 2 * NGW) { const int row2 = row + NGW; const bool two = row2 < M;
                f32x4 xa[4], xb2[4]; float ta[4][4], tb[4][4];
                rows_load(a, row, lane, xa, ta); if (two) rows_load(a, row2, lane, xb2, tb);
                rows_finish(a, rg, row, lane, xa, ta, wr_lds, cnt_lds); if (two) rows_finish(a, rg, row2, lane, xb2, tb, wr_lds, cnt_lds); } }
            if (moe) {
                __syncthreads();
                if (tid < NE) { const int c = cnt_lds[tid]; wgbase[bx * NE + tid] = (int)atomicAdd(ctl + CW_CNT + 64 * tid, (unsigned)c); }
                __syncthreads();
            }
        }
        if (!(fuse && !moe)) SEAM(pb + 8);
        if (!moe) {
            if (PHEN(10) && IN(pb + 9)) DUPREP(10) { pg8::Gemm g{H2, (const bf16_t*)(ws + WS_FGU), DM, DM, DM}; pg8::GridOrder S{M / 256, 2 * DFF / 256, G, bx, DM, DM, 2}; if constexpr (FP8_DENSE_DOWN) { pg8::Epi8<FSilu8> E{{(unsigned char*)HID, DFF, 1.0f}}; pg8::gemm_phase(lds, g, S, E); } else { pg8::Epi8<FSilu> E{{HID, DFF}}; pg8::gemm_phase(lds, g, S, E); } }
            SEAM(pb + 9);
            if (PHEN(11) && IN(pb + 10)) DUPREP(11) {
                { pg8::Gemm g{HID, (const bf16_t*)(ws + WS_FD), DFF, DFF, DFF};
                  constexpr int esz = FP8_DENSE_DOWN ? 1 : 2; constexpr float dsc = FP8_DENSE_DOWN ? 1.0f / 64.0f : 1.0f;
                  if (fuse) { pg8::PanelOrder S{G, vcu, DFF, DFF, esz}; pg8::Epi8<FFfnRes> E{{ws, (const bf16_t*)P.out, P.in[15] + l * DM, l * 5 + 2, dsc}}; pg8::gemm_phase<pg8::Epi8<FFfnRes>, pg8::PanelOrder, FP8_DENSE_DOWN>(lds, g, S, E); }
                  else { pg8::GridOrder S{M / 256, 4, G, bx, DFF, DFF, esz}; pg8::Epi8<FStoreS> E{{FB, DM, dsc}}; pg8::gemm_phase<pg8::Epi8<FStoreS>, pg8::GridOrder, FP8_DENSE_DOWN>(lds, g, S, E); } }
                { pg8::Gemm g{PBF, Wp_t, 256, 256, 256}; pg8::GridOrder S{M / 256, 4, G, bx, 256, 256, 2}; pg8::Epi8<FStore> E{{PP, DM}}; pg8::gemm_phase(lds, g, S, E); }
            }
            SEAM(pb + 10);
        } else {
            int tend[NE]; { int acc = 0;
#pragma unroll
                for (int e = 0; e < NE; ++e) { acc += (__builtin_amdgcn_readfirstlane((int)__hip_atomic_load(ctl + CW_CNT + 64 * e, __ATOMIC_RELAXED, __HIP_MEMORY_SCOPE_AGENT)) + 255) >> 8; tend[e] = acc; } }
            const int NT = tend[NE - 1];
            for (int c = 0; c < MOE_NCH; ++c) {
                int nT = (c == 0) ? (NT < MOE_C0 ? NT : MOE_C0) : NT - MOE_C0; nT = nT > MOE_CH ? MOE_CH : (nT < 0 ? 0 : nT);
                if (c == 0) {
                    if (PHEN(13) && IN(pb + 10 + 3 * c)) { PH_IDS
                        for (int tok = bx * (NWAVES * 64) + tid; tok < M; tok += G * (NWAVES * 64)) { const int info = ti_e[tok], e0 = info & 255, e1 = (info >> 8) & 255, wg = info >> 16; int s0 = 0, s1 = 0;
#pragma unroll
                            for (int j = 0; j < NE - 1; ++j) { if (e0 > j) s0 = tend[j] * 256; if (e1 > j) s1 = tend[j] * 256; }
                            const int r0 = s0 + wgbase[wg * NE + e0] + ti_p0[tok], r1 = s1 + wgbase[wg * NE + e1] + ti_p1[tok];
                            rowg[r0] = ti_g0[tok]; rowg[r1] = ti_g1[tok]; tokrow[2 * tok] = r0; tokrow[2 * tok + 1] = r1; rowtok[r0] = tok; rowtok[r1] = tok; }
                    }
                    SEAM(pb + 10 + 3 * c);
                }
                if (PHEN(14) && IN(pb + 11 + 3 * c)) DUPREP(14) {
                    pg8::Gemm g{H2, (const bf16_t*)((unsigned char*)P.out + MOEW_GU), DM, DM, DM, rowtok}; pg8::MoeOrder S; S.nT = nT; S.tile0 = c * MOE_C0; S.nN = 2 * MFF / 256; S.G = G; S.c = bx; S.lda = DM; S.ldb = DM; S.esz = 1; S.estride = (long)MGU_E;
                    S.esplit = MOE_ESPLIT; S.edelta = (long)((ws + WS_MGU_HI) - ((unsigned char*)P.out + MOEW_GU + (size_t)MOE_ESPLIT * MGU_E));
#pragma unroll
                    for (int e = 0; e < NE; ++e) S.tend[e] = tend[e];
                    pg8::Epi8<FSilu8> E{{(unsigned char*)HIDC, MFF, 1.0f / 32.0f}}; pg8::gemm_phase<pg8::Epi8<FSilu8>, pg8::MoeOrder, true, true>(lds, g, S, E);
                }
                SEAM(pb + 11 + 3 * c);
                if (PHEN(15) && IN(pb + 12 + 3 * c)) DUPREP(15) {
                    { pg8::Gemm g{HIDC, (const bf16_t*)((unsigned char*)P.out + MOEW_MD), MFF, MFF, MFF}; pg8::MoeOrder S; S.nT = nT; S.tile0 = c * MOE_C0; S.nN = 4; S.G = G; S.c = bx; S.lda = MFF; S.ldb = MFF; S.esz = 1; S.estride = (long)MD_E; S.rev = 1;
#pragma unroll
                      for (int e = 0; e < NE; ++e) S.tend[e] = tend[e];
                      pg8::Epi8<FRowScale> E{{Y, rowg, 1.0f / 64.0f}}; pg8::gemm_phase<pg8::Epi8<FRowScale>, pg8::MoeOrder, true>(lds, g, S, E); }
                    if (c == MOE_NCH - 1) {
                        int nskip = (nT * 4) % G; if (nskip > G / 4) nskip = 0;
                        if (bx >= nskip) { pg8::Gemm g{PBF, Wp_t, 256, 256, 256}; pg8::GridOrder S{M / 256, 4, G - nskip, bx - nskip, 256, 256, 2}; pg8::Epi8<FStore> E{{PP, DM}}; pg8::gemm_phase(lds, g, S, E); } }
                }
                SEAM(pb + 12 + 3 * c);
            }
        }
        if (PHEN(16) && IN(pb + 22) && !(fuse && !moe)) { PH_IDS
            RowsArgs a; a.xb8out = FP8_PLE ? ws + (moe ? WS_XB8_MOE : WS_XB8_DENSE) : nullptr; a.xin = nullptr; a.xin_bf = (const bf16_t*)P.out; a.xout = nullptr; a.tsrc = FB; a.y = moe ? Y : nullptr; a.tokrow = tokrow; a.gpost = P.in[15] + l * DM;
            a.hout = nullptr; a.gnext = nullptr; a.xbout = XB; a.router_b = nullptr; a.ti_e = nullptr; a.ti_p0 = nullptr; a.ti_p1 = nullptr; a.ti_g0 = nullptr; a.ti_g1 = nullptr; a.do_router = 0; a.h_fp8 = 0; a.hout8 = nullptr;
            DUPREP(16) { if (rep_) { a.xbout = (bf16_t*)(ws + 157 * MiB); }
            const RowGains rg = rows_gains(a, lane);
            for (int row = gw; row < M; row += 2 * NGW) { const int row2 = row + NGW; const bool two = row2 < M;
                f32x4 xa[4], xb2[4]; float ta[4][4], tb[4][4];
                rows_load(a, row, lane, xa, ta); if (two) rows_load(a, row2, lane, xb2, tb);
                rows_finish(a, rg, row, lane, xa, ta, (LAS float*)lds, (LAS int*)lds); if (two) rows_finish(a, rg, row2, lane, xb2, tb, (LAS float*)lds, (LAS int*)lds); } }
        }
        if (!(fuse && !moe)) SEAM(pb + 22);
        if (PHEN(17) && IN(pb + 23)) {
            pg8::Gemm g{FP8_PLE ? (const bf16_t*)(ws + (moe ? WS_XB8_MOE : WS_XB8_DENSE)) : XB, Wpg_t, DM, DM, DM}; constexpr int esz = FP8_PLE ? 1 : 2; constexpr float gsc = FP8_PLE ? 1.0f / 32.0f : 1.0f;
            if (fuse && l + 1 == DEPTH) { pg8::PanelOrder S{G, vcu, DM, DM, esz}; pg8::Epi8<FPleOut> E{{ws, P.in[26] + l * DM, P.out, l * 5 + 3, gsc}}; pg8::gemm_phase<pg8::Epi8<FPleOut>, pg8::PanelOrder, FP8_PLE>(lds, g, S, E); }
            else if (fuse) { constexpr bool h8only = (l + 1 == FP8_IN_LAYER) && gate_fp8(l + 1);
                using EP = pg8::Epi8<FPleRes<!h8only, (l + 1 == FP8_IN_LAYER) || gate_fp8(l + 1)>>;
                pg8::PanelOrder S{G, vcu, DM, DM, esz}; EP E{{ws, (bf16_t*)P.out, P.in[26] + l * DM, P.in[12] + (l + 1 < DEPTH ? l + 1 : l) * DM, l * 5 + 3, gsc}}; pg8::gemm_phase<EP, pg8::PanelOrder, FP8_PLE>(lds, g, S, E); }
            else { pg8::GridOrder S{M / 256, 4, G, bx, DM, DM, esz}; pg8::Epi8<FPle> E{{PP, gsc}}; pg8::gemm_phase<pg8::Epi8<FPle>, pg8::GridOrder, FP8_PLE>(lds, g, S, E); } }
        if (!fuse) SEAM(pb + 23);
        if (PHEN(18) && IN(pb + 24) && !fuse) { PH_IDS
            const bool more = (l + 1 < DEPTH);
            RowsArgs a; a.xb8out = nullptr; a.xin = nullptr; a.xin_bf = XB; a.xout = more ? nullptr : P.out; a.tsrc = PP; a.y = nullptr; a.tokrow = nullptr; a.gpost = P.in[26] + l * DM;
            a.hout = more ? H : nullptr; a.gnext = more ? P.in[12] + (l + 1) * DM : nullptr; a.xbout = more ? (bf16_t*)P.out : nullptr; a.router_b = nullptr; a.ti_e = nullptr; a.ti_p0 = nullptr; a.ti_p1 = nullptr; a.ti_g0 = nullptr; a.ti_g1 = nullptr; a.do_router = 0; a.h_fp8 = 0; a.hout8 = (more && l + 1 == FP8_IN_LAYER) ? ws + WS_H8 : nullptr;
            DUPREP(18) { if (rep_) { if (a.xbout) a.xbout = (bf16_t*)(ws + 157 * MiB); if (a.hout) a.hout = (bf16_t*)(ws + 157 * MiB); if (a.xout) a.xout = (float*)(ws + 157 * MiB); }
            const RowGains rg = rows_gains(a, lane);
            for (int row = gw; row < M; row += 2 * NGW) { const int row2 = row + NGW; const bool two = row2 < M;
                f32x4 xa[4], xb2[4]; float ta[4][4], tb[4][4];
                rows_load(a, row, lane, xa, ta); if (two) rows_load(a, row2, lane, xb2, tb);
                rows_finish(a, rg, row, lane, xa, ta, (LAS float*)lds, (LAS int*)lds); if (two) rows_finish(a, rg, row2, lane, xb2, tb, (LAS float*)lds, (LAS int*)lds); } }
        }
        if (l + 1 < DEPTH) SEAM(pb + 24);
    }

__global__ void __launch_bounds__(NWAVES * 64, 2) fwd_kernel(Params P) {
    extern __shared__ __attribute__((aligned(16))) unsigned char lds_raw[];
    LAS unsigned char* lds = (LAS unsigned char*)lds_raw;
    volatile LAS unsigned* MISC = (volatile LAS unsigned*)(lds + MISC_OFF);
    const int tid0 = threadIdx.x;
    const int G = gridDim.x, bx = blockIdx.x;
    const int vcu = (G % 8 == 0) ? (bx % 8) * (G / 8) + bx / 8 : bx;
    const int NGW = G * NWAVES;
    unsigned char* ws = P.ws;
    unsigned* ctl = (unsigned*)(ws + WS_CTL);
    for (int u = tid0; u < (LDS_BYTES - LDSCTL_OFF) / 4; u += NWAVES * 64) ((LAS unsigned*)(lds + LDSCTL_OFF))[u] = 0u;
    __syncthreads();
    XcdBarrier bar; bar.bar = ctl + CW_BAR; bar.x = 0; bar.st = nullptr;
    if (!MK_PER_PHASE) bar = xcd_barrier_post(ctl + CW_BAR, MISC + 8);
    const int lo = P.ph_lo, hi = P.ph_hi;

    const float* c16 = (const float*)(ws + WS_COS16); const float* s16 = (const float*)(ws + WS_SIN16);
    const float* c32 = (const float*)(ws + WS_COS32); const float* s32 = (const float*)(ws + WS_SIN32);
    bf16_t* const H = (bf16_t*)(ws + WS_H); bf16_t* const Z = (bf16_t*)(ws + WS_Z);
    bf16_t* const QA = (bf16_t*)(ws + WS_QA); bf16_t* const KA = (bf16_t*)(ws + WS_KA); bf16_t* const VA = (bf16_t*)(ws + WS_VA);
    bf16_t* const OCAT = (bf16_t*)(ws + WS_OCAT);
    bf16_t* const PB = (bf16_t*)(ws + WS_PB); bf16_t* const MERGED = (bf16_t*)(ws + WS_MERGED); bf16_t* const MIX = (bf16_t*)(ws + WS_MIX); bf16_t* const H2 = (bf16_t*)(ws + WS_H2);
    bf16_t* const HID = (bf16_t*)(ws + WS_HID); bf16_t* const FB = (bf16_t*)(ws + WS_FB); bf16_t* const XB = (bf16_t*)(ws + WS_XB); bf16_t* const PP = (bf16_t*)(ws + WS_PP);
    bf16_t* const PBF = (bf16_t*)(ws + WS_PBF);
    bf16_t* const MGU = (bf16_t*)(ws + WS_MGU); bf16_t* const MD = (bf16_t*)(ws + WS_MD); bf16_t* const Y = (bf16_t*)(ws + WS_Y); bf16_t* const XG = (bf16_t*)(ws + WS_XG); bf16_t* const HIDC = (bf16_t*)(ws + WS_HIDC);
    int* const rowtok = (int*)(ws + WS_ROWTOK); int* const tokrow = (int*)(ws + WS_TOKROW); float* const rowg = (float*)(ws + WS_ROWG); int* const wgbase = (int*)(ws + WS_WGBASE);
    int* const ti_e = (int*)(ws + WS_TI_E); int* const ti_p0 = (int*)(ws + WS_TI_P0); int* const ti_p1 = (int*)(ws + WS_TI_P1); float* const ti_g0 = (float*)(ws + WS_TI_G0); float* const ti_g1 = (float*)(ws + WS_TI_G1);

    if (PHEN(0) && IN(0)) DUPREP(0) { PH_IDS
        LAS float* scr = (LAS float*)(lds + wave * 16384);
        for (int it = gw; it < W_EARLY; it += NGW) w_item(P, ws, scr, it, lane);
        const int gt = bx * (NWAVES * 64) + tid, NGT = G * NWAVES * 64; const u32x4 z4 = {0u, 0u, 0u, 0u};
        for (int i = gt; i < 2 * 96 * 128; i += NGT) { const int l = i / (96 * 128), j = i - l * (96 * 128); if (l == FP8_IN_LAYER) { if (j < 96 * 64) *((u32x4*)(ws + WS_WIN + l * WIN_L + (size_t)ZN * DM) + j) = z4; } else *((u32x4*)(ws + WS_WIN + l * WIN_L + (size_t)ZN * DM * 2) + j) = z4; }
        for (int i = gt; i < 2 * 128 * 32; i += NGT) { const int l = i / (128 * 32), j = i - l * (128 * 32); *((u32x4*)(ws + WS_WUQ + l * WUQ_L + (size_t)384 * 256 * 2) + j) = z4; }
        for (int i = gt; i < 2 * 512 * 16; i += NGT) { const int l = i / (512 * 16), j = i - l * (512 * 16), row = j >> 4, ch = j & 15; *((u32x4*)(ws + WS_WUKV + l * WUKV_L + (size_t)row * 512 + 256) + ch) = z4; }
        for (int i = gt; i < SEQ * 48; i += NGT) {
            const int pos = i / 48, q = i - pos * 48; const bool t16 = q < 16; const int fi = t16 ? q : q - 16;
            const float inv = __builtin_amdgcn_exp2f(-(float)fi * (t16 ? (1.0f / 16.0f) : (1.0f / 32.0f)) * 13.287712379549449f);
            const float ang = (float)pos * inv; const double rev = (double)ang * 0.15915494309189535; const float fr = (float)(rev - __builtin_rint(rev));
            const float cs = __builtin_amdgcn_cosf(fr), sn = __builtin_amdgcn_sinf(fr);
            if (t16) { ((float*)(ws + WS_COS16))[pos * 16 + fi] = cs; ((float*)(ws + WS_SIN16))[pos * 16 + fi] = sn; }
            else { ((float*)(ws + WS_COS32))[pos * 32 + fi] = cs; ((float*)(ws + WS_SIN32))[pos * 32 + fi] = sn; } }
        f32x4 g0_[4];
#pragma unroll
        for (int j = 0; j < 4; ++j) g0_[j] = *((const f32x4*)P.in[12] + 64 * j + lane);
        for (int row0 = gw; row0 < M; row0 += 4 * NGW) {
            f32x4 v[4][4];
#pragma unroll
            for (int k = 0; k < 4; ++k) { const int row = row0 + k * NGW < M ? row0 + k * NGW : row0; const f32x4* xr = (const f32x4*)(P.in[0] + (size_t)row * DM) + lane;
#pragma unroll
                for (int j = 0; j < 4; ++j) v[k][j] = xr[64 * j]; }
#pragma unroll
            for (int k = 0; k < 4; ++k) { const int row = row0 + k * NGW; if (row < M) { float ss = 0.f;
#pragma unroll
                for (int j = 0; j < 4; ++j) ss += (v[k][j][0] * v[k][j][0] + v[k][j][1] * v[k][j][1]) + (v[k][j][2] * v[k][j][2] + v[k][j][3] * v[k][j][3]);
                const float rs = rsqrtf(wave_sum(ss) * (1.0f / DM) + NORM_EPS);
#pragma unroll
                for (int j = 0; j < 4; ++j) { const f32x4 g = g0_[j]; const float o[4] = {v[k][j][0] * rs * g[0], v[k][j][1] * rs * g[1], v[k][j][2] * rs * g[2], v[k][j][3] * rs * g[3]};
                    store4(H + (size_t)row * DM + 256 * j + 4 * lane, o);
                    if (FP8_GATE0) *(unsigned*)(ws + WS_H8 + (size_t)row * DM + 256 * j + 4 * lane) = cvt4_fp8(o[0], o[1], o[2], o[3]); } } } }
    }
    SEAM(0);

    layer_body<0>(P, lds, bar, lo, hi, G, bx, vcu, NGW, ws, ctl);
    layer_body<1>(P, lds, bar, lo, hi, G, bx, vcu, NGW, ws, ctl);
#undef IN
#undef SEAM
}

extern "C" void kernel_launch(void* const* d_in, const int* in_sizes, int n_in, void* d_out, int out_size, void* d_ws, size_t ws_size, hipStream_t stream) {
    static int grid = 0;
    if (grid == 0) {
        if (n_in != 27 || out_size != M * DM || ws_size < WS_END) { fprintf(stderr, "kernel_launch: unexpected shapes (n_in %d, out %d, ws %zu < %zu)\n", n_in, out_size, ws_size, (size_t)WS_END); grid = -1; return; }
        int dev = 0, cus = 0, per_cu = 0;
        if (hipGetDevice(&dev) != hipSuccess || hipDeviceGetAttribute(&cus, hipDeviceAttributeMultiprocessorCount, dev) != hipSuccess) { grid = -1; return; }
        if (hipFuncSetAttribute((const void*)fwd_kernel, hipFuncAttributeMaxDynamicSharedMemorySize, LDS_BYTES) != hipSuccess) { fprintf(stderr, "kernel_launch: hipFuncSetAttribute failed\n"); grid = -1; return; }
        if (hipOccupancyMaxActiveBlocksPerMultiprocessor(&per_cu, (const void*)fwd_kernel, NWAVES * 64, LDS_BYTES) != hipSuccess || per_cu < 1) { fprintf(stderr, "kernel_launch: occupancy query says %d\n", per_cu); per_cu = 1; }
        (void)hipGetLastError();
        grid = cus;
    }
    if (grid < 0) return;
    (void)hipMemsetAsync((char*)d_ws + WS_CTL, 0, CTL_ZERO_BYTES, stream);
    Params p{};
    for (int i = 0; i < 27; ++i) p.in[i] = (const float*)d_in[i];
    p.out = (float*)d_out; p.ws = (unsigned char*)d_ws;
#if MK_PER_PHASE
    for (int k = 0; k < N_PHASES; ++k) { p.ph_lo = k; p.ph_hi = k + 1; hipLaunchKernelGGL(fwd_kernel, dim3(grid), dim3(NWAVES * 64), LDS_BYTES, stream, p); }
#else
    p.ph_lo = 0; p.ph_hi = N_PHASES;
    hipLaunchKernelGGL(fwd_kernel, dim3(grid), dim3(NWAVES * 64), LDS_BYTES, stream, p);
#endif
}
```

```cpp
#include <hip/hip_runtime.h>
#include <cstdio>
#include <cstdint>
#include <type_traits>

#define LAS __attribute__((address_space(3)))
#define GAS __attribute__((address_space(1)))
typedef unsigned short bf16_t;
typedef short bf16x8 __attribute__((ext_vector_type(8)));
typedef short s16x4 __attribute__((ext_vector_type(4)));
typedef float f32x4 __attribute__((ext_vector_type(4)));
typedef float f32x16 __attribute__((ext_vector_type(16)));
typedef unsigned u32x4 __attribute__((ext_vector_type(4)));
typedef unsigned u32x2 __attribute__((ext_vector_type(2)));

#ifndef PHMASK
#define PHMASK 0xFFFFFFFFu
#endif
#define PHEN(i) (((PHMASK) >> (i)) & 1u)
#ifndef DUPMASK
#define DUPMASK 0u
#endif
#define DUPREP(i) for (int rep_ = 0; rep_ < 1 + (int)(((DUPMASK) >> (i)) & 1u); ++rep_)
#ifndef MK_PER_PHASE
#define MK_PER_PHASE 0
#endif

constexpr int DM = 1024, BATCH = 4, SEQ = 8192, DEPTH = 2, M = BATCH * SEQ;
constexpr int ZP = 3840;
constexpr int ZC_B = 416, ZC_C = 928, ZC_D = 3232, ZN = 3744, IN_COLS = 7840;
constexpr int DFF = 4096, MFF = 3584, NE = 8;
constexpr float NORM_EPS = 1e-6f;
constexpr float LOG2E = 1.4426950408889634f;
constexpr int MOE_MAXT = 264;
constexpr int MOE_C0 = MOE_MAXT, MOE_CH = MOE_MAXT, MOE_NCH = 1;

constexpr size_t MiB = 1u << 20;
constexpr size_t WS_CTL = 0, CTL_ZERO_BYTES = 2 * MiB;
constexpr size_t WS_ROWTOK = 1 * MiB;
constexpr size_t WS_COS16 = 2 * MiB, WS_SIN16 = WS_COS16 + 512 * 1024, WS_COS32 = 3 * MiB, WS_SIN32 = 4 * MiB;
constexpr size_t WS_TI_E = 5 * MiB, WS_TI_P0 = WS_TI_E + 128 * 1024, WS_TI_P1 = WS_TI_P0 + 128 * 1024, WS_TI_G0 = WS_TI_P1 + 128 * 1024, WS_TI_G1 = WS_TI_G0 + 128 * 1024;
constexpr size_t WS_TOKROW = 6 * MiB, WS_ROWG = WS_TOKROW + 256 * 1024, WS_WGBASE = 7 * MiB;
constexpr size_t WS_WIN = 8 * MiB, WIN_L = (size_t)ZP * DM * 2;
constexpr size_t WS_WG = 23 * MiB, WG_L = 8 * MiB;
constexpr size_t WS_WB = 39 * MiB, WB_L = 2 * MiB;
constexpr size_t WS_WOUT = 43 * MiB, WOUT_L = 2 * MiB;
constexpr size_t WS_WPG = 47 * MiB, WPG_L = 2 * MiB;
constexpr size_t WS_WP = 51 * MiB, WP_L = 512 * 1024;
constexpr size_t WS_WUQ = 52 * MiB, WUQ_L = 256 * 1024;
constexpr size_t WS_WUKV = WS_WUQ + 512 * 1024, WUKV_L = 256 * 1024;
constexpr size_t WS_FGU = 53 * MiB, WS_FD = 69 * MiB;
constexpr size_t WS_PBF = 77 * MiB;
constexpr size_t A0 = 93 * MiB;
constexpr size_t WS_H = A0, WS_Z = 157 * MiB, WS_QA = 397 * MiB, WS_KA = 421 * MiB, WS_VA = 445 * MiB, WS_OCAT = 461 * MiB, WS_OCG = 525 * MiB, OCG_G = 16 * MiB, WS_LG = 573 * MiB, LG_G = 512 * 1024;
constexpr size_t WS_H8 = 600 * MiB;
constexpr int FP8_GATE_LAYER = 1;
constexpr bool FP8_PLE = true;
constexpr size_t WS_XB8_DENSE = 397 * MiB, WS_XB8_MOE = 157 * MiB;
constexpr bool FP8_DENSE_DOWN = true;
constexpr bool FP8_GATE0 = true;
__host__ __device__ constexpr bool gate_fp8(int l) { return l == FP8_GATE_LAYER || (l == 0 && FP8_GATE0); }
constexpr int FP8_IN_LAYER = 1;
constexpr size_t WS_PB = 157 * MiB, WS_MERGED = 525 * MiB, WS_MIX = A0, WS_H2 = 461 * MiB;
constexpr size_t WS_HID = 157 * MiB, WS_FB = 525 * MiB, WS_XB = A0, WS_PP = 461 * MiB;
constexpr size_t WS_MGU = 157 * MiB, MGU_E = 7 * MiB, WS_MD = 269 * MiB, MD_E = 7 * MiB / 2, WS_Y = 325 * MiB, WS_XG = A0, WS_HIDC = A0;
constexpr size_t OUT_HALF = (size_t)M * DM * 2;
constexpr size_t MOEW_MD = OUT_HALF, MOEW_GU = OUT_HALF + 8 * MD_E, WS_MGU_HI = WS_FGU;
constexpr int MOE_ESPLIT = 5;
static_assert(MOEW_GU + MOE_ESPLIT * MGU_E <= 2 * OUT_HALF && WS_MGU_HI + (NE - MOE_ESPLIT) * MGU_E <= WS_PBF, "expert weight copies");
constexpr size_t WS_XSLOT = 644 * MiB, XSLOT_B = 2 * MiB;
constexpr size_t WS_END = 648 * MiB;
static_assert(WS_HIDC + (size_t)MOE_CH * 256 * MFF <= WS_Y, "hidden (fp8)");
static_assert(WS_Y + (size_t)MOE_MAXT * 256 * DM * 2 <= WS_H2, "y");
constexpr int CW_CNT = 64;
constexpr int CW_BAR = 4096;
constexpr int CW_PANEL = 16384;

__device__ __forceinline__ unsigned cvt_pk_bf16(float lo, float hi) { unsigned r; asm volatile("v_cvt_pk_bf16_f32 %0, %1, %2" : "=v"(r) : "v"(lo), "v"(hi)); return r; }
__device__ __forceinline__ float bf_lo(unsigned u) { return __uint_as_float(u << 16); }
__device__ __forceinline__ float bf_hi(unsigned u) { return __uint_as_float(u & 0xffff0000u); }
__device__ __forceinline__ u32x4 pack8(const float (&v)[8]) { u32x4 w; w.x = cvt_pk_bf16(v[0], v[1]); w.y = cvt_pk_bf16(v[2], v[3]); w.z = cvt_pk_bf16(v[4], v[5]); w.w = cvt_pk_bf16(v[6], v[7]); return w; }
__device__ __forceinline__ void unpack8(const u32x4 w, float (&v)[8]) { v[0] = bf_lo(w.x); v[1] = bf_hi(w.x); v[2] = bf_lo(w.y); v[3] = bf_hi(w.y); v[4] = bf_lo(w.z); v[5] = bf_hi(w.z); v[6] = bf_lo(w.w); v[7] = bf_hi(w.w); }
__device__ __forceinline__ float sigmoidf_(float x) { return __builtin_amdgcn_rcpf(1.0f + __builtin_amdgcn_exp2f(-x * LOG2E)); }
__device__ __forceinline__ float wave_sum(float v) {
#pragma unroll
    for (int o = 1; o < 64; o <<= 1) v += __shfl_xor(v, o);
    return v;
}
__device__ __forceinline__ unsigned cvt4_fp8(float a, float b, float c, float d) { int w = 0; w = __builtin_amdgcn_cvt_pk_fp8_f32(a, b, w, false); w = __builtin_amdgcn_cvt_pk_fp8_f32(c, d, w, true); return (unsigned)w; }
#define LDS_WAIT() asm volatile("s_waitcnt lgkmcnt(0)" ::: "memory")
#define VM_WAIT() asm volatile("s_waitcnt vmcnt(0)" ::: "memory")

#define XB_TMO      128
#define XB_XCNT(j)  (256  + 64 * (j))
#define XB_XSUB(j)  (1280 + 64 * (j))
#define XB_XGEN(j)  (2304 + 64 * (j))
#define XB_TOP      3328
#define XB_TOPGEN   3392
#define XCD_BAR_WORDS 3456
#define XB_SPIN_CAP (1u << 18)
__device__ __forceinline__ unsigned xb_ld(unsigned* p)              { return __hip_atomic_load(p, __ATOMIC_RELAXED, __HIP_MEMORY_SCOPE_AGENT); }
__device__ __forceinline__ unsigned xb_add(unsigned* p, unsigned v) { return __hip_atomic_fetch_add(p, v, __ATOMIC_RELAXED, __HIP_MEMORY_SCOPE_AGENT); }
__device__ __forceinline__ unsigned xb_xcc_id() { return (unsigned)__builtin_amdgcn_s_getreg((3 << 11) | 20) & 0xFu; }
#define XB_SPIN(cond, bar) do { unsigned _sp = 0; while (cond) { __builtin_amdgcn_s_sleep(1); \
    if ((++_sp & 255u) == 0u) { if (xb_ld(&(bar)[XB_TMO])) break; if (_sp > XB_SPIN_CAP) { atomicAdd(&(bar)[XB_TMO], 1u); break; } } } } while (0)
struct XcdBarrier { unsigned* bar; unsigned x; volatile LAS unsigned* st; };
__device__ __forceinline__ XcdBarrier xcd_barrier_post(unsigned* bar, volatile LAS unsigned* st) {
    XcdBarrier b; b.bar = bar; b.x = xb_xcc_id(); b.st = st;
    if (threadIdx.x == 0) (void)xb_add(&bar[XB_XCNT(b.x)], 1u);
    return b;
}
__device__ __forceinline__ void xcd_barrier_complete(unsigned* bar, unsigned x, unsigned& nloc, unsigned& nx) {
    const unsigned G = gridDim.x * gridDim.y * gridDim.z;
    unsigned sum, cnt, mine, sp = 0u;
    for (;;) {
        sum = 0u; cnt = 0u; mine = 0u;
#pragma unroll
        for (unsigned j = 0; j < 16; ++j) { const unsigned c = xb_ld(&bar[XB_XCNT(j)]); sum += c; cnt += (c > 0u) ? 1u : 0u; mine = (j == x) ? c : mine; }
        if (sum == G) break;
        __builtin_amdgcn_s_sleep(1);
        if ((++sp & 255u) == 0u) { if (xb_ld(&bar[XB_TMO])) break; if (sp > XB_SPIN_CAP) { atomicAdd(&bar[XB_TMO], 1u); break; } }
    }
    nloc = mine > 0u ? mine : 1u; nx = cnt > 0u ? cnt : 1u;
}
__device__ __forceinline__ void xcd_barrier(const XcdBarrier& b) {
    asm volatile("s_waitcnt vmcnt(0)" ::: "memory");
    __syncthreads();
    if (threadIdx.x == 0) {
        unsigned* bar = b.bar;
        __builtin_amdgcn_s_waitcnt(0);
        unsigned nloc = b.st[0], nx = b.st[1];
        if (nloc == 0u) { xcd_barrier_complete(bar, b.x, nloc, nx); b.st[0] = nloc; b.st[1] = nx; }
        const unsigned old = xb_add(&bar[XB_XSUB(b.x)], 1u);
        const unsigned gen = old / nloc;
        if (old + 1u == (gen + 1u) * nloc) {
            __builtin_amdgcn_fence(__ATOMIC_RELEASE, "agent");
            asm volatile("s_waitcnt vmcnt(0)" ::: "memory");
            const unsigned og = xb_add(&bar[XB_TOP], 1u);
            const unsigned tg = og / nx;
            if (og + 1u == (tg + 1u) * nx) xb_add(&bar[XB_TOPGEN], 1u);
            else XB_SPIN(xb_ld(&bar[XB_TOPGEN]) == tg, bar);
            __builtin_amdgcn_fence(__ATOMIC_ACQUIRE, "agent");
            xb_add(&bar[XB_XGEN(b.x)], 1u);
            asm volatile("s_waitcnt vmcnt(0)" ::: "memory");
        } else {
            XB_SPIN(xb_ld(&bar[XB_XGEN(b.x)]) == gen, bar);
            __builtin_amdgcn_fence(__ATOMIC_ACQUIRE, "agent");
            asm volatile("s_waitcnt vmcnt(0)" ::: "memory");
        }
    }
    __syncthreads();
}

namespace pg8 {
constexpr int BM = 256, BK = 64, HALF = 128, HTB = HALF * BK * 2, STAGE_BYTES = 8 * HTB, NXCD = 8, WGM = 8;
__host__ __device__ __forceinline__ int lds_byte(int r, int c) { const int st = (r >> 4) * 2 + (c >> 5), rr = r & 15, cc = c & 31, ob = rr * 64 + cc * 2; return st * 1024 + (ob ^ (((ob >> 9) & 1) << 5)); }
__host__ __device__ __forceinline__ void stage_rc(int b, int& R, int& C) { const int st = b / 1024, sb = b % 1024, swz = sb ^ (((sb >> 9) & 1) << 5); R = (st >> 1) * 16 + swz / 64; C = (st & 1) * 32 + (swz % 64) / 2; }
__host__ __device__ __forceinline__ int perm32(int rho) { const int n = rho >> 4, i = rho & 15; return 8 * (i >> 2) + 4 * n + (i & 3); }

struct Unit { int pm, pn, aux; long aoff, boff; };
struct Gemm { const bf16_t* A; const bf16_t* Bt; int lda, ldb, K; const int* rowtok = nullptr; };

__device__ __forceinline__ bool grid_map(long L, int nM, int nN, int& pm, int& pn) {
    const int nwg = nM * nN; if (L >= nwg) return false;
    int wgid = (int)L; { const int q = nwg / NXCD, r = nwg % NXCD, xcd = wgid % NXCD, off = wgid / NXCD; wgid = (xcd < r ? xcd * (q + 1) : r * (q + 1) + (xcd - r) * q) + off; }
    const int nig = WGM * nN, gid = wgid / nig, fm = gid * WGM, gsz = (nM - fm) < WGM ? (nM - fm) : WGM;
    pm = fm + ((wgid % nig) % gsz); pn = (wgid % nig) / gsz; return true;
}
struct GridOrder {
    int nM, nN, G, c, lda, ldb, esz; int rev = 0;
    __device__ __forceinline__ bool next(int i, Unit& u) const {
        if (!grid_map((long)i * G + c, nM, nN, u.pm, u.pn)) return false;
        if (rev) u.pm = nM - 1 - u.pm;
        u.aux = 0; u.aoff = (long)u.pm * BM * lda * esz; u.boff = (long)u.pn * BM * ldb * esz; return true; }
};
struct BranchOrder {
    int G, c;
    __device__ __forceinline__ bool next(int i, Unit& u) const {
        if (!grid_map((long)i * G + c, M / BM, 16, u.pm, u.pn)) return false;
        u.aux = 0; u.aoff = (long)u.pm * BM * DM * 2 + (long)(u.pn >> 2) * 512; u.boff = (long)u.pn * BM * 256 * 2; return true; }
};
struct GateOrder {
    int G, c;
    __device__ __forceinline__ bool next(int i, Unit& u) const {
        int pc; if (!grid_map((long)(i >> 2) * G + c, M / BM, 4, u.pm, pc)) return false;
        u.pn = (i & 3) * 4 + pc; u.aux = 0; u.aoff = (long)u.pm * BM * DM * 2; u.boff = (long)u.pn * BM * DM * 2; return true; }
};
struct PanelOrder {
    int G, vcu, lda, ldb, esz;
    __device__ __forceinline__ bool next(int i, Unit& u) const {
        const int per = G >> 2, pm = i * per + (vcu >> 2); if ((vcu >> 2) >= per || pm >= M / BM) return false;
        u.pm = pm; u.pn = vcu & 3; u.aux = 0; u.aoff = (long)pm * BM * lda * esz; u.boff = (long)u.pn * BM * ldb * esz; return true; }
};
struct MoeOrder {
    int nT, tile0, nN, G, c, lda, ldb, esz; long estride; int tend[NE]; int esplit = NE; long edelta = 0; int rev = 0;
    __device__ __forceinline__ bool next(int i, Unit& u) const {
        if (!grid_map((long)i * G + c, nT, nN, u.pm, u.pn)) return false;
        if (rev) u.pm = nT - 1 - u.pm;
        const int tile = tile0 + u.pm; int e = 0;
#pragma unroll
        for (int j = 0; j < NE - 1; ++j) e += (tile >= tend[j]) ? 1 : 0;
        u.aux = tile; u.aoff = (long)u.pm * BM * lda * esz; u.boff = (long)e * estride + (e >= esplit ? edelta : 0L) + (long)u.pn * BM * ldb * esz; return true; }
};

template <class T, class = void> struct has_probe : std::false_type {};
template <class T> struct has_probe<T, std::void_t<decltype(T::PROBE)>> : std::true_type {};
template <class T, class = void> struct has_prep : std::false_type {};
template <class T> struct has_prep<T, std::void_t<decltype(T::PREP)>> : std::true_type {};
template <class T, class = void> struct has_gate2 : std::false_type {};
template <class T> struct has_gate2<T, std::void_t<decltype(T::GATE2)>> : std::true_type {};
template <class T, class = void> struct has_normx : std::false_type {};
template <class T> struct has_normx<T, std::void_t<decltype(T::NORMX)>> : std::true_type {};
__device__ __forceinline__ void panel_exchange(const f32x4 (&acc)[2][2][4][2], float* slots, unsigned* cnt, int pm, int pn, int wr, int wc, int fr, int fq, float (&rs)[2][4]) {
#pragma unroll
    for (int ai = 0; ai < 2; ++ai)
#pragma unroll
        for (int m = 0; m < 4; ++m) { float q = 0.f;
#pragma unroll
            for (int bj = 0; bj < 2; ++bj)
#pragma unroll
                for (int n = 0; n < 2; ++n) { const f32x4 a = acc[ai][bj][m][n]; q += (a[0] * a[0] + a[1] * a[1]) + (a[2] * a[2] + a[3] * a[3]); }
            auto s1 = __builtin_amdgcn_permlane16_swap(__float_as_uint(q), __float_as_uint(q), false, false); q = __uint_as_float(s1[0]) + __uint_as_float(s1[1]);
            auto s2 = __builtin_amdgcn_permlane32_swap(__float_as_uint(q), __float_as_uint(q), false, false); q = __uint_as_float(s2[0]) + __uint_as_float(s2[1]);
            if (fq == 0) __hip_atomic_store(slots + (size_t)(pm * 256 + ai * HALF + wr * 64 + m * 16 + fr) * 16 + pn * 4 + wc, q, __ATOMIC_RELAXED, __HIP_MEMORY_SCOPE_AGENT); }
    asm volatile("s_waitcnt vmcnt(0)\n\ts_barrier" ::: "memory");
    unsigned* c = cnt + pm * 16;
    if (wr == 0 && wc == 0) {
        if (fr + 16 * fq == 0) __hip_atomic_fetch_add(c, 1u, __ATOMIC_RELAXED, __HIP_MEMORY_SCOPE_AGENT);
        for (unsigned sp = 0; sp < (1u << 20); ++sp) {
            if ((unsigned)__builtin_amdgcn_readfirstlane(__hip_atomic_load(c, __ATOMIC_RELAXED, __HIP_MEMORY_SCOPE_AGENT)) >= 4u) break;
            __builtin_amdgcn_s_sleep(1); } }
    asm volatile("s_waitcnt vmcnt(0)\n\ts_barrier" ::: "memory");
#pragma unroll
    for (int ai = 0; ai < 2; ++ai) { u32x4 w[4][4];
#pragma unroll
        for (int m = 0; m < 4; ++m) { const float* sl = slots + (size_t)(pm * 256 + ai * HALF + wr * 64 + m * 16 + fr) * 16;
#pragma unroll
            for (int k = 0; k < 4; ++k) asm volatile("global_load_dwordx4 %0, %1, off offset:%c2 sc1" : "=&v"(w[m][k]) : "v"(sl), "i"(k * 16) : "memory"); }
        asm volatile("s_waitcnt vmcnt(0)" : "+v"(w[0][0]), "+v"(w[0][1]), "+v"(w[0][2]), "+v"(w[0][3]), "+v"(w[1][0]), "+v"(w[1][1]), "+v"(w[1][2]), "+v"(w[1][3]),
                                            "+v"(w[2][0]), "+v"(w[2][1]), "+v"(w[2][2]), "+v"(w[2][3]), "+v"(w[3][0]), "+v"(w[3][1]), "+v"(w[3][2]), "+v"(w[3][3]) :: "memory");
#pragma unroll
        for (int m = 0; m < 4; ++m) { float tot = 0.f;
#pragma unroll
            for (int k = 0; k < 4; ++k) { tot += __uint_as_float(w[m][k].x); tot += __uint_as_float(w[m][k].y); tot += __uint_as_float(w[m][k].z); tot += __uint_as_float(w[m][k].w); }
            rs[ai][m] = rsqrtf(tot * (1.0f / 1024.0f) + NORM_EPS); } }
}
template <class T, class = void> struct has_staged8 : std::false_type {};
template <class T> struct has_staged8<T, std::void_t<decltype(T::STAGED8)>> : std::true_type {};
template <class T, class = void> struct has_staged4 : std::false_type {};
template <class T> struct has_staged4<T, std::void_t<decltype(T::STAGED4)>> : std::true_type {};
template <class T, class = void> struct has_staged : std::false_type {};
template <class T> struct has_staged<T, std::void_t<decltype(T::STAGED)>> : std::true_type {};
constexpr int EPI_STG_OFF = 131072 + 1024, EPI_STG_WAVE = 2048;
struct EpiLd { f32x4 a, b; };
template <class F> struct Epi8 {
    static constexpr bool PERM = true;
    F f;
    template <bool STORE = true>
    __device__ __forceinline__ void run(f32x4 (&acc)[2][2][4][2], const Unit& u, int wr, int wc, int fr0, int fq0, LAS unsigned char* stg) const {
        int fr = fr0, fq = fq0; asm volatile("" : "+v"(fr), "+v"(fq));
        if constexpr (has_normx<F>::value) {
#define EPI_ROW(ai_, m_) ((ai_) * HALF + wr * 64 + (m_) * 16 + fr)
#define EPI_COL(bj_) ((bj_) * HALF + wc * 32 + 8 * fq)
#define EPI_GETV(ai_, bj_, m_) const f32x4 a_ = acc[ai_][bj_][m_][0], b_ = acc[ai_][bj_][m_][1]; float v[8] = {a_[0], a_[1], a_[2], a_[3], b_[0], b_[1], b_[2], b_[3]}
#define EPI_PUTV(ai_, bj_, m_) acc[ai_][bj_][m_][0] = (f32x4){v[0], v[1], v[2], v[3]}; acc[ai_][bj_][m_][1] = (f32x4){v[4], v[5], v[6], v[7]}
#pragma unroll
            for (int am = 0; am < 4; ++am) { const int ai = am >> 1, m0 = (am & 1) * 2; EpiLd w[2][2];
#pragma unroll
                for (int mm = 0; mm < 2; ++mm)
#pragma unroll
                    for (int bj = 0; bj < 2; ++bj) w[mm][bj] = f.tload(u, EPI_ROW(ai, m0 + mm), EPI_COL(bj));
#pragma unroll
                for (int mm = 0; mm < 2; ++mm)
#pragma unroll
                    for (int bj = 0; bj < 2; ++bj) { const int m = m0 + mm; EPI_GETV(ai, bj, m); f.tval(u, EPI_ROW(ai, m), EPI_COL(bj), v, w[mm][bj]); EPI_PUTV(ai, bj, m); } }
            float rs[2][4];
            panel_exchange(acc, f.slotp(0), f.cntp(0), u.pm, u.pn, wr, wc, fr, fq, rs);
            asm volatile("" : "+v"(fr), "+v"(fq));
            if constexpr (F::NORMX == 2) {
                f32x4 g[2][2];
#pragma unroll
                for (int bj = 0; bj < 2; ++bj) f.gains(u, EPI_COL(bj), 1, g[bj][0], g[bj][1]);
#pragma unroll
                for (int am = 0; am < 4; ++am) { const int ai = am >> 1, m0 = (am & 1) * 2; EpiLd w[2][2];
#pragma unroll
                    for (int mm = 0; mm < 2; ++mm)
#pragma unroll
                        for (int bj = 0; bj < 2; ++bj) w[mm][bj] = f.mload(u, EPI_ROW(ai, m0 + mm), EPI_COL(bj));
#pragma unroll
                    for (int mm = 0; mm < 2; ++mm)
#pragma unroll
                        for (int bj = 0; bj < 2; ++bj) { const int m = m0 + mm; EPI_GETV(ai, bj, m); f.mid(u, EPI_ROW(ai, m), EPI_COL(bj), v, rs[ai][m], w[mm][bj], g[bj][0], g[bj][1]); EPI_PUTV(ai, bj, m); } }
                panel_exchange(acc, f.slotp(1), f.cntp(1), u.pm, u.pn, wr, wc, fr, fq, rs);
                asm volatile("" : "+v"(fr), "+v"(fq));
            }
            { f32x4 g[2][2];
#pragma unroll
              for (int bj = 0; bj < 2; ++bj) f.gains(u, EPI_COL(bj), 2, g[bj][0], g[bj][1]);
#pragma unroll
              for (int am = 0; am < 4; ++am) { const int ai = am >> 1, m0 = (am & 1) * 2; EpiLd w[2][2];
#pragma unroll
                  for (int mm = 0; mm < 2; ++mm)
#pragma unroll
                      for (int bj = 0; bj < 2; ++bj) w[mm][bj] = f.fload(u, EPI_ROW(ai, m0 + mm), EPI_COL(bj));
#pragma unroll
                  for (int mm = 0; mm < 2; ++mm)
#pragma unroll
                      for (int bj = 0; bj < 2; ++bj) { const int m = m0 + mm; EPI_GETV(ai, bj, m); f.finish(u, EPI_ROW(ai, m), EPI_COL(bj), v, rs[ai][m], w[mm][bj], g[bj][0], g[bj][1]); } } }
#undef EPI_ROW
#undef EPI_COL
#undef EPI_GETV
#undef EPI_PUTV
            return;
        }
        if constexpr (has_gate2<F>::value) {
#pragma unroll
            for (int ai = 0; ai < 2; ++ai) { u32x4 pw[4][2];
#pragma unroll
                for (int m = 0; m < 4; ++m) f.loadp(u, ai, m, wr, wc, fr, fq, pw[m][0], pw[m][1]);
#pragma unroll
                for (int m = 0; m < 4; ++m) { const f32x4 a0 = acc[ai][0][m][0], b0 = acc[ai][0][m][1], a1 = acc[ai][1][m][0], b1 = acc[ai][1][m][1];
                    float v0[8] = {a0[0], a0[1], a0[2], a0[3], b0[0], b0[1], b0[2], b0[3]}, v1[8] = {a1[0], a1[1], a1[2], a1[3], b1[0], b1[1], b1[2], b1[3]};
                    f.pair(u, ai, m, wr, wc, fr, fq, v0, v1, pw[m][0], pw[m][1]); } }
            return;
        }
        if constexpr (has_staged8<F>::value) {
            const int lane = fr + 16 * fq;
#pragma unroll
            for (int ai = 0; ai < 2; ++ai)
#pragma unroll
                for (int bj = 0; bj < 2; ++bj)
#pragma unroll
                    for (int mp = 0; mp < 2; ++mp) { const int row0 = ai * HALF + wr * 64 + mp * 32, cb = bj * HALF + wc * 32;
#pragma unroll
                        for (int mm = 0; mm < 2; ++mm) { const f32x4 a = acc[ai][bj][2 * mp + mm][0], b = acc[ai][bj][2 * mp + mm][1];
                            float v[8] = {a[0], a[1], a[2], a[3], b[0], b[1], b[2], b[3]};
                            *(LAS u32x2*)(stg + ((mm * 16 + fr) * 4 + fq) * 8) = f.pack8b(u, row0 + mm * 16 + fr, cb + 8 * fq, v); }
                        { const int lrow = lane >> 1, hf = lane & 1; const u32x4 w = *(const LAS u32x4*)(stg + lrow * 32 + hf * 16);
                          *(u32x4*)f.dst(u, row0 + lrow, cb + 16 * hf) = w; } }
            return;
        }
        if constexpr (has_staged4<F>::value) {
            const int lane = fr + 16 * fq;
#pragma unroll
            for (int ai = 0; ai < 2; ++ai)
#pragma unroll
                for (int bj = 0; bj < 2; ++bj) { const int row0 = ai * HALF + wr * 64, cb = bj * HALF + wc * 32;
#pragma unroll
                    for (int m = 0; m < 4; ++m) { const f32x4 a = acc[ai][bj][m][0], b = acc[ai][bj][m][1];
                        float v[8] = {a[0], a[1], a[2], a[3], b[0], b[1], b[2], b[3]};
                        *(LAS unsigned*)(stg + ((m * 16 + fr) * 4 + fq) * 4) = f.pack4b(u, row0 + m * 16 + fr, cb + 8 * fq, v); }
                    { const u32x4 w = *(const LAS u32x4*)(stg + lane * 16);
                      *(u32x4*)f.dst(u, row0 + lane, cb) = w; } }
            return;
        }
        if constexpr (has_staged<F>::value && has_prep<F>::value) {
            const int lane = fr + 16 * fq;
            EpiLd cur[2], nxt[2];
#pragma unroll
            for (int mm = 0; mm < 2; ++mm) cur[mm] = f.prep(u, wr * 64 + mm * 16 + fr, wc * 32 + 8 * fq);
#pragma unroll
            for (int k = 0; k < 8; ++k) { const int ai = k >> 2, bj = (k >> 1) & 1, mp = k & 1, row0 = ai * HALF + wr * 64 + mp * 32, cb = bj * HALF + wc * 32;
#pragma unroll
                for (int mm = 0; mm < 2; ++mm) { const f32x4 a = acc[ai][bj][2 * mp + mm][0], b = acc[ai][bj][2 * mp + mm][1];
                    float v[8] = {a[0], a[1], a[2], a[3], b[0], b[1], b[2], b[3]};
                    *(LAS u32x4*)(stg + ((mm * 16 + fr) * 4 + fq) * 16) = f.pack(u, row0 + mm * 16 + fr, cb + 8 * fq, v, cur[mm]); }
                if (k + 1 < 8) { const int k1 = k + 1, ai1 = k1 >> 2, bj1 = (k1 >> 1) & 1, mp1 = k1 & 1;
#pragma unroll
                    for (int mm = 0; mm < 2; ++mm) nxt[mm] = f.prep(u, ai1 * HALF + wr * 64 + mp1 * 32 + mm * 16 + fr, bj1 * HALF + wc * 32 + 8 * fq); }
#pragma unroll
                for (int ps = 0; ps < 2; ++ps) { const int lrow = ps * 16 + (lane >> 2), ch = lane & 3;
                    const u32x4 w = *(const LAS u32x4*)(stg + (lrow * 4 + ch) * 16);
                    *(u32x4*)f.dst(u, row0 + lrow, cb + 8 * ch) = w; }
                cur[0] = nxt[0]; cur[1] = nxt[1]; }
            return;
        }
        if constexpr (has_staged<F>::value && !has_prep<F>::value) {
            const int lane = fr + 16 * fq;
#pragma unroll
            for (int ai = 0; ai < 2; ++ai)
#pragma unroll
                for (int bj = 0; bj < 2; ++bj)
#pragma unroll
                    for (int mp = 0; mp < 2; ++mp) { const int row0 = ai * HALF + wr * 64 + mp * 32, cb = bj * HALF + wc * 32;
#pragma unroll
                        for (int mm = 0; mm < 2; ++mm) { const f32x4 a = acc[ai][bj][2 * mp + mm][0], b = acc[ai][bj][2 * mp + mm][1];
                            float v[8] = {a[0], a[1], a[2], a[3], b[0], b[1], b[2], b[3]};
                            *(LAS u32x4*)(stg + ((mm * 16 + fr) * 4 + fq) * 16) = f.pack(u, row0 + mm * 16 + fr, cb + 8 * fq, v); }
#pragma unroll
                        for (int ps = 0; ps < 2; ++ps) { const int lrow = ps * 16 + (lane >> 2), ch = lane & 3;
                            const u32x4 w = *(const LAS u32x4*)(stg + (lrow * 4 + ch) * 16);
                            if constexpr (STORE) *(u32x4*)f.dst(u, row0 + lrow, cb + 8 * ch) = w; else asm volatile("" :: "v"(w)); } }
            return;
        }
#pragma unroll
        for (int ai = 0; ai < 2; ++ai)
#pragma unroll
            for (int m = 0; m < 4; ++m) { const int row = ai * HALF + wr * 64 + m * 16 + fr;
#pragma unroll
                for (int bj = 0; bj < 2; ++bj) { const f32x4 a = acc[ai][bj][m][0], b = acc[ai][bj][m][1];
                    float v[8] = {a[0], a[1], a[2], a[3], b[0], b[1], b[2], b[3]};
                    f(u, row, bj * HALF + wc * 32 + 8 * fq, v); } }
    }
    __device__ __forceinline__ void operator()(f32x4 (&acc)[2][2][4][2], const Unit& u, int wr, int wc, int fr, int fq, LAS unsigned char* stg) const { run<true>(acc, u, wr, wc, fr, fq, stg); }
};

typedef int v8i32 __attribute__((ext_vector_type(8)));
template <class Epi, class Sched, bool FP8 = false, bool AG = false>
__device__ __forceinline__ void gemm_phase(LAS unsigned char* lds, const Gemm g, const Sched& S, const Epi& E) {
    int tid_ = threadIdx.x; asm volatile("" : "+v"(tid_));
    const int tid = tid_, wid = __builtin_amdgcn_readfirstlane(tid >> 6), lane = tid & 63, wr = wid >> 2, wc = wid & 3, fr = lane & 15, fq = lane >> 4;
    int K_ = g.K; asm volatile("" : "+s"(K_));
    const int K = K_, nt = FP8 ? K / (2 * BK) : K / BK;
    unsigned voffA[2], voffB[2];
#pragma unroll
    for (int i = 0; i < 2; ++i) { int R, C; stage_rc(tid * 16 + i * 8192, R, C); const int Rb = Epi::PERM ? ((R & ~31) + perm32(R & 31)) : R;
        voffA[i] = FP8 ? (unsigned)(R * g.lda + C * 2) : (unsigned)(R * g.lda + C) * 2u; voffB[i] = FP8 ? (unsigned)(Rb * g.ldb + C * 2) : (unsigned)(Rb * g.ldb + C) * 2u; }
    const size_t kstep = (size_t)(BK * 2);
    const size_t hstepA = (size_t)HALF * g.lda * (FP8 ? 1 : 2), hstepB = (size_t)HALF * g.ldb * (FP8 ? 1 : 2);
    const unsigned ldsw = (unsigned)wid * 1024u;
    const int aoff = FP8 ? lds_byte(wr * 64 + fr, fq * 16) : lds_byte(wr * 64 + fr, fq * 8), boff = FP8 ? lds_byte(wc * 32 + fr, fq * 16) : lds_byte(wc * 32 + fr, fq * 8);
    constexpr int KOFF = FP8 ? 16 : 1024;
#define PG8_SA(b, h) (((b) * 2 + (h)) * HTB)
#define PG8_SB(b, h) ((4 + (b) * 2 + (h)) * HTB)
#define PG8_STAGE(bufoff, gbase, voff) do { _Pragma("unroll") for (int _i = 0; _i < 2; ++_i) \
        __builtin_amdgcn_global_load_lds((const unsigned*)((const char*)(gbase) + (voff)[_i]), (LAS unsigned*)(lds + (bufoff) + ldsw + _i * 8192), 16, 0, 0); } while (0)
    unsigned tokA[2], tokN[2];
#define PG8_AGLOAD(un, tk) do { int t_ = tid; asm volatile("" : "+v"(t_)); _Pragma("unroll") for (int _i = 0; _i < 2; ++_i) { int R_, C_; stage_rc(t_ * 16 + _i * 8192, R_, C_); const int* rt_ = g.rowtok + (un).aux * 256 + R_; \
        tk[_i] = (unsigned)rt_[0] | ((unsigned)rt_[HALF] << 16); } } while (0)
#define PG8_STAGE_A(b, h, kptr, nx) do { if constexpr (AG) { int t_ = tid; asm volatile("" : "+v"(t_)); int R_, C_; stage_rc(t_ * 16, R_, C_);       \
          _Pragma("unroll") for (int _i = 0; _i < 2; ++_i) { const unsigned tk_ = (nx) ? tokN[_i] : tokA[_i]; \
            const unsigned vo_ = ((h) ? (tk_ >> 16) : (tk_ & 0xffffu)) * (unsigned)g.lda + (unsigned)(C_ * 2); \
            __builtin_amdgcn_global_load_lds((const unsigned*)((const char*)(kptr) + vo_), (LAS unsigned*)(lds + PG8_SA(b, h) + ldsw + _i * 8192), 16, 0, 0); } } \
        else PG8_STAGE(PG8_SA(b, h), (kptr) + (h) * hstepA, voffA); } while (0)
#define PG8_LDA(dst, b, h) do { _Pragma("unroll") for (int m = 0; m < 4; ++m) _Pragma("unroll") for (int k = 0; k < 2; ++k) dst[m][k] = *(const LAS bf16x8*)(lds + PG8_SA(b, h) + aoff + m * 2048 + k * KOFF); } while (0)
#define PG8_LDB(dst, b, h) do { _Pragma("unroll") for (int n = 0; n < 2; ++n) _Pragma("unroll") for (int k = 0; k < 2; ++k) dst[n][k] = *(const LAS bf16x8*)(lds + PG8_SB(b, h) + boff + n * 2048 + k * KOFF); } while (0)
#define PG8_CAT(x) __builtin_bit_cast(v8i32, __builtin_shufflevector((x)[0], (x)[1], 0, 1, 2, 3, 4, 5, 6, 7, 8, 9, 10, 11, 12, 13, 14, 15))
#define PG8_MMA(ai, bj, At, Bt) do { __builtin_amdgcn_s_setprio(1); _Pragma("unroll") for (int m = 0; m < 4; ++m) _Pragma("unroll") for (int n = 0; n < 2; ++n) { \
        if constexpr (FP8) { const v8i32 b8_ = PG8_CAT(Bt[n]), a8_ = PG8_CAT(At[m]); asm volatile("v_mfma_f32_16x16x128_f8f6f4 %0, %1, %2, %0" : "+v"(acc[ai][bj][m][n]) : "v"(b8_), "v"(a8_)); } \
        else { _Pragma("unroll") for (int k = 0; k < 2; ++k) acc[ai][bj][m][n] = __builtin_amdgcn_mfma_f32_16x16x32_bf16(Bt[n][k], At[m][k], acc[ai][bj][m][n], 0, 0, 0); } } \
        PG8_XMFMA(At, Bt); __builtin_amdgcn_s_setprio(0); } while (0)
#if defined(GEMM_XMFMA)
#define PG8_XMFMA(At, Bt) do { if constexpr (!FP8) { _Pragma("unroll") for (int x_ = 0; x_ < 4; ++x_) xacc_ = __builtin_amdgcn_mfma_f32_16x16x32_bf16(Bt[0][0], At[x_][0], xacc_, 0, 0, 0); asm volatile("" : "+v"(xacc_)); } } while (0)
#else
#define PG8_XMFMA(At, Bt) do { } while (0)
#endif
#define PG8_WAIT_V(n) asm volatile("s_waitcnt vmcnt(" #n ")" ::: "memory")
#define PG8_WAIT_L(n) asm volatile("s_waitcnt lgkmcnt(" #n ")" ::: "memory")
#define PG8_BAR __builtin_amdgcn_s_barrier()
#define PG8_SCHED __builtin_amdgcn_sched_barrier(0)
    Unit cur, nxt; int ui = 0;
    if (!S.next(0, cur)) return;
    f32x4 acc[2][2][4][2];
#pragma unroll
    for (int a = 0; a < 2; ++a)
#pragma unroll
        for (int b = 0; b < 2; ++b)
#pragma unroll
            for (int m = 0; m < 4; ++m)
#pragma unroll
                for (int n = 0; n < 2; ++n) acc[a][b][m][n] = (f32x4){0.f, 0.f, 0.f, 0.f};
    bf16x8 At[4][2], B0[2][2], B1[2][2];
#if defined(GEMM_XMFMA)
    f32x4 xacc_ = (f32x4){0.f, 0.f, 0.f, 0.f};
#endif
    const char* cA = (const char*)g.A + (AG ? 0 : cur.aoff); const char* cB = (const char*)g.Bt + cur.boff;
    if constexpr (AG) { static_assert(!AG || FP8, "gathered A: fp8 rows"); PG8_AGLOAD(cur, tokA); }
    PG8_STAGE(PG8_SB(0, 0), cB, voffB); PG8_STAGE(PG8_SB(0, 1), cB + hstepB, voffB); PG8_STAGE_A(0, 0, cA, false); PG8_STAGE_A(0, 1, cA, false);
    if (wr == 1) PG8_BAR;
    PG8_WAIT_V(2); PG8_BAR;
    PG8_STAGE(PG8_SB(1, 0), cB + kstep, voffB); PG8_STAGE_A(1, 0, cA + kstep, false); PG8_STAGE(PG8_SB(1, 1), cB + hstepB + kstep, voffB);
    PG8_WAIT_V(6); PG8_BAR;
    for (;;) {
        const bool has_next = S.next(ui + 1, nxt);
        const char* nA = (has_next && !AG) ? (const char*)g.A + nxt.aoff : cA; const char* nB = has_next ? (const char*)g.Bt + nxt.boff : cB;
        if constexpr (AG) { if (has_next) PG8_AGLOAD(nxt, tokN); else { tokN[0] = tokA[0]; tokN[1] = tokA[1]; } }
        for (int t = 0; t < nt; t += 2) {
            const bool last = (t == nt - 2);
            const char* a1 = cA + (size_t)(t + 1) * kstep;
            const char* a2 = last ? nA : cA + (size_t)(t + 2) * kstep; const char* b2 = last ? nB : cB + (size_t)(t + 2) * kstep;
            const char* a3 = a2 + kstep; const char* b3 = b2 + kstep;
            PG8_LDB(B0, 0, 0); PG8_LDB(B1, 0, 1); PG8_SCHED; PG8_LDA(At, 0, 0); PG8_STAGE_A(1, 1, a1, false);
            PG8_WAIT_V(8); PG8_WAIT_L(0); PG8_BAR; PG8_MMA(0, 0, At, B0); PG8_MMA(0, 1, At, B1); PG8_BAR; PG8_SCHED;
            PG8_LDA(At, 0, 1); PG8_STAGE(PG8_SB(0, 0), b2, voffB); PG8_STAGE(PG8_SB(0, 1), b2 + hstepB, voffB); PG8_STAGE_A(0, 0, a2, last);
            PG8_WAIT_V(8); PG8_WAIT_L(0); PG8_BAR; PG8_MMA(1, 0, At, B0); PG8_MMA(1, 1, At, B1); PG8_BAR; PG8_SCHED;
            PG8_LDB(B0, 1, 0); PG8_LDB(B1, 1, 1); PG8_SCHED; PG8_LDA(At, 1, 0); PG8_STAGE_A(0, 1, a2, last);
            PG8_WAIT_V(8); PG8_WAIT_L(0); PG8_BAR; PG8_MMA(0, 0, At, B0); PG8_MMA(0, 1, At, B1); PG8_BAR; PG8_SCHED;
            PG8_LDA(At, 1, 1); PG8_STAGE(PG8_SB(1, 0), b3, voffB); PG8_STAGE(PG8_SB(1, 1), b3 + hstepB, voffB); PG8_STAGE_A(1, 0, a3, last);
            PG8_WAIT_V(8); PG8_WAIT_L(0); PG8_BAR; PG8_MMA(1, 0, At, B0); PG8_MMA(1, 1, At, B1); PG8_BAR; PG8_SCHED;
        }
        if (wr == 0) PG8_BAR;
        if constexpr (FP8) asm volatile("s_nop 15\n\ts_nop 15" ::: "memory");
        E(acc, cur, wr, wc, fr, fq, lds + EPI_STG_OFF + wid * EPI_STG_WAVE);
#if defined(EPI_NOSTORE_REP)
        if constexpr (has_probe<decltype(E.f)>::value) E.template run<false>(acc, cur, wr, wc, fr, fq, lds + EPI_STG_OFF + wid * EPI_STG_WAVE);
#endif
#if defined(EPI_STORE_REP)
        if constexpr (has_probe<decltype(E.f)>::value) E.template run<true>(acc, cur, wr, wc, fr, fq, lds + EPI_STG_OFF + wid * EPI_STG_WAVE);
#endif
        if (!has_next) break;
#pragma unroll
        for (int a = 0; a < 2; ++a)
#pragma unroll
            for (int b = 0; b < 2; ++b)
#pragma unroll
                for (int m = 0; m < 4; ++m)
#pragma unroll
                    for (int n = 0; n < 2; ++n) acc[a][b][m][n] = (f32x4){0.f, 0.f, 0.f, 0.f};
        cur = nxt; cA = nA; cB = nB; ++ui;
        if constexpr (AG) { tokA[0] = tokN[0]; tokA[1] = tokN[1]; }
        if (wr == 1) PG8_BAR;
    }
    PG8_WAIT_V(0);
    PG8_BAR;
#undef PG8_SA
#undef PG8_SB
#undef PG8_STAGE
#undef PG8_STAGE_A
#undef PG8_AGLOAD
#undef PG8_LDA
#undef PG8_LDB
#undef PG8_MMA
#undef PG8_XMFMA
#undef PG8_CAT
#undef PG8_WAIT_V
#undef PG8_WAIT_L
#undef PG8_BAR
#undef PG8_SCHED
}
}

__device__ __forceinline__ bool z_is_rope_col(int n, bool& isq) {
    if (n >= ZC_D) { const int r = n - ZC_D; isq = r < 256; return r < 384; }
    if (n >= ZC_C) { const int r = (n - ZC_C) % 768; isq = r < 256; return r < 512; }
    isq = false; return false;
}
__device__ __forceinline__ int z_map(int n) { bool q; if (!z_is_rope_col(n, q)) return n; const int d = (n - ZC_C) & 63; return n - d + ((d < 32) ? 2 * d : 2 * (d - 32) + 1); }

using pg8::Unit;
using pg8::EpiLd;
struct FStore {
    static constexpr int PROBE = 1;
    static constexpr int STAGED = 1;
    bf16_t* dstp; int ld;
    __device__ __forceinline__ u32x4 pack(const Unit&, int, int, float (&v)[8]) const { return pack8(v); }
    __device__ __forceinline__ bf16_t* dst(const Unit& u, int row, int c8) const { return dstp + (size_t)(u.pm * 256 + row) * ld + u.pn * 256 + c8; }
    __device__ __forceinline__ void operator()(const Unit& u, int row, int c8, float (&v)[8]) const {
        __builtin_nontemporal_store(pack8(v), (u32x4*)(dstp + (size_t)(u.pm * 256 + row) * ld + u.pn * 256 + c8)); }
};
struct FIn {
    static constexpr int STAGED = 1;
    bf16_t* z; const float* c32; const float* s32; float wsc;
    static constexpr int PREP = 1;
    __device__ __forceinline__ EpiLd prep(const Unit& u, int row, int c8) const {
        const int col = u.pn * 256 + c8, r = u.pm * 256 + row; bool isq; EpiLd w; w.a = (f32x4){0.f, 0.f, 0.f, 0.f}; w.b = w.a;
        if (z_is_rope_col(col, isq)) { const int t = r & (SEQ - 1), i0 = ((col - ZC_C) & 63) >> 1; w.a = *(const f32x4*)(c32 + t * 32 + i0); w.b = *(const f32x4*)(s32 + t * 32 + i0); }
        return w; }
    __device__ __forceinline__ u32x4 pack(const Unit& u, int row, int c8, float (&v)[8], const EpiLd& w) const {
        const int col = u.pn * 256 + c8; bool isq;
#pragma unroll
        for (int i = 0; i < 8; ++i) v[i] *= wsc;
        if (z_is_rope_col(col, isq)) { const f32x4 c = w.a, s = w.b; const float sc = isq ? 0.125f * LOG2E : 1.0f;
#pragma unroll
            for (int p = 0; p < 4; ++p) { const float x1 = v[2 * p], x2 = v[2 * p + 1]; v[2 * p] = (x1 * c[p] - x2 * s[p]) * sc; v[2 * p + 1] = (x2 * c[p] + x1 * s[p]) * sc; } }
        return pack8(v); }
    __device__ __forceinline__ bf16_t* dst(const Unit& u, int row, int c8) const { return z + (size_t)(u.pm * 256 + row) * ZP + u.pn * 256 + c8; }
    __device__ __forceinline__ void operator()(const Unit& u, int row, int c8, float (&v)[8]) const { *(u32x4*)dst(u, row, c8) = pack(u, row, c8, v, prep(u, row, c8)); }
};
struct FStoreS {
    bf16_t* dst; int ld; float sc;
    __device__ __forceinline__ void operator()(const Unit& u, int row, int c8, float (&v)[8]) const {
#pragma unroll
        for (int i = 0; i < 8; ++i) v[i] *= sc;
        *(u32x4*)(dst + (size_t)(u.pm * 256 + row) * ld + u.pn * 256 + c8) = pack8(v); }
};
struct FSilu8 {
    static constexpr int STAGED4 = 1;
    unsigned char* hid; int ld; float sc;
    __device__ __forceinline__ unsigned pack4b(const Unit&, int, int, float (&v)[8]) const {
        float h[4];
#pragma unroll
        for (int i = 0; i < 4; ++i) { const float g = v[2 * i] * sc; h[i] = g * sigmoidf_(g) * (v[2 * i + 1] * sc); }
        return cvt4_fp8(h[0], h[1], h[2], h[3]); }
    __device__ __forceinline__ unsigned char* dst(const Unit& u, int row, int c8) const { return hid + (size_t)(u.pm * 256 + row) * ld + ((u.pn * 256 + c8) >> 1); }
    __device__ __forceinline__ void operator()(const Unit& u, int row, int c8, float (&v)[8]) const { *(unsigned*)dst(u, row, c8) = pack4b(u, row, c8, v); }
};
__device__ __forceinline__ int gate_map(int nn) { const int n = nn >> 10, ch = nn & 1023; return ((ch >> 6) << 8) + ((n >> 1) << 7) + (((ch >> 4) & 3) << 5) + ((((n & 1) << 1) + ((ch >> 3) & 1)) << 3) + (ch & 7); }
__device__ __forceinline__ size_t pfrag_off(int pm, int pn, int wave, int ai, int m, int half, int lane) { return ((size_t)((((((pm * 16 + pn) * 8 + wave) * 2 + ai) * 4 + m) * 2 + half) * 64 + lane)) * 8; }
struct FStoreP {
    bf16_t* P;
    __device__ __forceinline__ void operator()(const Unit& u, int row, int c8, float (&v)[8]) const {
        const int n = u.pn >> 2, c = (u.pn & 3) * 256 + c8, ai = row >> 7, wr = (row >> 6) & 1, m = (row >> 4) & 3, fr = row & 15;
        *(u32x4*)(P + pfrag_off(u.pm, c >> 6, wr * 4 + ((c >> 4) & 3), ai, m, n >> 1, fr + 16 * ((n & 1) * 2 + ((c >> 3) & 1)))) = pack8(v); }
};
struct FGate {
    static constexpr int GATE2 = 1;
    const bf16_t* P; bf16_t* mg; float sc;
    __device__ __forceinline__ void operator()(const Unit&, int, int, float (&)[8]) const {}
    __device__ __forceinline__ void loadp(const Unit& u, int ai, int m, int wr, int wc, int fr, int fq, u32x4& w0, u32x4& w1) const {
        const bf16_t* pf = P + pfrag_off(u.pm, u.pn, wr * 4 + wc, ai, m, 0, fr + 16 * fq); w0 = *(const u32x4*)pf; w1 = *(const u32x4*)(pf + 512); }
    __device__ __forceinline__ void pair(const Unit& u, int ai, int m, int wr, int wc, int fr, int fq, float (&v0)[8], float (&v1)[8], const u32x4 w0, const u32x4 w1) const {
        const size_t r = (size_t)(u.pm * 256 + ai * 128 + wr * 64 + m * 16 + fr); const int ch = u.pn * 64 + wc * 16 + (fq & 1) * 8;
        float p0[8], p1[8]; unpack8(w0, p0); unpack8(w1, p1);
        const float nsc = -sc * LOG2E;
#pragma unroll
        for (int i = 0; i < 8; ++i) v0[i] = __builtin_amdgcn_rcpf(1.0f + __builtin_amdgcn_exp2f(v0[i] * nsc)) * p0[i] + __builtin_amdgcn_rcpf(1.0f + __builtin_amdgcn_exp2f(v1[i] * nsc)) * p1[i];
        float t[4];
#pragma unroll
        for (int i = 0; i < 4; ++i) { auto b = __builtin_amdgcn_permlane32_swap(__float_as_uint(v0[i]), __float_as_uint(v0[i + 4]), false, false); t[i] = __uint_as_float(b[0]) + __uint_as_float(b[1]); }
        u32x2 o; o.x = cvt_pk_bf16(t[0], t[1]); o.y = cvt_pk_bf16(t[2], t[3]);
        *(u32x2*)(mg + r * DM + ch + (fq >> 1) * 4) = o; }
};
struct FSilu {
    static constexpr int STAGED8 = 1;
    bf16_t* hid; int ld;
    __device__ __forceinline__ u32x2 pack8b(const Unit&, int, int, float (&v)[8]) const {
        float h[4];
#pragma unroll
        for (int i = 0; i < 4; ++i) h[i] = v[2 * i] * sigmoidf_(v[2 * i]) * v[2 * i + 1];
        u32x2 w; w.x = cvt_pk_bf16(h[0], h[1]); w.y = cvt_pk_bf16(h[2], h[3]); return w; }
    __device__ __forceinline__ bf16_t* dst(const Unit& u, int row, int c8) const { return hid + (size_t)(u.pm * 256 + row) * ld + ((u.pn * 256 + c8) >> 1); }
    __device__ __forceinline__ void operator()(const Unit& u, int row, int c8, float (&v)[8]) const { *(u32x2*)dst(u, row, c8) = pack8b(u, row, c8, v); }
};
struct FRowScale {
    static constexpr int STAGED = 1;
    bf16_t* y; const float* rowg; float sc;
    static constexpr int PREP = 1;
    __device__ __forceinline__ EpiLd prep(const Unit& u, int row, int) const { EpiLd w; w.a = (f32x4){rowg[(size_t)(u.aux * 256 + row)], 0.f, 0.f, 0.f}; w.b = w.a; return w; }
    __device__ __forceinline__ u32x4 pack(const Unit&, int, int, float (&v)[8], const EpiLd& w) const { const float g = w.a[0] * sc;
#pragma unroll
        for (int i = 0; i < 8; ++i) v[i] *= g;
        return pack8(v); }
    __device__ __forceinline__ bf16_t* dst(const Unit& u, int row, int c8) const { return y + (size_t)(u.aux * 256 + row) * DM + u.pn * 256 + c8; }
    __device__ __forceinline__ void operator()(const Unit& u, int row, int c8, float (&v)[8]) const {
        const size_t r = (size_t)(u.aux * 256 + row); const float g = rowg[r] * sc;
#pragma unroll
        for (int i = 0; i < 8; ++i) v[i] *= g;
        *(u32x4*)(y + r * DM + u.pn * 256 + c8) = pack8(v); }
};
struct FPle {
    bf16_t* pp; float sc;
    __device__ __forceinline__ void operator()(const Unit& u, int row, int c8, float (&v)[8]) const {
        bf16_t* p = pp + (size_t)(u.pm * 256 + row) * DM + u.pn * 256 + c8;
        float q[8]; unpack8(*(const u32x4*)p, q);
#pragma unroll
        for (int i = 0; i < 8; ++i) q[i] *= sigmoidf_(v[i] * sc);
        *(u32x4*)p = pack8(q); }
};
#define EPI_OFF() ((size_t)(u.pm * 256 + row) * DM + u.pn * 256 + c8)
#define EPI_ACC_MEMBERS \
    __device__ __forceinline__ float* slotp(int k) const { return (float*)(ws + WS_XSLOT + (size_t)k * XSLOT_B); } \
    __device__ __forceinline__ unsigned* cntp(int k) const { return (unsigned*)ws + CW_PANEL + (ci + k) * 4096; } \
    __device__ __forceinline__ void operator()(const Unit&, int, int, float (&)[8]) const {}
__device__ __forceinline__ EpiLd epi_ld16(const bf16_t* p) { EpiLd w; w.a = __builtin_bit_cast(f32x4, *(const u32x4*)p); w.b = w.a; return w; }
__device__ __forceinline__ EpiLd epi_none() { EpiLd w; w.a = (f32x4){0.f, 0.f, 0.f, 0.f}; w.b = w.a; return w; }
__device__ __forceinline__ void epi_gain(const float* g, int col, f32x4& ga, f32x4& gb) { ga = *(const f32x4*)(g + col); gb = *(const f32x4*)(g + col + 4); }
struct FPleOut {
    static constexpr int NORMX = 1;
    unsigned char* ws; const float* g; float* out; int ci; float sc;
    EPI_ACC_MEMBERS
    __device__ __forceinline__ EpiLd tload(const Unit& u, int row, int c8) const { return epi_ld16((const bf16_t*)(ws + WS_PP) + EPI_OFF()); }
    __device__ __forceinline__ void tval(const Unit&, int, int, float (&v)[8], const EpiLd& w) const { float q[8]; unpack8(__builtin_bit_cast(u32x4, w.a), q);
#pragma unroll
        for (int i = 0; i < 8; ++i) v[i] = q[i] * sigmoidf_(v[i] * sc); }
    __device__ __forceinline__ void gains(const Unit& u, int c8, int, f32x4& ga, f32x4& gb) const { epi_gain(g, u.pn * 256 + c8, ga, gb); }
    __device__ __forceinline__ EpiLd fload(const Unit& u, int row, int c8) const { return epi_ld16((const bf16_t*)(ws + WS_XB) + EPI_OFF()); }
    __device__ __forceinline__ void finish(const Unit& u, int row, int c8, float (&v)[8], float rs, const EpiLd& w, f32x4 ga, f32x4 gb) const {
        float x[8]; unpack8(__builtin_bit_cast(u32x4, w.a), x); f32x4 o0, o1;
#pragma unroll
        for (int i = 0; i < 4; ++i) { o0[i] = x[i] + v[i] * rs * ga[i]; o1[i] = x[4 + i] + v[4 + i] * rs * gb[i]; }
        float* o = out + EPI_OFF(); *(f32x4*)o = o0; *(f32x4*)(o + 4) = o1; }
};
template <bool XF32>
struct FMixRes {
    static constexpr int NORMX = 2;
    unsigned char* ws; const float* xf; bf16_t* xs; const float* g1; const float* g2; int ci;
    EPI_ACC_MEMBERS
    __device__ __forceinline__ EpiLd tload(const Unit&, int, int) const { return epi_none(); }
    __device__ __forceinline__ void tval(const Unit&, int, int, float (&)[8], const EpiLd&) const {}
    __device__ __forceinline__ void gains(const Unit& u, int c8, int stage, f32x4& ga, f32x4& gb) const { epi_gain(stage == 1 ? g1 : g2, u.pn * 256 + c8, ga, gb); }
    __device__ __forceinline__ EpiLd mload(const Unit& u, int row, int c8) const {
        if constexpr (XF32) { EpiLd w; const float* p = xf + EPI_OFF(); w.a = *(const f32x4*)p; w.b = *(const f32x4*)(p + 4); return w; } else return epi_ld16(xs + EPI_OFF()); }
    __device__ __forceinline__ void mid(const Unit& u, int row, int c8, float (&v)[8], float rs, const EpiLd& w, f32x4 ga, f32x4 gb) const {
        float x[8];
        if constexpr (XF32) { x[0] = w.a[0]; x[1] = w.a[1]; x[2] = w.a[2]; x[3] = w.a[3]; x[4] = w.b[0]; x[5] = w.b[1]; x[6] = w.b[2]; x[7] = w.b[3]; } else unpack8(__builtin_bit_cast(u32x4, w.a), x);
#pragma unroll
        for (int i = 0; i < 4; ++i) { v[i] = x[i] + v[i] * rs * ga[i]; v[4 + i] = x[4 + i] + v[4 + i] * rs * gb[i]; }
        *(u32x4*)(xs + EPI_OFF()) = pack8(v); }
    __device__ __forceinline__ EpiLd fload(const Unit&, int, int) const { return epi_none(); }
    __device__ __forceinline__ void finish(const Unit& u, int row, int c8, float (&v)[8], float rs, const EpiLd&, f32x4 ga, f32x4 gb) const {
#pragma unroll
        for (int i = 0; i < 4; ++i) { v[i] *= rs * ga[i]; v[4 + i] *= rs * gb[i]; }
        *(u32x4*)((bf16_t*)(ws + WS_H2) + EPI_OFF()) = pack8(v); }
};
struct FFfnRes {
    static constexpr int NORMX = 1;
    unsigned char* ws; const bf16_t* xs; const float* g; int ci; float sc;
    EPI_ACC_MEMBERS
    __device__ __forceinline__ EpiLd tload(const Unit&, int, int) const { return epi_none(); }
    __device__ __forceinline__ void tval(const Unit&, int, int, float (&v)[8], const EpiLd&) const {
#pragma unroll
        for (int i = 0; i < 8; ++i) v[i] *= sc; }
    __device__ __forceinline__ void gains(const Unit& u, int c8, int, f32x4& ga, f32x4& gb) const { epi_gain(g, u.pn * 256 + c8, ga, gb); }
    __device__ __forceinline__ EpiLd fload(const Unit& u, int row, int c8) const { return epi_ld16(xs + EPI_OFF()); }
    __device__ __forceinline__ void finish(const Unit& u, int row, int c8, float (&v)[8], float rs, const EpiLd& w, f32x4 ga, f32x4 gb) const {
        float x[8]; unpack8(__builtin_bit_cast(u32x4, w.a), x);
#pragma unroll
        for (int i = 0; i < 4; ++i) { v[i] = x[i] + v[i] * rs * ga[i]; v[4 + i] = x[4 + i] + v[4 + i] * rs * gb[i]; }
        const size_t off = EPI_OFF();
        *(u32x4*)((bf16_t*)(ws + WS_XB) + off) = pack8(v);
        if constexpr (FP8_PLE) { u32x2 o; o.x = cvt4_fp8(v[0], v[1], v[2], v[3]); o.y = cvt4_fp8(v[4], v[5], v[6], v[7]); *(u32x2*)(ws + WS_XB8_DENSE + off) = o; } }
};
template <bool HBF, bool H8>
struct FPleRes {
    static constexpr int NORMX = 2;
    unsigned char* ws; bf16_t* xs; const float* g1; const float* g2; int ci; float sc;
    EPI_ACC_MEMBERS
    __device__ __forceinline__ EpiLd tload(const Unit& u, int row, int c8) const { return epi_ld16((const bf16_t*)(ws + WS_PP) + EPI_OFF()); }
    __device__ __forceinline__ void tval(const Unit&, int, int, float (&v)[8], const EpiLd& w) const { float q[8]; unpack8(__builtin_bit_cast(u32x4, w.a), q);
#pragma unroll
        for (int i = 0; i < 8; ++i) v[i] = q[i] * sigmoidf_(v[i] * sc); }
    __device__ __forceinline__ void gains(const Unit& u, int c8, int stage, f32x4& ga, f32x4& gb) const { epi_gain(stage == 1 ? g1 : g2, u.pn * 256 + c8, ga, gb); }
    __device__ __forceinline__ EpiLd mload(const Unit& u, int row, int c8) const { return epi_ld16((const bf16_t*)(ws + WS_XB) + EPI_OFF()); }
    __device__ __forceinline__ void mid(const Unit& u, int row, int c8, float (&v)[8], float rs, const EpiLd& w, f32x4 ga, f32x4 gb) const {
        float x[8]; unpack8(__builtin_bit_cast(u32x4, w.a), x);
#pragma unroll
        for (int i = 0; i < 4; ++i) { v[i] = x[i] + v[i] * rs * ga[i]; v[4 + i] = x[4 + i] + v[4 + i] * rs * gb[i]; }
        *(u32x4*)(xs + EPI_OFF()) = pack8(v); }
    __device__ __forceinline__ EpiLd fload(const Unit&, int, int) const { return epi_none(); }
    __device__ __forceinline__ void finish(const Unit& u, int row, int c8, float (&v)[8], float rs, const EpiLd&, f32x4 ga, f32x4 gb) const {
#pragma unroll
        for (int i = 0; i < 4; ++i) { v[i] *= rs * ga[i]; v[4 + i] *= rs * gb[i]; }
        const size_t off = EPI_OFF();
        if constexpr (HBF) *(u32x4*)((bf16_t*)(ws + WS_H) + off) = pack8(v);
        if constexpr (H8) { u32x2 o; o.x = cvt4_fp8(v[0], v[1], v[2], v[3]); o.y = cvt4_fp8(v[4], v[5], v[6], v[7]); *(u32x2*)(ws + WS_H8 + off) = o; } }
};
#undef EPI_OFF
#undef EPI_ACC_MEMBERS
struct FUq {
    bf16_t* qa; const float* c16; const float* s16; float scale;
    __device__ __forceinline__ void operator()(const Unit& u, int row, int c8, float (&v)[8]) const {
        const int n = u.pn * 256 + c8; if (n >= 384) return;
        const int r = u.pm * 256 + row, pos = r & (SEQ - 1), j = n % 96;
        if (j >= 64) { const int i0 = (j - 64) >> 1; const f32x4 c = *(const f32x4*)(c16 + pos * 16 + i0), s = *(const f32x4*)(s16 + pos * 16 + i0);
#pragma unroll
            for (int p = 0; p < 4; ++p) { const float x1 = v[2 * p], x2 = v[2 * p + 1]; v[2 * p] = x1 * c[p] - x2 * s[p]; v[2 * p + 1] = x2 * c[p] + x1 * s[p]; } }
#pragma unroll
        for (int i = 0; i < 8; ++i) v[i] *= scale;
        *(u32x4*)(qa + (size_t)r * 384 + n) = pack8(v); }
};
struct FUkv {
    bf16_t* ka; bf16_t* va;
    __device__ __forceinline__ void operator()(const Unit& u, int row, int c8, float (&v)[8]) const {
        const int n = u.pn * 256 + c8, h = n >> 7, j = n & 127; const size_t r = (size_t)(u.pm * 256 + row);
        bf16_t* d = (j < 64) ? ka + r * 384 + h * 96 + j : va + r * 256 + h * 64 + (j - 64);
        *(u32x4*)d = pack8(v); }
};

struct AttnDesc { const bf16_t* Q; const bf16_t* K; const bf16_t* V; bf16_t* O; float* lse; int qs, ks, vs, os, lss, q0, L, band; float m0, l0; };
constexpr int ATT_K = 0, ATT_KSLOT = 12288, ATT_V = 3 * ATT_KSLOT, ATT_VSLOT = 8192, ATT_WS = ATT_V + 3 * ATT_VSLOT, ATT_OST = ATT_WS + 8 * 256, ATT_BYTES = ATT_OST + 8 * 4096;
__device__ __forceinline__ int crow(int r, int hi) { return (r & 3) + 8 * (r >> 2) + 4 * hi; }
__device__ __forceinline__ void att_pv(f32x16 (&o)[2], int vb, bf16x8 pa0, bf16x8 pa1, bf16x8 pa2, bf16x8 pa3) {
#pragma unroll
    for (int d0 = 0; d0 < 2; ++d0) { s16x4 lo[4], hi[4];
#pragma unroll
        for (int ks = 0; ks < 4; ++ks) {
            asm volatile("ds_read_b64_tr_b16 %0,%1 offset:%c2" : "=&v"(lo[ks]) : "v"(vb), "i"(d0 * 4096 + ks * 1024) : "memory");
            asm volatile("ds_read_b64_tr_b16 %0,%1 offset:%c2" : "=&v"(hi[ks]) : "v"(vb), "i"(d0 * 4096 + ks * 1024 + 512) : "memory"); }
        asm volatile("s_waitcnt lgkmcnt(0)" ::: "memory"); __builtin_amdgcn_sched_barrier(0);
#define ATT_PK(k) (bf16x8){lo[k][0], lo[k][1], lo[k][2], lo[k][3], hi[k][0], hi[k][1], hi[k][2], hi[k][3]}
        o[d0] = __builtin_amdgcn_mfma_f32_32x32x16_bf16(pa0, ATT_PK(0), o[d0], 0, 0, 0);
        o[d0] = __builtin_amdgcn_mfma_f32_32x32x16_bf16(pa1, ATT_PK(1), o[d0], 0, 0, 0);
        o[d0] = __builtin_amdgcn_mfma_f32_32x32x16_bf16(pa2, ATT_PK(2), o[d0], 0, 0, 0);
        o[d0] = __builtin_amdgcn_mfma_f32_32x32x16_bf16(pa3, ATT_PK(3), o[d0], 0, 0, 0);
#undef ATT_PK
    }
}
template <int DQK>
__device__ __forceinline__ void attn_unit(LAS unsigned char* lds, const AttnDesc u) {
    constexpr int ND = DQK / 16, NCH = DQK / 8;
    int tid_ = threadIdx.x; asm volatile("" : "+v"(tid_));
    const int tid = tid_, lane = tid & 63, r32 = lane & 31, hi = lane >> 5, wid = __builtin_amdgcn_readfirstlane(tid >> 6);
    const int qw0 = u.q0 + wid * 32, band = u.band;
    int t_lo = 0, t_hi = u.L / 64 - 1;
    if (band >= 0) { const int a = u.q0 - band; t_lo = a > 0 ? (a >> 6) : 0; const int b = (u.q0 + 255 + band) >> 6; t_hi = b < t_hi ? b : t_hi; }
    static_assert(DQK == 64, "the banded body stages exactly one K piece and one V piece per wave and tile (its counted wait depends on it)");
#define ATT_DMA(t_, slot_) do { const int tt_ = (t_) < t_hi ? (t_) : t_hi;                   \
        const bf16_t* kg_ = u.K + (size_t)(tt_ * 64 + lane) * u.ks; \
        __builtin_amdgcn_global_load_lds((const unsigned*)(kg_ + wid * 8), (LAS unsigned*)(lds + ATT_K + (slot_) * ATT_KSLOT + wid * 1024), 16, 0, 0); \
        const bf16_t* vg_ = u.V + (size_t)(tt_ * 64 + 16 * (wid & 3) + (lane >> 2)) * u.vs + (wid >> 2) * 32 + (lane & 3) * 8; \
        __builtin_amdgcn_global_load_lds((const unsigned*)vg_, (LAS unsigned*)(lds + ATT_V + (slot_) * ATT_VSLOT + wid * 1024), 16, 0, 0); } while (0)
    ATT_DMA(t_lo, 0); ATT_DMA(t_lo + 1, 1);
    bf16x8 qr[ND];
    { const bf16_t* qp = u.Q + (size_t)(qw0 + r32) * u.qs + hi * 8;
#pragma unroll
      for (int d0 = 0; d0 < ND; ++d0) qr[d0] = *(const bf16x8*)(qp + d0 * 16); }
    float m = u.m0, l = (hi == 0) ? u.l0 : 0.f;
    f32x16 o[2];
#pragma unroll
    for (int r = 0; r < 16; ++r) { o[0][r] = 0.f; o[1][r] = 0.f; }
    LAS float* wsf = (LAS float*)(lds + ATT_WS) + wid * 64;
    const int vb0 = (int)(unsigned)(uintptr_t)(lds + ATT_V) + ((lane >> 4) & 1) * 32 + (lane & 3) * 8 + (4 * hi + ((lane & 15) >> 2)) * 64;
    int slot = 0, fslot = 2;
    for (int t = t_lo; t <= t_hi; ++t) {
        asm volatile("s_waitcnt vmcnt(2) lgkmcnt(0)\n\ts_barrier" ::: "memory");
        ATT_DMA(t + 2, fslot);
        const bool active = band < 0 || (t * 64 + 63 >= qw0 - band && t * 64 <= qw0 + 31 + band);
        if (active) {
            const LAS unsigned char* kp = lds + ATT_K + slot * ATT_KSLOT + hi * 1024 + r32 * 16;
            f32x16 p0, p1;
#pragma unroll
            for (int r = 0; r < 16; ++r) { p0[r] = 0.f; p1[r] = 0.f; }
#pragma unroll
            for (int d0 = 0; d0 < ND; ++d0) {
                const bf16x8 b0 = *(const LAS bf16x8*)(kp + d0 * 2048), b1 = *(const LAS bf16x8*)(kp + d0 * 2048 + 512);
                p0 = __builtin_amdgcn_mfma_f32_32x32x16_bf16(b0, qr[d0], p0, 0, 0, 0);
                p1 = __builtin_amdgcn_mfma_f32_32x32x16_bf16(b1, qr[d0], p1, 0, 0, 0); }
            if (band >= 0) { const int kb = t * 64 + 4 * hi - (qw0 + r32);
#pragma unroll
                for (int r = 0; r < 16; ++r) { const int d = kb + (r & 3) + 8 * (r >> 2);
                    if (d > band || d < -band) p0[r] = -INFINITY;
                    if (d + 32 > band || d + 32 < -band) p1[r] = -INFINITY; } }
            float mx = fmaxf(p0[0], p1[0]);
#pragma unroll
            for (int r = 1; r < 16; ++r) mx = fmaxf(mx, fmaxf(p0[r], p1[r]));
            mx = fmaxf(mx, __shfl_xor(mx, 32));
            const float mn = fmaxf(m, mx), alpha = __builtin_amdgcn_exp2f(m - mn);
            m = mn;
            float s = 0.f;
#pragma unroll
            for (int r = 0; r < 16; ++r) { p0[r] = __builtin_amdgcn_exp2f(p0[r] - mn); p1[r] = __builtin_amdgcn_exp2f(p1[r] - mn); s += p0[r] + p1[r]; }
            l = l * alpha + s;
            if (__any(alpha != 1.0f)) {
                if (hi == 0) wsf[r32] = alpha;
#pragma unroll
                for (int r = 0; r < 16; ++r) { const float a = wsf[crow(r, hi)]; o[0][r] *= a; o[1][r] *= a; } }
            u32x4 pw0, pw1, pw2, pw3;
            pw0.x = cvt_pk_bf16(p0[0], p0[1]); pw0.y = cvt_pk_bf16(p0[2], p0[3]); pw0.z = cvt_pk_bf16(p0[4], p0[5]); pw0.w = cvt_pk_bf16(p0[6], p0[7]);
            pw1.x = cvt_pk_bf16(p0[8], p0[9]); pw1.y = cvt_pk_bf16(p0[10], p0[11]); pw1.z = cvt_pk_bf16(p0[12], p0[13]); pw1.w = cvt_pk_bf16(p0[14], p0[15]);
            pw2.x = cvt_pk_bf16(p1[0], p1[1]); pw2.y = cvt_pk_bf16(p1[2], p1[3]); pw2.z = cvt_pk_bf16(p1[4], p1[5]); pw2.w = cvt_pk_bf16(p1[6], p1[7]);
            pw3.x = cvt_pk_bf16(p1[8], p1[9]); pw3.y = cvt_pk_bf16(p1[10], p1[11]); pw3.z = cvt_pk_bf16(p1[12], p1[13]); pw3.w = cvt_pk_bf16(p1[14], p1[15]);
            att_pv(o, vb0 + slot * ATT_VSLOT, __builtin_bit_cast(bf16x8, pw0), __builtin_bit_cast(bf16x8, pw1), __builtin_bit_cast(bf16x8, pw2), __builtin_bit_cast(bf16x8, pw3));
        }
        slot = (slot == 2) ? 0 : slot + 1; fslot = (fslot == 2) ? 0 : fslot + 1;
    }
    asm volatile("s_waitcnt vmcnt(0)" ::: "memory");
#undef ATT_DMA
    l += __shfl_xor(l, 32);
    if (hi == 0) wsf[32 + r32] = l;
    LAS bf16_t* stg = (LAS bf16_t*)(lds + ATT_OST) + wid * 2048;
#pragma unroll
    for (int r = 0; r < 16; ++r) { const int orow = crow(r, hi); const float rl = __builtin_amdgcn_rcpf(wsf[32 + orow]);
        stg[orow * 64 + r32] = (bf16_t)cvt_pk_bf16(o[0][r] * rl, 0.f); stg[orow * 64 + 32 + r32] = (bf16_t)cvt_pk_bf16(o[1][r] * rl, 0.f); }
    LDS_WAIT();
#pragma unroll
    for (int i = 0; i < 4; ++i) { const int row = i * 8 + (lane >> 3), ch = lane & 7; const u32x4 v = *(const LAS u32x4*)(stg + row * 64 + ch * 8);
        *(u32x4*)(u.O + (size_t)(qw0 + row) * u.os + ch * 8) = v; }
    if (u.lse != nullptr && hi == 0) u.lse[(size_t)(qw0 + r32) * u.lss] = m + __builtin_amdgcn_logf(l);
    asm volatile("s_waitcnt lgkmcnt(0)\n\ts_barrier" ::: "memory");
}

__device__ __forceinline__ float att_rowmax(const f32x16& a, const f32x16& b) {
    float x = fmaxf(fmaxf(a[0], a[1]), b[0]), y = fmaxf(fmaxf(a[2], a[3]), b[1]); x = fmaxf(fmaxf(x, b[2]), b[3]);
#pragma unroll
    for (int r = 4; r < 16; r += 4) { x = fmaxf(fmaxf(x, a[r]), a[r + 1]); y = fmaxf(fmaxf(y, a[r + 2]), a[r + 3]); x = fmaxf(fmaxf(x, b[r]), b[r + 1]); y = fmaxf(fmaxf(y, b[r + 2]), b[r + 3]); }
    const float mm = fmaxf(x, y);
    auto rr = __builtin_amdgcn_permlane32_swap(__float_as_uint(mm), __float_as_uint(mm), false, false);
    return fmaxf(__uint_as_float(rr[0]), __uint_as_float(rr[1]));
}
template <int DQK>
__device__ __forceinline__ void att_step(f32x16& c0, f32x16& c1, f32x16& n0, f32x16& n1, const bf16x8 (&qr)[DQK / 16], f32x16& negm, f32x16 (&o)[2], float& m, float& l,
                                         const u32x4 (&pwp)[4], u32x4 (&pwn)[4], LAS float* wsf, const LAS unsigned char* kpn, int vbp, int r32, int hi) {
    constexpr int ND = DQK / 16, NS = 2 * ND;
    const float mx = att_rowmax(c0, c1);
    const bool resc = __any(mx > 8.0f);
    if (__builtin_expect(resc, 0)) {
        const float dl = fmaxf(mx, 0.f); m += dl;
#pragma unroll
        for (int r = 0; r < 16; ++r) { c0[r] -= dl; c1[r] -= dl; negm[r] = -m; }
        const float f = __builtin_amdgcn_exp2f(-dl); l *= f;
        if (hi == 0) wsf[r32] = f;
    }
    float sacc = 0.f;
    bf16x8 kf[NS]; s16x4 vlo[8], vhi[8];
    kf[0] = *(const LAS bf16x8*)(kpn); kf[1] = *(const LAS bf16x8*)(kpn + 512);
    asm volatile("ds_read_b64_tr_b16 %0,%1 offset:0" : "=&v"(vlo[0]) : "v"(vbp) : "memory");
    asm volatile("ds_read_b64_tr_b16 %0,%1 offset:512" : "=&v"(vhi[0]) : "v"(vbp) : "memory");
    asm volatile("" : "+v"(c0[0]), "+v"(c0[1]), "+v"(c1[0]), "+v"(c1[1]));
    asm volatile("" : "+v"(kf[0]));
    __builtin_amdgcn_sched_barrier(0);
#pragma unroll
    for (int i = 0; i < 8; ++i) {
        const int q0 = (NS == 8) ? i : (3 * i) / 2, q1 = (NS == 8) ? i + 1 : (3 * (i + 1)) / 2;
#pragma unroll
        for (int q = q0; q < q1; ++q) { const int d0 = q >> 1;
            if ((q & 1) == 0) n0 = __builtin_amdgcn_mfma_f32_32x32x16_bf16(kf[q], qr[d0], d0 == 0 ? negm : n0, 0, 0, 0);
            else              n1 = __builtin_amdgcn_mfma_f32_32x32x16_bf16(kf[q], qr[d0], d0 == 0 ? negm : n1, 0, 0, 0);
            if (q + 2 < NS) kf[q + 2] = *(const LAS bf16x8*)(kpn + ((q + 2) >> 1) * 2048 + ((q + 2) & 1) * 512); }
        { const int ra = 2 * i, rb = 2 * i + 1;
            c0[ra] = __builtin_amdgcn_exp2f(c0[ra]); c0[rb] = __builtin_amdgcn_exp2f(c0[rb]); c1[ra] = __builtin_amdgcn_exp2f(c1[ra]); c1[rb] = __builtin_amdgcn_exp2f(c1[rb]);
            sacc += (c0[ra] + c0[rb]) + (c1[ra] + c1[rb]);
            const unsigned wa = cvt_pk_bf16(c0[ra], c0[rb]), wb = cvt_pk_bf16(c1[ra], c1[rb]);
            if (i < 4) { pwn[0][i] = wa; pwn[2][i] = wb; } else { pwn[1][i - 4] = wa; pwn[3][i - 4] = wb; } }
        { const int newer = ((q0 + 2 < NS) ? 1 : 0) + ((q1 - q0 > 1 && q0 + 3 < NS) ? 1 : 0);
          if (newer == 2) asm volatile("s_waitcnt lgkmcnt(2)" : "+v"(vlo[i]), "+v"(vhi[i]) :: "memory");
          else if (newer == 1) asm volatile("s_waitcnt lgkmcnt(1)" : "+v"(vlo[i]), "+v"(vhi[i]) :: "memory");
          else asm volatile("s_waitcnt lgkmcnt(0)" : "+v"(vlo[i]), "+v"(vhi[i]) :: "memory"); }
        { const bf16x8 vf = (bf16x8){vlo[i][0], vlo[i][1], vlo[i][2], vlo[i][3], vhi[i][0], vhi[i][1], vhi[i][2], vhi[i][3]};
          o[i & 1] = __builtin_amdgcn_mfma_f32_32x32x16_bf16(__builtin_bit_cast(bf16x8, pwp[i >> 1]), vf, o[i & 1], 0, 0, 0); }
        if (i + 1 < 8) { const int j = i + 1;
            asm volatile("ds_read_b64_tr_b16 %0,%1 offset:%c2" : "=&v"(vlo[j]) : "v"(vbp), "i"((j & 1) * 4096 + (j >> 1) * 1024) : "memory");
            asm volatile("ds_read_b64_tr_b16 %0,%1 offset:%c2" : "=&v"(vhi[j]) : "v"(vbp), "i"((j & 1) * 4096 + (j >> 1) * 1024 + 512) : "memory"); }
        asm volatile("" : "+v"(c0[2 * i]), "+v"(c0[2 * i + 1]), "+v"(c1[2 * i]), "+v"(c1[2 * i + 1]), "+v"(sacc));
        if (i + 1 < 8) asm volatile("" : "+v"(c0[2 * i + 2]), "+v"(c0[2 * i + 3]), "+v"(c1[2 * i + 2]), "+v"(c1[2 * i + 3]));
        if (q1 < NS) asm volatile("" : "+v"(kf[q1]));
        __builtin_amdgcn_sched_barrier(0);
    }
    l += sacc;
    if (__builtin_expect(resc, 0)) {
#pragma unroll
        for (int r = 0; r < 16; ++r) { const float a = wsf[crow(r, hi)]; o[0][r] *= a; o[1][r] *= a; }
    }
}
constexpr int ATD_K0 = 0, ATD_V0 = 3 * ATT_KSLOT, ATD_WS = ATD_V0 + 3 * ATT_VSLOT, ATD_OST = ATD_WS + 8 * 256, ATD_BYTES = ATD_OST + 8 * 4096;
template <int DQK>
__device__ __forceinline__ void attn_dense(LAS unsigned char* lds, const AttnDesc u) {
    constexpr int ND = DQK / 16, NCH = DQK / 8;
    int tid_ = threadIdx.x; asm volatile("" : "+v"(tid_));
    const int tid = tid_, lane = tid & 63, r32 = lane & 31, hi = lane >> 5, wid = __builtin_amdgcn_readfirstlane(tid >> 6);
    const int qw0 = u.q0 + wid * 32, NT = u.L / 64;
    const bool two_k = (NCH > 8) && (wid < NCH - 8);
#define ATD_K(t_, slot_) do { const bf16_t* kg_ = u.K + (size_t)((t_) * 64 + lane) * u.ks; \
        __builtin_amdgcn_global_load_lds((const unsigned*)(kg_ + wid * 8), (LAS unsigned*)(lds + ATD_K0 + (slot_) * ATT_KSLOT + wid * 1024), 16, 0, 0); \
        if (two_k) __builtin_amdgcn_global_load_lds((const unsigned*)(kg_ + (wid + 8) * 8), (LAS unsigned*)(lds + ATD_K0 + (slot_) * ATT_KSLOT + (wid + 8) * 1024), 16, 0, 0); } while (0)
#define ATD_V(t_, slot_) do { const bf16_t* vg_ = u.V + (size_t)((t_) * 64 + 16 * (wid & 3) + (lane >> 2)) * u.vs + (wid >> 2) * 32 + (lane & 3) * 8; \
        __builtin_amdgcn_global_load_lds((const unsigned*)vg_, (LAS unsigned*)(lds + ATD_V0 + (slot_) * ATT_VSLOT + wid * 1024), 16, 0, 0); } while (0)
#define ATD_WAITBAR() do { if (two_k) asm volatile("s_waitcnt vmcnt(3) lgkmcnt(0)\n\ts_barrier" ::: "memory"); else asm volatile("s_waitcnt vmcnt(2) lgkmcnt(0)\n\ts_barrier" ::: "memory"); } while (0)
#define ATD_ROT(x) x = (x == 2) ? 0 : x + 1
    ATD_K(0, 0); ATD_V(0, 2);
    bf16x8 qr[ND];
    { const bf16_t* qp = u.Q + (size_t)(qw0 + r32) * u.qs + hi * 8;
#pragma unroll
      for (int d0 = 0; d0 < ND; ++d0) qr[d0] = *(const bf16x8*)(qp + d0 * 16); }
    float m = 0.f, l = 0.f;
    f32x16 o[2], negm, pA0, pA1, pB0, pB1; u32x4 pwA[4], pwB[4];
#pragma unroll
    for (int r = 0; r < 16; ++r) { o[0][r] = 0.f; o[1][r] = 0.f; negm[r] = 0.f; pA0[r] = 0.f; pA1[r] = 0.f; }
#pragma unroll
    for (int k = 0; k < 4; ++k) pwB[k] = (u32x4){0u, 0u, 0u, 0u};
    LAS float* wsf = (LAS float*)(lds + ATD_WS) + wid * 64;
    const int vb0 = (int)(unsigned)(uintptr_t)(lds + ATD_V0) + ((lane >> 4) & 1) * 32 + (lane & 3) * 8 + (4 * hi + ((lane & 15) >> 2)) * 64;
    const LAS unsigned char* kp0 = lds + ATD_K0 + hi * 1024 + r32 * 16;
    asm volatile("s_waitcnt vmcnt(0) lgkmcnt(0)\n\ts_barrier" ::: "memory");
    ATD_K(1, 1); ATD_V(0, 0); ATD_K(2, 2);
#pragma unroll
    for (int d0 = 0; d0 < ND; ++d0) {
        const bf16x8 b0 = *(const LAS bf16x8*)(kp0 + d0 * 2048), b1 = *(const LAS bf16x8*)(kp0 + d0 * 2048 + 512);
        pA0 = __builtin_amdgcn_mfma_f32_32x32x16_bf16(b0, qr[d0], pA0, 0, 0, 0);
        pA1 = __builtin_amdgcn_mfma_f32_32x32x16_bf16(b1, qr[d0], pA1, 0, 0, 0); }
    { const float mx = att_rowmax(pA0, pA1); m = mx;
#pragma unroll
      for (int r = 0; r < 16; ++r) { pA0[r] -= mx; pA1[r] -= mx; negm[r] = -mx; } }
    int kn = 1, kf = 0, vp = 2, vf = 1;
    for (int t = 0; t < NT; t += 2) {
        ATD_WAITBAR();
        { const int tk = t + 3 < NT ? t + 3 : NT - 1, tv = t + 1; ATD_K(tk, kf); ATD_V(tv, vf); }
        att_step<DQK>(pA0, pA1, pB0, pB1, qr, negm, o, m, l, pwB, pwA, wsf, kp0 + kn * ATT_KSLOT, vb0 + vp * ATT_VSLOT, r32, hi);
        ATD_ROT(kn); ATD_ROT(kf); ATD_ROT(vp); ATD_ROT(vf);
        ATD_WAITBAR();
        { const int tk = t + 4 < NT ? t + 4 : NT - 1, tv = t + 2 < NT ? t + 2 : NT - 1; ATD_K(tk, kf); ATD_V(tv, vf); }
        att_step<DQK>(pB0, pB1, pA0, pA1, qr, negm, o, m, l, pwA, pwB, wsf, kp0 + kn * ATT_KSLOT, vb0 + vp * ATT_VSLOT, r32, hi);
        ATD_ROT(kn); ATD_ROT(kf); ATD_ROT(vp); ATD_ROT(vf);
    }
    asm volatile("s_waitcnt vmcnt(0) lgkmcnt(0)\n\ts_barrier" ::: "memory");
    att_pv(o, vb0 + vp * ATT_VSLOT, __builtin_bit_cast(bf16x8, pwB[0]), __builtin_bit_cast(bf16x8, pwB[1]), __builtin_bit_cast(bf16x8, pwB[2]), __builtin_bit_cast(bf16x8, pwB[3]));
#undef ATD_K
#undef ATD_V
#undef ATD_WAITBAR
#undef ATD_ROT
    l += __shfl_xor(l, 32);
    if (hi == 0) wsf[32 + r32] = l;
    LAS bf16_t* stg = (LAS bf16_t*)(lds + ATD_OST) + wid * 2048;
#pragma unroll
    for (int r = 0; r < 16; ++r) { const int orow = crow(r, hi); const float rl = __builtin_amdgcn_rcpf(wsf[32 + orow]);
        stg[orow * 64 + r32] = (bf16_t)cvt_pk_bf16(o[0][r] * rl, 0.f); stg[orow * 64 + 32 + r32] = (bf16_t)cvt_pk_bf16(o[1][r] * rl, 0.f); }
    LDS_WAIT();
#pragma unroll
    for (int i = 0; i < 4; ++i) { const int row = i * 8 + (lane >> 3), ch = lane & 7; const u32x4 v = *(const LAS u32x4*)(stg + row * 64 + ch * 8);
        *(u32x4*)(u.O + (size_t)(qw0 + row) * u.os + ch * 8) = v; }
    asm volatile("s_waitcnt vmcnt(0) lgkmcnt(0)\n\ts_barrier" ::: "memory");
}

__device__ __forceinline__ void load4(const bf16_t* p, float (&v)[4]) { const u32x2 w = *(const u32x2*)p; v[0] = bf_lo(w.x); v[1] = bf_hi(w.x); v[2] = bf_lo(w.y); v[3] = bf_hi(w.y); }
__device__ __forceinline__ void store4(bf16_t* p, const float (&v)[4]) { u32x2 w; w.x = cvt_pk_bf16(v[0], v[1]); w.y = cvt_pk_bf16(v[2], v[3]); *(u32x2*)p = w; }

__device__ __forceinline__ int uq_map(int n) { const int h = n / 96, j = n - h * 96; if (j < 64) return n; const int jj = j - 64; return h * 96 + 64 + 2 * (jj & 15) + (jj >> 4); }
__device__ __forceinline__ void tr_item(const float* W, int ldw, int ncol0, int Nsub, bf16_t* WT, int ldt, int rbase, int rmul, int mode, LAS float* scr, int item, int lane0) {
    int lane = lane0; asm volatile("" : "+v"(lane));
    const int nblk = Nsub / 32, kb = item / nblk, nb = item - kb * nblk, k0 = 64 * kb, n0 = 32 * nb;
    { f32x4 v[8];
#pragma unroll
      for (int i = 0; i < 8; ++i) v[i] = *(const f32x4*)(W + (size_t)(k0 + 8 * i + (lane >> 3)) * ldw + ncol0 + n0 + 4 * (lane & 7));
#pragma unroll
      for (int i = 0; i < 8; ++i) { LAS float* d = scr + (8 * i + (lane >> 3)) * 33 + 4 * (lane & 7); d[0] = v[i][0]; d[1] = v[i][1]; d[2] = v[i][2]; d[3] = v[i][3]; } }
    LDS_WAIT();
    const int c = lane & 7;
#pragma unroll
    for (int j = 0; j < 4; ++j) { const int n = (lane >> 3) + 8 * j; const LAS float* s = scr + (8 * c) * 33 + n;
        u32x4 o; o.x = cvt_pk_bf16(s[0 * 33], s[1 * 33]); o.y = cvt_pk_bf16(s[2 * 33], s[3 * 33]); o.z = cvt_pk_bf16(s[4 * 33], s[5 * 33]); o.w = cvt_pk_bf16(s[6 * 33], s[7 * 33]);
        const int nn = n0 + n, dest = mode == 1 ? uq_map(nn) : (mode == 2 ? gate_map(nn) : (mode == 3 ? z_map(nn) : rbase + nn * rmul));
        *(u32x4*)(WT + (size_t)dest * ldt + k0 + 8 * c) = o; }
    LDS_WAIT();
}

__device__ __forceinline__ void tr_load(const float* W, int ldw, int Nsub, int item, int lane0, f32x4 (&v)[8]) {
    int lane = lane0; asm volatile("" : "+v"(lane));
    const int nblk = Nsub / 32, kb = item / nblk, nb = item - kb * nblk, k0 = 64 * kb, n0 = 32 * nb;
#pragma unroll
    for (int i = 0; i < 8; ++i) v[i] = *(const f32x4*)(W + (size_t)(k0 + 8 * i + (lane >> 3)) * ldw + n0 + 4 * (lane & 7));
}
__device__ __forceinline__ void tr_finish8(const f32x4 (&v)[8], int Nsub, unsigned char* WT, int ldt, int rbase, int rmul, float scale, LAS float* scr, int item, int lane0, int mode = 0) {
    int lane = lane0; asm volatile("" : "+v"(lane));
    const int nblk = Nsub / 32, kb = item / nblk, nb = item - kb * nblk, k0 = 64 * kb, n0 = 32 * nb;
#pragma unroll
    for (int i = 0; i < 8; ++i) { LAS float* d = scr + (8 * i + (lane >> 3)) * 33 + 4 * (lane & 7); d[0] = v[i][0]; d[1] = v[i][1]; d[2] = v[i][2]; d[3] = v[i][3]; }
    LDS_WAIT();
    const int c = lane & 7;
#pragma unroll
    for (int j = 0; j < 4; ++j) { const int n = (lane >> 3) + 8 * j; const LAS float* q = scr + (8 * c) * 33 + n;
        u32x2 o; o.x = cvt4_fp8(q[0 * 33] * scale, q[1 * 33] * scale, q[2 * 33] * scale, q[3 * 33] * scale); o.y = cvt4_fp8(q[4 * 33] * scale, q[5 * 33] * scale, q[6 * 33] * scale, q[7 * 33] * scale);
        const int nn = n0 + n, dest = mode == 1 ? gate_map(nn) : (mode == 2 ? z_map(nn) : rbase + nn * rmul);
        *(u32x2*)(WT + (size_t)dest * ldt + k0 + 8 * c) = o; }
    LDS_WAIT();
}
__device__ __forceinline__ void tr_item8(const float* W, int ldw, int Nsub, unsigned char* WT, int ldt, int rbase, int rmul, float scale, LAS float* scr, int item, int lane, int mode = 0) {
    f32x4 v[8]; tr_load(W, ldw, Nsub, item, lane, v); tr_finish8(v, Nsub, WT, ldt, rbase, rmul, scale, scr, item, lane, mode);
}

template <int ROPE, bool NORM>
__device__ __forceinline__ void head_compute(float (&v)[4], int lane, const f32x4 g, const f32x4 c, const f32x4 s, float scale) {
    const int jj = lane & 15;
    if (NORM) { float ss = (v[0] * v[0] + v[1] * v[1]) + (v[2] * v[2] + v[3] * v[3]);
        ss += __shfl_xor(ss, 1); ss += __shfl_xor(ss, 2); ss += __shfl_xor(ss, 4); ss += __shfl_xor(ss, 8);
        const float rs = rsqrtf(ss * (1.0f / 64.0f) + NORM_EPS);
#pragma unroll
        for (int e = 0; e < 4; ++e) v[e] *= rs * g[e]; }
    if (ROPE != 0) { const bool first = (ROPE == 1) ? ((jj & 4) == 0) : ((jj & 8) == 0);
#pragma unroll
        for (int e = 0; e < 4; ++e) { const float pe = __shfl_xor(v[e], ROPE == 1 ? 4 : 8); v[e] = first ? v[e] * c[e] - pe * s[e] : v[e] * c[e] + pe * s[e]; } }
#pragma unroll
    for (int e = 0; e < 4; ++e) v[e] *= scale;
}

struct PostArgs { bf16_t* z; bf16_t* ka; const float *c16, *s16, *qa_g, *kva_g, *bq_g, *bk_g; };
struct PostRegs { float v[5][4]; f32x4 cax, sax, ckr, skr; };
struct PostGains { f32x4 qa, kva, bq, bk; };
__device__ __forceinline__ PostGains post_gains(const PostArgs a, int lane) { PostGains g; g.qa = *(const f32x4*)(a.qa_g + 4 * lane); g.kva = *(const f32x4*)(a.kva_g + 4 * (lane & 31));
    g.bq = *(const f32x4*)(a.bq_g + 4 * (lane & 15)); g.bk = *(const f32x4*)(a.bk_g + 4 * (lane & 15)); return g; }
__device__ __forceinline__ void post_load(const PostArgs a, int row, int lane, PostRegs& p) {
    const bf16_t* zr = a.z + (size_t)row * ZP; const int t = row & (SEQ - 1), trow = t >> 6, tcol = t & 63, jj = lane & 15; const bool h32 = lane < 32;
#pragma unroll
    for (int i = 0; i < 5; ++i) { p.v[i][0] = 0.f; p.v[i][1] = 0.f; p.v[i][2] = 0.f; p.v[i][3] = 0.f; }
    load4(zr + 4 * lane, p.v[0]);
    if (h32) load4(zr + 256 + 4 * lane, p.v[1]);
    if (lane < 8) load4(zr + 384 + 4 * lane, p.v[2]);
    load4(zr + ZC_B + 4 * lane, p.v[3]);
    if (h32) load4(zr + ZC_B + 256 + 4 * lane, p.v[4]);
    const int pax = (jj < 8) ? trow : tcol;
    p.cax = *(const f32x4*)(a.c16 + pax * 16 + 4 * (jj & 3)); p.sax = *(const f32x4*)(a.s16 + pax * 16 + 4 * (jj & 3));
    p.ckr = *(const f32x4*)(a.c16 + t * 16 + 4 * (lane & 3)); p.skr = *(const f32x4*)(a.s16 + t * 16 + 4 * (lane & 3));
}
__device__ __forceinline__ void post_finish(const PostArgs a, const PostGains& pg, int row, int lane, PostRegs& p) {
    bf16_t* zr = a.z + (size_t)row * ZP; const float QS = 0.125f * LOG2E; const bool h32 = lane < 32;
    float (&v)[5][4] = p.v; const f32x4 cax = p.cax, sax = p.sax, ckr = p.ckr, skr = p.skr;
    { const float ss = wave_sum((v[0][0] * v[0][0] + v[0][1] * v[0][1]) + (v[0][2] * v[0][2] + v[0][3] * v[0][3])); const float rs = rsqrtf(ss * (1.0f / 256.0f) + NORM_EPS); const f32x4 g = pg.qa;
#pragma unroll
      for (int e = 0; e < 4; ++e) v[0][e] *= rs * g[e]; }
    { float ss = (v[1][0] * v[1][0] + v[1][1] * v[1][1]) + (v[1][2] * v[1][2] + v[1][3] * v[1][3]);
      ss += __shfl_xor(ss, 1); ss += __shfl_xor(ss, 2); ss += __shfl_xor(ss, 4); ss += __shfl_xor(ss, 8); ss += __shfl_xor(ss, 16);
      const float rs = rsqrtf(ss * (1.0f / 128.0f) + NORM_EPS); const f32x4 g = pg.kva;
#pragma unroll
      for (int e = 0; e < 4; ++e) v[1][e] *= rs * g[e]; }
    float okr[8];
#pragma unroll
    for (int e = 0; e < 4; ++e) { const float pe = __shfl_xor(v[2][e], 4); okr[2 * e] = v[2][e] * ckr[e] - pe * skr[e]; okr[2 * e + 1] = pe * ckr[e] + v[2][e] * skr[e]; }
    head_compute<1, true>(v[3], lane, pg.bq, cax, sax, QS);
    head_compute<1, true>(v[4], lane, pg.bk, cax, sax, 1.0f);
    store4(zr + 4 * lane, v[0]);
    if (h32) store4(zr + 256 + 4 * lane, v[1]);
    if (lane < 4) { const u32x4 w = pack8(okr); bf16_t* kr = a.ka + (size_t)row * 384 + 64 + 8 * lane;
#pragma unroll
        for (int h = 0; h < 4; ++h) *(u32x4*)(kr + h * 96) = w; }
    store4(zr + ZC_B + 4 * lane, v[3]);
    if (h32) store4(zr + ZC_B + 256 + 4 * lane, v[4]);
}

struct RowsArgs {
    const float* xin; const bf16_t* xin_bf; float* xout; const bf16_t* tsrc; const bf16_t* y; const int* tokrow; const float* gpost;
    bf16_t* hout; const float* gnext; bf16_t* xbout;
    const float* router_b; int* ti_e; int* ti_p0; int* ti_p1; float* ti_g0; float* ti_g1; int do_router; int h_fp8; unsigned char* hout8; unsigned char* xb8out;
};
__device__ __forceinline__ void rows_load(const RowsArgs a, int row, int lane, f32x4 (&x)[4], float (&tv)[4][4]) {
    if (a.xin != nullptr) { const f32x4* xr = (const f32x4*)(a.xin + (size_t)row * DM) + lane;
#pragma unroll
        for (int j = 0; j < 4; ++j) x[j] = xr[64 * j]; }
    else {
#pragma unroll
        for (int j = 0; j < 4; ++j) { float v[4]; load4(a.xin_bf + (size_t)row * DM + 256 * j + 4 * lane, v); x[j] = (f32x4){v[0], v[1], v[2], v[3]}; } }
    if (a.y == nullptr) {
#pragma unroll
        for (int j = 0; j < 4; ++j) load4(a.tsrc + (size_t)row * DM + 256 * j + 4 * lane, tv[j]);
    } else {
        const int r0 = a.tokrow[2 * row], r1 = a.tokrow[2 * row + 1];
#pragma unroll
        for (int j = 0; j < 4; ++j) { float p[4], q[4]; load4(a.y + (size_t)r0 * DM + 256 * j + 4 * lane, p); load4(a.y + (size_t)r1 * DM + 256 * j + 4 * lane, q);
#pragma unroll
            for (int e = 0; e < 4; ++e) tv[j][e] = p[e] + q[e]; }
    }
}
struct RowGains { f32x4 gp[4], gn[4]; };
__device__ __forceinline__ RowGains rows_gains(const RowsArgs a, int lane) { RowGains g;
#pragma unroll
    for (int j = 0; j < 4; ++j) { g.gp[j] = *((const f32x4*)a.gpost + 64 * j + lane); g.gn[j] = (a.gnext != nullptr) ? *((const f32x4*)a.gnext + 64 * j + lane) : (f32x4){0.f, 0.f, 0.f, 0.f}; }
    return g; }
__device__ __forceinline__ void rows_finish(const RowsArgs a, const RowGains& rg, int row, int lane, f32x4 (&x)[4], float (&tv)[4][4], LAS float* wr_lds, LAS int* cnt_lds) {
    float ss = 0.f;
#pragma unroll
    for (int j = 0; j < 4; ++j) ss += (tv[j][0] * tv[j][0] + tv[j][1] * tv[j][1]) + (tv[j][2] * tv[j][2] + tv[j][3] * tv[j][3]);
    const float rs = rsqrtf(wave_sum(ss) * (1.0f / DM) + NORM_EPS);
    float s2 = 0.f;
#pragma unroll
    for (int j = 0; j < 4; ++j) { const f32x4 g = rg.gp[j];
#pragma unroll
        for (int e = 0; e < 4; ++e) { x[j][e] += tv[j][e] * rs * g[e]; s2 += x[j][e] * x[j][e]; } }
    if (a.xout != nullptr) { f32x4* xo = (f32x4*)(a.xout + (size_t)row * DM) + lane;
#pragma unroll
        for (int j = 0; j < 4; ++j) xo[64 * j] = x[j]; }
    if (a.xbout != nullptr) {
#pragma unroll
        for (int j = 0; j < 4; ++j) { const float v[4] = {x[j][0], x[j][1], x[j][2], x[j][3]}; store4(a.xbout + (size_t)row * DM + 256 * j + 4 * lane, v);
            if (a.xb8out != nullptr) *(unsigned*)(a.xb8out + (size_t)row * DM + 256 * j + 4 * lane) = cvt4_fp8(v[0], v[1], v[2], v[3]); }
    }
    if (a.hout != nullptr) {
        const float rs2 = rsqrtf(wave_sum(s2) * (1.0f / DM) + NORM_EPS);
        float lg[NE];
#pragma unroll
        for (int e = 0; e < NE; ++e) lg[e] = 0.f;
#pragma unroll
        for (int j = 0; j < 4; ++j) { const f32x4 g = rg.gn[j]; float v[4];
#pragma unroll
            for (int e = 0; e < 4; ++e) v[e] = x[j][e] * rs2 * g[e];
            if (a.h_fp8) *(unsigned*)((unsigned char*)a.hout + (size_t)row * DM + 256 * j + 4 * lane) = cvt4_fp8(v[0], v[1], v[2], v[3]);
            else store4(a.hout + (size_t)row * DM + 256 * j + 4 * lane, v);
            if (a.hout8 != nullptr) *(unsigned*)(a.hout8 + (size_t)row * DM + 256 * j + 4 * lane) = cvt4_fp8(v[0], v[1], v[2], v[3]);
            if (a.do_router) {
#pragma unroll
                for (int e = 0; e < 4; ++e) { const LAS f32x4* w = (const LAS f32x4*)(wr_lds + (256 * j + 4 * lane + e) * NE); const f32x4 w0 = w[0], w1 = w[1];
                    lg[0] += v[e] * w0[0]; lg[1] += v[e] * w0[1]; lg[2] += v[e] * w0[2]; lg[3] += v[e] * w0[3]; lg[4] += v[e] * w1[0]; lg[5] += v[e] * w1[1]; lg[6] += v[e] * w1[2]; lg[7] += v[e] * w1[3]; } } }
        if (a.do_router) {
#pragma unroll
            for (int e = 0; e < NE; ++e) lg[e] = wave_sum(lg[e]) + a.router_b[e];
            int e0 = 0; float v0 = lg[0];
#pragma unroll
            for (int e = 1; e < NE; ++e) if (lg[e] > v0) { v0 = lg[e]; e0 = e; }
            int e1 = -1; float v1 = -INFINITY;
#pragma unroll
            for (int e = 0; e < NE; ++e) if (e != e0 && lg[e] > v1) { v1 = lg[e]; e1 = e; }
            const float ex = __expf(v1 - v0), g0 = 1.0f / (1.0f + ex), g1 = ex * g0;
            if (lane == 0) { const int p0 = __hip_atomic_fetch_add(cnt_lds + e0, 1, __ATOMIC_RELAXED, __HIP_MEMORY_SCOPE_WORKGROUP), p1 = __hip_atomic_fetch_add(cnt_lds + e1, 1, __ATOMIC_RELAXED, __HIP_MEMORY_SCOPE_WORKGROUP);
                a.ti_e[row] = e0 | (e1 << 8) | ((int)blockIdx.x << 16); a.ti_p0[row] = p0; a.ti_p1[row] = p1; a.ti_g0[row] = g0; a.ti_g1[row] = g1; }
        }
    }
}

constexpr int NWAVES = 8;
constexpr int RING_BYTES = 131072, LDSCTL_OFF = RING_BYTES, MISC_OFF = LDSCTL_OFF + 320, LDS_BYTES = 149504;
constexpr int PH_STRIDE = 25, N_PHASES = 1 + PH_STRIDE * DEPTH;
struct Params { const float* in[27]; float* out; unsigned char* ws; int ph_lo, ph_hi; };

#define IN(k) (lo <= (k) && (k) < hi)
#ifndef SEAMREP
#define SEAMREP 1
#endif
#define SEAM(k) do { if (lo <= (k) && (k) + 1 < hi) { for (int sr_ = 0; sr_ < SEAMREP; ++sr_) xcd_barrier(bar); } } while (0)
#define PH_IDS int tid = threadIdx.x; asm volatile("" : "+v"(tid)); const int lane = tid & 63, wave = __builtin_amdgcn_readfirstlane(tid >> 6), gw = bx * NWAVES + wave; (void)lane; (void)wave; (void)gw;
constexpr int I_IN1 = 16 * 117, I_IN2 = 16 * 128, I_WB = 512, I_WO = 512, I_PG = 512, I_WP = 128, I_UQ = 48, I_UKV = 32;
constexpr int IL = I_IN1 + I_IN2 + I_WB + I_WO + I_PG + I_WP + I_UQ + I_UKV, I_F = 2048, I_UQOFF = IL - I_UQ - I_UKV;
constexpr int W_EARLY = I_IN1 + I_UQ + I_UKV, W_L0REST = IL - W_EARLY, W_ALL = 2 * IL + 3 * I_F;
constexpr int I_E = 16 * 112, MOE_ITEMS = NE * 3 * I_E;
__device__ __forceinline__ void w_layer_item(const Params& P, unsigned char* ws, LAS float* scr, int l, int r, int lane) {
    if (r < I_IN1) { if (l == FP8_IN_LAYER) tr_item8(P.in[2] + (size_t)l * DM * IN_COLS, IN_COLS, ZN, ws + WS_WIN + l * WIN_L, DM, 0, 1, 32.0f, scr, r, lane, 2);
                     else tr_item(P.in[2] + (size_t)l * DM * IN_COLS, IN_COLS, 0, ZN, (bf16_t*)(ws + WS_WIN + l * WIN_L), DM, 0, 1, 3, scr, r, lane); return; } r -= I_IN1;
    if (r < I_IN2) { if (gate_fp8(l)) tr_item8(P.in[2] + (size_t)l * DM * IN_COLS + ZN, IN_COLS, 4096, ws + WS_WG + l * WG_L, DM, 0, 1, 32.0f, scr, r, lane, 1);
                     else tr_item(P.in[2] + (size_t)l * DM * IN_COLS, IN_COLS, ZN, 4096, (bf16_t*)(ws + WS_WG + l * WG_L), DM, 0, 1, 2, scr, r, lane); return; } r -= I_IN2;
    if (r < I_WB) { const int n = r >> 7; tr_item(P.in[10] + (size_t)(l * 4 + n) * 256 * DM, DM, 0, DM, (bf16_t*)(ws + WS_WB + l * WB_L), 256, n * DM, 1, 0, scr, r & 127, lane); return; } r -= I_WB;
    if (r < I_WO) { tr_item(P.in[11] + (size_t)l * DM * DM, DM, 0, DM, (bf16_t*)(ws + WS_WOUT + l * WOUT_L), DM, 0, 1, 0, scr, r, lane); return; } r -= I_WO;
    if (r < I_PG) { if (FP8_PLE) tr_item8(P.in[25] + (size_t)l * DM * DM, DM, DM, ws + WS_WPG + l * WPG_L, DM, 0, 1, 32.0f, scr, r, lane); else tr_item(P.in[25] + (size_t)l * DM * DM, DM, 0, DM, (bf16_t*)(ws + WS_WPG + l * WPG_L), DM, 0, 1, 0, scr, r, lane); return; } r -= I_PG;
    if (r < I_WP) { tr_item(P.in[24] + (size_t)l * 256 * DM, DM, 0, DM, (bf16_t*)(ws + WS_WP + l * WP_L), 256, 0, 1, 0, scr, r, lane); return; } r -= I_WP;
    if (r < I_UQ) { tr_item(P.in[5] + (size_t)l * 256 * 384, 384, 0, 384, (bf16_t*)(ws + WS_WUQ + l * WUQ_L), 256, 0, 1, 1, scr, r, lane); return; } r -= I_UQ;
    tr_item(P.in[6] + (size_t)l * 128 * 512, 512, 0, 512, (bf16_t*)(ws + WS_WUKV + l * WUKV_L), 256, 0, 1, 0, scr, r, lane);
}
__device__ __forceinline__ void w_item(const Params& P, unsigned char* ws, LAS float* scr, int it, int lane) {
    if (it < W_EARLY) { w_layer_item(P, ws, scr, 0, it < I_IN1 ? it : I_UQOFF + (it - I_IN1), lane); return; }
    it -= W_EARLY;
    if (it < W_L0REST) { w_layer_item(P, ws, scr, 0, I_IN1 + it, lane); return; }
    it -= W_L0REST;
    if (it < IL) { w_layer_item(P, ws, scr, 1, it, lane); return; }
    it -= IL;
    if (it < I_F) { tr_item(P.in[16], DFF, 0, DFF, (bf16_t*)(ws + WS_FGU), DM, 0, 2, 0, scr, it, lane); return; } it -= I_F;
    if (it < I_F) { tr_item(P.in[17], DFF, 0, DFF, (bf16_t*)(ws + WS_FGU), DM, 1, 2, 0, scr, it, lane); return; } it -= I_F;
    if (FP8_DENSE_DOWN) tr_item8(P.in[18], DM, DM, ws + WS_FD, DFF, 0, 1, 64.0f, scr, it, lane); else tr_item(P.in[18], DM, 0, DM, (bf16_t*)(ws + WS_FD), DFF, 0, 1, 0, scr, it, lane);
}
__device__ __forceinline__ unsigned char* moe_gu_ptr(const Params& P, unsigned char* ws, int e) { return e < MOE_ESPLIT ? (unsigned char*)P.out + MOEW_GU + (size_t)e * MGU_E : ws + WS_MGU_HI + (size_t)(e - MOE_ESPLIT) * MGU_E; }
__device__ __forceinline__ void moe_load(const Params& P, int lj, int it, int lane, f32x4 (&v)[8]) {
    const int e = it / (3 * I_E); int r = it - e * (3 * I_E);
    if (r < I_E) { tr_load(P.in[21] + ((size_t)lj * NE + e) * DM * MFF, MFF, MFF, r, lane, v); return; } r -= I_E;
    if (r < I_E) { tr_load(P.in[22] + ((size_t)lj * NE + e) * DM * MFF, MFF, MFF, r, lane, v); return; } r -= I_E;
    tr_load(P.in[23] + ((size_t)lj * NE + e) * MFF * DM, DM, DM, r, lane, v);
}
__device__ __forceinline__ void moe_finish(const Params& P, unsigned char* ws, LAS float* scr, int it, int lane, const f32x4 (&v)[8]) {
    const int e = it / (3 * I_E); int r = it - e * (3 * I_E);
    if (r < I_E) { tr_finish8(v, MFF, moe_gu_ptr(P, ws, e), DM, 0, 2, 32.0f, scr, r, lane); return; } r -= I_E;
    if (r < I_E) { tr_finish8(v, MFF, moe_gu_ptr(P, ws, e), DM, 1, 2, 32.0f, scr, r, lane); return; } r -= I_E;
    tr_finish8(v, DM, (unsigned char*)P.out + MOEW_MD + (size_t)e * MD_E, MFF, 0, 1, 64.0f, scr, r, lane);
}
__device__ __forceinline__ void moe_item(const Params& P, unsigned char* ws, LAS float* scr, int lj, int it, int lane) {
    const int e = it / (3 * I_E); int r = it - e * (3 * I_E);
    if (r < I_E) { tr_item8(P.in[21] + ((size_t)lj * NE + e) * DM * MFF, MFF, MFF, moe_gu_ptr(P, ws, e), DM, 0, 2, 32.0f, scr, r, lane); return; } r -= I_E;
    if (r < I_E) { tr_item8(P.in[22] + ((size_t)lj * NE + e) * DM * MFF, MFF, MFF, moe_gu_ptr(P, ws, e), DM, 1, 2, 32.0f, scr, r, lane); return; } r -= I_E;
    tr_item8(P.in[23] + ((size_t)lj * NE + e) * MFF * DM, DM, DM, (unsigned char*)P.out + MOEW_MD + (size_t)e * MD_E, MFF, 0, 1, 64.0f, scr, r, lane);
}

template <int l>
__device__ __forceinline__ void layer_body(const Params P, LAS unsigned char* lds, const XcdBarrier bar, const int lo, const int hi, const int G, const int bx, const int vcu, const int NGW, unsigned char* ws_in, unsigned* ctl) {
    unsigned char* ws = ws_in;
    const float* c16 = (const float*)(ws + WS_COS16); const float* s16 = (const float*)(ws + WS_SIN16);
    const float* c32 = (const float*)(ws + WS_COS32); const float* s32 = (const float*)(ws + WS_SIN32);
    bf16_t* const H = (bf16_t*)(ws + WS_H); bf16_t* const Z = (bf16_t*)(ws + WS_Z);
    bf16_t* const QA = (bf16_t*)(ws + WS_QA); bf16_t* const KA = (bf16_t*)(ws + WS_KA); bf16_t* const VA = (bf16_t*)(ws + WS_VA);
    bf16_t* const OCAT = (bf16_t*)(ws + WS_OCAT);
    bf16_t* const PB = (bf16_t*)(ws + WS_PB); bf16_t* const MERGED = (bf16_t*)(ws + WS_MERGED); bf16_t* const MIX = (bf16_t*)(ws + WS_MIX); bf16_t* const H2 = (bf16_t*)(ws + WS_H2);
    bf16_t* const HID = (bf16_t*)(ws + WS_HID); bf16_t* const FB = (bf16_t*)(ws + WS_FB); bf16_t* const XB = (bf16_t*)(ws + WS_XB); bf16_t* const PP = (bf16_t*)(ws + WS_PP);
    bf16_t* const PBF = (bf16_t*)(ws + WS_PBF);
    bf16_t* const MGU = (bf16_t*)(ws + WS_MGU); bf16_t* const MD = (bf16_t*)(ws + WS_MD); bf16_t* const Y = (bf16_t*)(ws + WS_Y); bf16_t* const XG = (bf16_t*)(ws + WS_XG); bf16_t* const HIDC = (bf16_t*)(ws + WS_HIDC);
    int* const rowtok = (int*)(ws + WS_ROWTOK); int* const tokrow = (int*)(ws + WS_TOKROW); float* const rowg = (float*)(ws + WS_ROWG); int* const wgbase = (int*)(ws + WS_WGBASE);
    int* const ti_e = (int*)(ws + WS_TI_E); int* const ti_p0 = (int*)(ws + WS_TI_P0); int* const ti_p1 = (int*)(ws + WS_TI_P1); float* const ti_g0 = (float*)(ws + WS_TI_G0); float* const ti_g1 = (float*)(ws + WS_TI_G1);

        const int pb = 1 + PH_STRIDE * l; constexpr bool moe = (l & 1) != 0; constexpr int lj = l >> 1;
        const bf16_t* Win_t = (const bf16_t*)(ws + WS_WIN + l * WIN_L); const bf16_t* Wg_t = (const bf16_t*)(ws + WS_WG + l * WG_L);
        const bf16_t* Wb_t = (const bf16_t*)(ws + WS_WB + l * WB_L); const bf16_t* Wout_t = (const bf16_t*)(ws + WS_WOUT + l * WOUT_L);
        const bf16_t* Wpg_t = (const bf16_t*)(ws + WS_WPG + l * WPG_L); const bf16_t* Wp_t = (const bf16_t*)(ws + WS_WP + l * WP_L);
        const bf16_t* Wuq_t = (const bf16_t*)(ws + WS_WUQ + l * WUQ_L); const bf16_t* Wukv_t = (const bf16_t*)(ws + WS_WUKV + l * WUKV_L);

        constexpr int CQ = moe ? 4 : 1, CTOT = moe ? MOE_ITEMS : (l == 0 ? W_ALL - W_EARLY : 0), TQ = moe ? 3 : 8;
        const int m1rem = ((M / 256) * (ZP / 256)) % G, tailw = m1rem ? (G - m1rem) * NWAVES : 0;
        const int CT_A = (tailw * TQ * CQ < CTOT) ? CTOT - tailw * TQ * CQ : 0;
        if (PHEN(1) && IN(pb + 0)) DUPREP(1) {
            if constexpr (l == FP8_IN_LAYER) { pg8::Gemm g{(const bf16_t*)(ws + WS_H8), Win_t, DM, DM, DM}; pg8::GridOrder S{M / 256, ZP / 256, G, bx, DM, DM, 1}; pg8::Epi8<FIn> E{{Z, c32, s32, 1.0f / 32.0f}}; pg8::gemm_phase<pg8::Epi8<FIn>, pg8::GridOrder, true>(lds, g, S, E); }
            else { pg8::Gemm g{H, Win_t, DM, DM, DM}; pg8::GridOrder S{M / 256, ZP / 256, G, bx, DM, DM, 2}; pg8::Epi8<FIn> E{{Z, c32, s32, 1.0f}}; pg8::gemm_phase(lds, g, S, E); }
            if (rep_ == 0 && m1rem != 0 && bx >= m1rem && CTOT > 0) { PH_IDS
                LAS float* tscr = (LAS float*)(lds + wave * 16384); const int tw = (bx - m1rem) * NWAVES + wave;
                for (int b = 0; b < TQ; ++b) {
                    if constexpr (moe) { f32x4 cv_[CQ][8];
#pragma unroll
                        for (int k_ = 0; k_ < CQ; ++k_) { const int it_ = CT_A + (b * CQ + k_) * tailw + tw; moe_load(P, lj, it_ < CTOT ? it_ : CTOT - 1, lane, cv_[k_]); }
#pragma unroll
                        for (int k_ = 0; k_ < CQ; ++k_) { const int it_ = CT_A + (b * CQ + k_) * tailw + tw; if (it_ < CTOT) moe_finish(P, ws, tscr, it_, lane, cv_[k_]); } }
                    else { const int it_ = CT_A + b * tailw + tw; if (it_ < CTOT) w_item(P, ws, tscr, W_EARLY + it_, lane); } } } }
        SEAM(pb + 0);
        if (PHEN(2) && IN(pb + 1)) { PH_IDS
            const PostArgs a{Z, KA, c16, s16, P.in[3] + l * 256, P.in[4] + l * 128, P.in[7] + l * 64, P.in[8] + l * 64};
            const PostGains pg = post_gains(a, lane);
            for (int row = gw; row < M; row += 4 * NGW) {
                PostRegs pr_[4];
#pragma unroll
                for (int k = 0; k < 4; ++k) { const int rk = row + k * NGW < M ? row + k * NGW : row; post_load(a, M - 1 - rk, lane, pr_[k]); }
#pragma unroll
                for (int k = 0; k < 4; ++k) if (row + k * NGW < M) post_finish(a, pg, M - 1 - (row + k * NGW), lane, pr_[k]); }
        }
        SEAM(pb + 1);
        if (PHEN(3) && IN(pb + 2)) DUPREP(3) {
            { pg8::Gemm g{Z, Wuq_t, ZP, 256, 256}; pg8::GridOrder S{M / 256, 2, G, bx, ZP, 256, 2}; pg8::Epi8<FUq> E{{QA, c16, s16, 0.10206207261596577f * LOG2E}}; pg8::gemm_phase(lds, g, S, E); }
            { pg8::Gemm g{Z + 256, Wukv_t, ZP, 256, 256}; pg8::GridOrder S{M / 256, 2, G, bx, ZP, 256, 2}; pg8::Epi8<FUkv> E{{KA, VA}}; pg8::gemm_phase(lds, g, S, E); }
        }
        SEAM(pb + 2);
        if (PHEN(4) && IN(pb + 3)) { PH_IDS DUPREP(4) {
            LAS float* cscr = (LAS float*)(lds + wave * 16384); int cslot = 0;
#define CONV_SLOT() do { if (rep_ == 0 && (cslot == 0 || cslot * CQ * NGW < CT_A)) { \
                if constexpr (moe) { f32x4 cv_[CQ][8]; \
                    _Pragma("unroll") for (int k_ = 0; k_ < CQ; ++k_) { const int it_ = (cslot * CQ + k_) * NGW + gw; moe_load(P, lj, it_ < CT_A ? it_ : (CT_A > 0 ? CT_A - 1 : 0), lane, cv_[k_]); } \
                    _Pragma("unroll") for (int k_ = 0; k_ < CQ; ++k_) { const int it_ = (cslot * CQ + k_) * NGW + gw; if (it_ < CT_A) moe_finish(P, ws, cscr, it_, lane, cv_[k_]); } } \
                else { const int it_ = cslot * NGW + gw; if (it_ < CT_A) w_item(P, ws, cscr, W_EARLY + it_, lane); } \
                if (cslot == 0) { const int gt_ = bx * (NWAVES * 64) + tid, NGT_ = G * NWAVES * 64; const float* pl_ = P.in[1] + (size_t)l * M * 256;        \
                    for (int i_ = gt_; i_ < M * 256 / 8; i_ += NGT_) { const f32x4 a0 = *((const f32x4*)pl_ + 2 * i_), a1 = *((const f32x4*)pl_ + 2 * i_ + 1); const float v_[8] = {a0[0], a0[1], a0[2], a0[3], a1[0], a1[1], a1[2], a1[3]}; *((u32x4*)PBF + i_) = pack8(v_); } } \
                ++cslot; __syncthreads(); } } while (0)
            for (int id = vcu; id < 512; id += G) {
                const int bh = id >> 5, qb = id & 31, b = bh >> 2, h = bh & 3; const size_t r0 = (size_t)b * SEQ;
                AttnDesc d; d.Q = QA + r0 * 384 + h * 96; d.K = KA + r0 * 384 + h * 96; d.V = VA + r0 * 256 + h * 64; d.O = OCAT + r0 * DM + h * 64; d.lse = nullptr;
                d.qs = 384; d.ks = 384; d.vs = 256; d.os = DM; d.lss = 0; d.q0 = qb * 256; d.L = SEQ; d.band = -1; d.m0 = -1e30f; d.l0 = 0.f;
                attn_dense<96>(lds, d); CONV_SLOT(); }
            for (int id = vcu; id < 512; id += G) {
                const int bh = id >> 5, qb = id & 31, b = bh >> 2, h = bh & 3; const size_t r0 = (size_t)b * SEQ;
                AttnDesc d; d.lse = nullptr; d.lss = 0; d.m0 = -1e30f; d.l0 = 0.f;
                d.Q = Z + r0 * ZP + ZC_B + h * 64; d.K = Z + r0 * ZP + ZC_B + 256 + (h >> 1) * 64; d.V = Z + r0 * ZP + ZC_B + 384 + (h >> 1) * 64; d.O = OCAT + r0 * DM + 256 + h * 64;
                d.qs = ZP; d.ks = ZP; d.vs = ZP; d.os = DM; d.q0 = qb * 256; d.L = SEQ; d.band = -1;
                attn_dense<64>(lds, d); CONV_SLOT(); }
            for (int id = vcu + 512; id < 2560; id += G) {
                AttnDesc d; d.lse = nullptr; d.lss = 0; d.m0 = -1e30f; d.l0 = 0.f;
                if (id < 512) { const int bh = id >> 5, qb = id & 31, b = bh >> 2, h = bh & 3; const size_t r0 = (size_t)b * SEQ;
                    d.Q = Z + r0 * ZP + ZC_B + h * 64; d.K = Z + r0 * ZP + ZC_B + 256 + (h >> 1) * 64; d.V = Z + r0 * ZP + ZC_B + 384 + (h >> 1) * 64; d.O = OCAT + r0 * DM + 256 + h * 64;
                    d.qs = ZP; d.ks = ZP; d.vs = ZP; d.os = DM; d.q0 = qb * 256; d.L = SEQ; d.band = -1; }
                else if (id < 2048) { const int cid = id - 512, gi = cid >> 9, rem = cid & 511, b = rem >> 7, h = (rem >> 5) & 3, blk = rem & 31;
                    const int dsh = 2 * gi, dil = 1 << dsh, ls = SEQ >> dsh, bpc = ls >> 8, cls = blk / bpc, ub = blk - cls * bpc; const size_t r0 = (size_t)b * SEQ + cls;
                    const bf16_t* zb = Z + r0 * ZP + ZC_C + gi * 768 + h * 64;
                    d.Q = zb; d.K = zb + 256; d.V = zb + 512; d.O = (bf16_t*)(ws + WS_OCG + gi * OCG_G) + r0 * 256 + h * 64; d.lse = (float*)(ws + WS_LG + gi * LG_G) + r0 * 4 + h;
                    d.qs = dil * ZP; d.ks = dil * ZP; d.vs = dil * ZP; d.os = dil * 256; d.lss = dil * 4; d.q0 = ub * 256; d.L = ls; d.band = 64; }
                else { const int did = id - 2048, bh = did >> 5, qb = did & 31, b = bh >> 2, h = bh & 3; const size_t r0 = (size_t)b * SEQ;
                    d.Q = Z + r0 * ZP + ZC_D + h * 64; d.K = Z + r0 * ZP + ZC_D + 256 + (h >> 1) * 64; d.V = Z + r0 * ZP + ZC_D + 384 + (h >> 1) * 64; d.O = OCAT + r0 * DM + 768 + h * 64;
                    d.qs = ZP; d.ks = ZP; d.vs = ZP; d.os = DM; d.q0 = qb * 256; d.L = SEQ; d.band = 128; d.m0 = P.in[9][l * 4 + h] * LOG2E; d.l0 = 1.f; }
                attn_unit<64>(lds, d); CONV_SLOT(); }
            while (rep_ == 0 && (cslot == 0 || cslot * CQ * NGW < CT_A)) CONV_SLOT();
#undef CONV_SLOT
        } }
        SEAM(pb + 3);
        if (PHEN(5) && IN(pb + 4)) { PH_IDS DUPREP(5) {
            for (int row0 = gw; row0 < M; row0 += 4 * NGW) { const int hd = lane >> 4;
                float L[4][3]; u32x2 vr[4][3];
#pragma unroll
                for (int k = 0; k < 4; ++k) { const int row = row0 + k * NGW < M ? row0 + k * NGW : row0;
#pragma unroll
                    for (int g = 0; g < 3; ++g) { L[k][g] = ((const float*)(ws + WS_LG + g * LG_G))[(size_t)row * 4 + hd]; vr[k][g] = *(const u32x2*)((const bf16_t*)(ws + WS_OCG + g * OCG_G) + (size_t)row * 256 + 4 * lane); } }
#pragma unroll
                for (int k = 0; k < 4; ++k) { const int row = row0 + k * NGW; if (row < M) {
                    const float mx = fmaxf(L[k][0], fmaxf(L[k][1], L[k][2])); float w[3], sw = 0.f, o[4] = {0.f, 0.f, 0.f, 0.f};
#pragma unroll
                    for (int g = 0; g < 3; ++g) { w[g] = __builtin_amdgcn_exp2f(L[k][g] - mx); sw += w[g]; }
                    const float inv = 1.0f / sw;
#pragma unroll
                    for (int g = 0; g < 3; ++g) { const float v[4] = {bf_lo(vr[k][g].x), bf_hi(vr[k][g].x), bf_lo(vr[k][g].y), bf_hi(vr[k][g].y)};
#pragma unroll
                        for (int e = 0; e < 4; ++e) o[e] += w[g] * inv * v[e]; }
                    store4(OCAT + (size_t)row * DM + 512 + 4 * lane, o); } } }
        } }
        SEAM(pb + 4);
        if (PHEN(6) && IN(pb + 5)) DUPREP(6) { pg8::Gemm g{OCAT, Wb_t, DM, 256, 256}; pg8::BranchOrder S{G, bx}; pg8::Epi8<FStoreP> E{{PB}}; pg8::gemm_phase(lds, g, S, E); }
        SEAM(pb + 5);
        if (PHEN(7) && IN(pb + 6)) DUPREP(7) {
            if constexpr (gate_fp8(l)) { pg8::Gemm g{(const bf16_t*)(ws + WS_H8), Wg_t, DM, DM, DM}; pg8::GridOrder S{M / 256, 16, G, bx, DM, DM, 1, 1}; pg8::Epi8<FGate> E{{PB, MERGED, 1.0f / 32.0f}}; pg8::gemm_phase<pg8::Epi8<FGate>, pg8::GridOrder, true>(lds, g, S, E); }
            else { pg8::Gemm g{H, Wg_t, DM, DM, DM}; pg8::GridOrder S{M / 256, 16, G, bx, DM, DM, 2}; pg8::Epi8<FGate> E{{PB, MERGED, 1.0f}}; pg8::gemm_phase(lds, g, S, E); } }
        SEAM(pb + 6);
        const bool fuse = (G % 8 == 0);
        if (PHEN(8) && IN(pb + 7)) DUPREP(8) { pg8::Gemm g{MERGED, Wout_t, DM, DM, DM};
            if (fuse && !moe) { pg8::PanelOrder S{G, vcu, DM, DM, 2}; pg8::Epi8<FMixRes<l == 0>> E{{ws, P.in[0], (bf16_t*)P.out, P.in[13] + l * DM, P.in[14] + l * DM, l * 5 + 0}}; pg8::gemm_phase(lds, g, S, E); }
            else { pg8::GridOrder S{M / 256, 4, G, bx, DM, DM, 2}; pg8::Epi8<FStore> E{{MIX, DM}}; pg8::gemm_phase(lds, g, S, E); } }
        SEAM(pb + 7);
        if (PHEN(9) && IN(pb + 8) && !(fuse && !moe)) { PH_IDS
            LAS float* wr_lds = (LAS float*)lds; LAS int* cnt_lds = (LAS int*)(lds + RING_BYTES - 64);
            if (moe) { for (int i = tid; i < DM * NE; i += NWAVES * 64) wr_lds[i] = P.in[19][(size_t)lj * DM * NE + i]; if (tid < NE) cnt_lds[tid] = 0; __syncthreads(); }
            RowsArgs a; a.xb8out = nullptr; a.xin = (l == 0) ? P.in[0] : nullptr; a.xin_bf = (const bf16_t*)P.out; a.xout = nullptr; a.tsrc = MIX; a.y = nullptr; a.tokrow = nullptr; a.gpost = P.in[13] + l * DM;
            a.hout = H2; a.gnext = P.in[14] + l * DM; a.xbout = (bf16_t*)P.out; a.router_b = P.in[20] + lj * NE; a.ti_e = ti_e; a.ti_p0 = ti_p0; a.ti_p1 = ti_p1; a.ti_g0 = ti_g0; a.ti_g1 = ti_g1; a.do_router = moe ? 1 : 0; a.hout8 = nullptr; a.h_fp8 = moe ? 1 : 0;
            DUPREP(9) { if (rep_) { a.xbout = (bf16_t*)(ws + 325 * MiB); a.hout = (bf16_t*)(ws + 325 * MiB); a.do_router = 0; }
            const RowGains rg = rows_gains(a, lane);
            for (int row = gw; row < M; row += 2 * NGW) { const int row2 = row + NGW; const bool two = row2 < M;
                f32x4 xa[4], xb2[4]; float ta[4][4], tb[4][4];
                rows_load(a, row, lane, xa, ta); if (two) rows_load(a, row2, lane, xb2, tb);
                rows_finish(a, rg, row, lane, xa, ta, wr_lds, cnt_lds); if (two) rows_finish(a, rg, row2, lane, xb2, tb, wr_lds, cnt_lds); } }
            if (moe) {
                __syncthreads();
                if (tid < NE) { const int c = cnt_lds[tid]; wgbase[bx * NE + tid] = (int)atomicAdd(ctl + CW_CNT + 64 * tid, (unsigned)c); }
                __syncthreads();
            }
        }
        if (!(fuse && !moe)) SEAM(pb + 8);
        if (!moe) {
            if (PHEN(10) && IN(pb + 9)) DUPREP(10) { pg8::Gemm g{H2, (const bf16_t*)(ws + WS_FGU), DM, DM, DM}; pg8::GridOrder S{M / 256, 2 * DFF / 256, G, bx, DM, DM, 2}; if constexpr (FP8_DENSE_DOWN) { pg8::Epi8<FSilu8> E{{(unsigned char*)HID, DFF, 1.0f}}; pg8::gemm_phase(lds, g, S, E); } else { pg8::Epi8<FSilu> E{{HID, DFF}}; pg8::gemm_phase(lds, g, S, E); } }
            SEAM(pb + 9);
            if (PHEN(11) && IN(pb + 10)) DUPREP(11) {
                { pg8::Gemm g{HID, (const bf16_t*)(ws + WS_FD), DFF, DFF, DFF};
                  constexpr int esz = FP8_DENSE_DOWN ? 1 : 2; constexpr float dsc = FP8_DENSE_DOWN ? 1.0f / 64.0f : 1.0f;
                  if (fuse) { pg8::PanelOrder S{G, vcu, DFF, DFF, esz}; pg8::Epi8<FFfnRes> E{{ws, (const bf16_t*)P.out, P.in[15] + l * DM, l * 5 + 2, dsc}}; pg8::gemm_phase<pg8::Epi8<FFfnRes>, pg8::PanelOrder, FP8_DENSE_DOWN>(lds, g, S, E); }
                  else { pg8::GridOrder S{M / 256, 4, G, bx, DFF, DFF, esz}; pg8::Epi8<FStoreS> E{{FB, DM, dsc}}; pg8::gemm_phase<pg8::Epi8<FStoreS>, pg8::GridOrder, FP8_DENSE_DOWN>(lds, g, S, E); } }
                { pg8::Gemm g{PBF, Wp_t, 256, 256, 256}; pg8::GridOrder S{M / 256, 4, G, bx, 256, 256, 2}; pg8::Epi8<FStore> E{{PP, DM}}; pg8::gemm_phase(lds, g, S, E); }
            }
            SEAM(pb + 10);
        } else {
            int tend[NE]; { int acc = 0;
#pragma unroll
                for (int e = 0; e < NE; ++e) { acc += (__builtin_amdgcn_readfirstlane((int)__hip_atomic_load(ctl + CW_CNT + 64 * e, __ATOMIC_RELAXED, __HIP_MEMORY_SCOPE_AGENT)) + 255) >> 8; tend[e] = acc; } }
            const int NT = tend[NE - 1];
            for (int c = 0; c < MOE_NCH; ++c) {
                int nT = (c == 0) ? (NT < MOE_C0 ? NT : MOE_C0) : NT - MOE_C0; nT = nT > MOE_CH ? MOE_CH : (nT < 0 ? 0 : nT);
                if (c == 0) {
                    if (PHEN(13) && IN(pb + 10 + 3 * c)) { PH_IDS
                        for (int tok = bx * (NWAVES * 64) + tid; tok < M; tok += G * (NWAVES * 64)) { const int info = ti_e[tok], e0 = info & 255, e1 = (info >> 8) & 255, wg = info >> 16; int s0 = 0, s1 = 0;
#pragma unroll
                            for (int j = 0; j < NE - 1; ++j) { if (e0 > j) s0 = tend[j] * 256; if (e1 > j) s1 = tend[j] * 256; }
                            const int r0 = s0 + wgbase[wg * NE + e0] + ti_p0[tok], r1 = s1 + wgbase[wg * NE + e1] + ti_p1[tok];
                            rowg[r0] = ti_g0[tok]; rowg[r1] = ti_g1[tok]; tokrow[2 * tok] = r0; tokrow[2 * tok + 1] = r1; rowtok[r0] = tok; rowtok[r1] = tok; }
                    }
                    SEAM(pb + 10 + 3 * c);
                }
                if (PHEN(14) && IN(pb + 11 + 3 * c)) DUPREP(14) {
                    pg8::Gemm g{H2, (const bf16_t*)((unsigned char*)P.out + MOEW_GU), DM, DM, DM, rowtok}; pg8::MoeOrder S; S.nT = nT; S.tile0 = c * MOE_C0; S.nN = 2 * MFF / 256; S.G = G; S.c = bx; S.lda = DM; S.ldb = DM; S.esz = 1; S.estride = (long)MGU_E;
                    S.esplit = MOE_ESPLIT; S.edelta = (long)((ws + WS_MGU_HI) - ((unsigned char*)P.out + MOEW_GU + (size_t)MOE_ESPLIT * MGU_E));
#pragma unroll
                    for (int e = 0; e < NE; ++e) S.tend[e] = tend[e];
                    pg8::Epi8<FSilu8> E{{(unsigned char*)HIDC, MFF, 1.0f / 32.0f}}; pg8::gemm_phase<pg8::Epi8<FSilu8>, pg8::MoeOrder, true, true>(lds, g, S, E);
                }
                SEAM(pb + 11 + 3 * c);
                if (PHEN(15) && IN(pb + 12 + 3 * c)) DUPREP(15) {
                    { pg8::Gemm g{HIDC, (const bf16_t*)((unsigned char*)P.out + MOEW_MD), MFF, MFF, MFF}; pg8::MoeOrder S; S.nT = nT; S.tile0 = c * MOE_C0; S.nN = 4; S.G = G; S.c = bx; S.lda = MFF; S.ldb = MFF; S.esz = 1; S.estride = (long)MD_E; S.rev = 1;
#pragma unroll
                      for (int e = 0; e < NE; ++e) S.tend[e] = tend[e];
                      pg8::Epi8<FRowScale> E{{Y, rowg, 1.0f / 64.0f}}; pg8::gemm_phase<pg8::Epi8<FRowScale>, pg8::MoeOrder, true>(lds, g, S, E); }
                    if (c == MOE_NCH - 1) {
                        int nskip = (nT * 4) % G; if (nskip > G / 4) nskip = 0;
                        if (bx >= nskip) { pg8::Gemm g{PBF, Wp_t, 256, 256, 256}; pg8::GridOrder S{M / 256, 4, G - nskip, bx - nskip, 256, 256, 2}; pg8::Epi8<FStore> E{{PP, DM}}; pg8::gemm_phase(lds, g, S, E); } }
                }
                SEAM(pb + 12 + 3 * c);
            }
        }
        if (PHEN(16) && IN(pb + 22) && !(fuse && !moe)) { PH_IDS
            RowsArgs a; a.xb8out = FP8_PLE ? ws + (moe ? WS_XB8_MOE : WS_XB8_DENSE) : nullptr; a.xin = nullptr; a.xin_bf = (const bf16_t*)P.out; a.xout = nullptr; a.tsrc = FB; a.y = moe ? Y : nullptr; a.tokrow = tokrow; a.gpost = P.in[15] + l * DM;
            a.hout = nullptr; a.gnext = nullptr; a.xbout = XB; a.router_b = nullptr; a.ti_e = nullptr; a.ti_p0 = nullptr; a.ti_p1 = nullptr; a.ti_g0 = nullptr; a.ti_g1 = nullptr; a.do_router = 0; a.h_fp8 = 0; a.hout8 = nullptr;
            DUPREP(16) { if (rep_) { a.xbout = (bf16_t*)(ws + 157 * MiB); }
            const RowGains rg = rows_gains(a, lane);
            for (int row = gw; row < M; row += 2 * NGW) { const int row2 = row + NGW; const bool two = row2 < M;
                f32x4 xa[4], xb2[4]; float ta[4][4], tb[4][4];
                rows_load(a, row, lane, xa, ta); if (two) rows_load(a, row2, lane, xb2, tb);
                rows_finish(a, rg, row, lane, xa, ta, (LAS float*)lds, (LAS int*)lds); if (two) rows_finish(a, rg, row2, lane, xb2, tb, (LAS float*)lds, (LAS int*)lds); } }
        }
        if (!(fuse && !moe)) SEAM(pb + 22);
        if (PHEN(17) && IN(pb + 23)) {
            pg8::Gemm g{FP8_PLE ? (const bf16_t*)(ws + (moe ? WS_XB8_MOE : WS_XB8_DENSE)) : XB, Wpg_t, DM, DM, DM}; constexpr int esz = FP8_PLE ? 1 : 2; constexpr float gsc = FP8_PLE ? 1.0f / 32.0f : 1.0f;
            if (fuse && l + 1 == DEPTH) { pg8::PanelOrder S{G, vcu, DM, DM, esz}; pg8::Epi8<FPleOut> E{{ws, P.in[26] + l * DM, P.out, l * 5 + 3, gsc}}; pg8::gemm_phase<pg8::Epi8<FPleOut>, pg8::PanelOrder, FP8_PLE>(lds, g, S, E); }
            else if (fuse) { constexpr bool h8only = (l + 1 == FP8_IN_LAYER) && gate_fp8(l + 1);
                using EP = pg8::Epi8<FPleRes<!h8only, (l + 1 == FP8_IN_LAYER) || gate_fp8(l + 1)>>;
                pg8::PanelOrder S{G, vcu, DM, DM, esz}; EP E{{ws, (bf16_t*)P.out, P.in[26] + l * DM, P.in[12] + (l + 1 < DEPTH ? l + 1 : l) * DM, l * 5 + 3, gsc}}; pg8::gemm_phase<EP, pg8::PanelOrder, FP8_PLE>(lds, g, S, E); }
            else { pg8::GridOrder S{M / 256, 4, G, bx, DM, DM, esz}; pg8::Epi8<FPle> E{{PP, gsc}}; pg8::gemm_phase<pg8::Epi8<FPle>, pg8::GridOrder, FP8_PLE>(lds, g, S, E); } }
        if (!fuse) SEAM(pb + 23);
        if (PHEN(18) && IN(pb + 24) && !fuse) { PH_IDS
            const bool more = (l + 1 < DEPTH);
            RowsArgs a; a.xb8out = nullptr; a.xin = nullptr; a.xin_bf = XB; a.xout = more ? nullptr : P.out; a.tsrc = PP; a.y = nullptr; a.tokrow = nullptr; a.gpost = P.in[26] + l * DM;
            a.hout = more ? H : nullptr; a.gnext = more ? P.in[12] + (l + 1) * DM : nullptr; a.xbout = more ? (bf16_t*)P.out : nullptr; a.router_b = nullptr; a.ti_e = nullptr; a.ti_p0 = nullptr; a.ti_p1 = nullptr; a.ti_g0 = nullptr; a.ti_g1 = nullptr; a.do_router = 0; a.h_fp8 = 0; a.hout8 = (more && l + 1 == FP8_IN_LAYER) ? ws + WS_H8 : nullptr;
            DUPREP(18) { if (rep_) { if (a.xbout) a.xbout = (bf16_t*)(ws + 157 * MiB); if (a.hout) a.hout = (bf16_t*)(ws + 157 * MiB); if (a.xout) a.xout = (float*)(ws + 157 * MiB); }
            const RowGains rg = rows_gains(a, lane);
            for (int row = gw; row < M; row += 2 * NGW) { const int row2 = row + NGW; const bool two = row2 < M;
                f32x4 xa[4], xb2[4]; float ta[4][4], tb[4][4];
                rows_load(a, row, lane, xa, ta); if (two) rows_load(a, row2, lane, xb2, tb);
                rows_finish(a, rg, row, lane, xa, ta, (LAS float*)lds, (LAS int*)lds); if (two) rows_finish(a, rg, row2, lane, xb2, tb, (LAS float*)lds, (LAS int*)lds); } }
        }
        if (l + 1 < DEPTH) SEAM(pb + 24);
    }

__global__ void __launch_bounds__(NWAVES * 64, 2) fwd_kernel(Params P) {
    extern __shared__ __attribute__((aligned(16))) unsigned char lds_raw[];
    LAS unsigned char* lds = (LAS unsigned char*)lds_raw;
    volatile LAS unsigned* MISC = (volatile LAS unsigned*)(lds + MISC_OFF);
    const int tid0 = threadIdx.x;
    const int G = gridDim.x, bx = blockIdx.x;
    const int vcu = (G % 8 == 0) ? (bx % 8) * (G / 8) + bx / 8 : bx;
    const int NGW = G * NWAVES;
    unsigned char* ws = P.ws;
    unsigned* ctl = (unsigned*)(ws + WS_CTL);
    for (int u = tid0; u < (LDS_BYTES - LDSCTL_OFF) / 4; u += NWAVES * 64) ((LAS unsigned*)(lds + LDSCTL_OFF))[u] = 0u;
    __syncthreads();
    XcdBarrier bar; bar.bar = ctl + CW_BAR; bar.x = 0; bar.st = nullptr;
    if (!MK_PER_PHASE) bar = xcd_barrier_post(ctl + CW_BAR, MISC + 8);
    const int lo = P.ph_lo, hi = P.ph_hi;

    const float* c16 = (const float*)(ws + WS_COS16); const float* s16 = (const float*)(ws + WS_SIN16);
    const float* c32 = (const float*)(ws + WS_COS32); const float* s32 = (const float*)(ws + WS_SIN32);
    bf16_t* const H = (bf16_t*)(ws + WS_H); bf16_t* const Z = (bf16_t*)(ws + WS_Z);
    bf16_t* const QA = (bf16_t*)(ws + WS_QA); bf16_t* const KA = (bf16_t*)(ws + WS_KA); bf16_t* const VA = (bf16_t*)(ws + WS_VA);
    bf16_t* const OCAT = (bf16_t*)(ws + WS_OCAT);
    bf16_t* const PB = (bf16_t*)(ws + WS_PB); bf16_t* const MERGED = (bf16_t*)(ws + WS_MERGED); bf16_t* const MIX = (bf16_t*)(ws + WS_MIX); bf16_t* const H2 = (bf16_t*)(ws + WS_H2);
    bf16_t* const HID = (bf16_t*)(ws + WS_HID); bf16_t* const FB = (bf16_t*)(ws + WS_FB); bf16_t* const XB = (bf16_t*)(ws + WS_XB); bf16_t* const PP = (bf16_t*)(ws + WS_PP);
    bf16_t* const PBF = (bf16_t*)(ws + WS_PBF);
    bf16_t* const MGU = (bf16_t*)(ws + WS_MGU); bf16_t* const MD = (bf16_t*)(ws + WS_MD); bf16_t* const Y = (bf16_t*)(ws + WS_Y); bf16_t* const XG = (bf16_t*)(ws + WS_XG); bf16_t* const HIDC = (bf16_t*)(ws + WS_HIDC);
    int* const rowtok = (int*)(ws + WS_ROWTOK); int* const tokrow = (int*)(ws + WS_TOKROW); float* const rowg = (float*)(ws + WS_ROWG); int* const wgbase = (int*)(ws + WS_WGBASE);
    int* const ti_e = (int*)(ws + WS_TI_E); int* const ti_p0 = (int*)(ws + WS_TI_P0); int* const ti_p1 = (int*)(ws + WS_TI_P1); float* const ti_g0 = (float*)(ws + WS_TI_G0); float* const ti_g1 = (float*)(ws + WS_TI_G1);

    if (PHEN(0) && IN(0)) DUPREP(0) { PH_IDS
        LAS float* scr = (LAS float*)(lds + wave * 16384);
        for (int it = gw; it < W_EARLY; it += NGW) w_item(P, ws, scr, it, lane);
        const int gt = bx * (NWAVES * 64) + tid, NGT = G * NWAVES * 64; const u32x4 z4 = {0u, 0u, 0u, 0u};
        for (int i = gt; i < 2 * 96 * 128; i += NGT) { const int l = i / (96 * 128), j = i - l * (96 * 128); if (l == FP8_IN_LAYER) { if (j < 96 * 64) *((u32x4*)(ws + WS_WIN + l * WIN_L + (size_t)ZN * DM) + j) = z4; } else *((u32x4*)(ws + WS_WIN + l * WIN_L + (size_t)ZN * DM * 2) + j) = z4; }
        for (int i = gt; i < 2 * 128 * 32; i += NGT) { const int l = i / (128 * 32), j = i - l * (128 * 32); *((u32x4*)(ws + WS_WUQ + l * WUQ_L + (size_t)384 * 256 * 2) + j) = z4; }
        for (int i = gt; i < 2 * 512 * 16; i += NGT) { const int l = i / (512 * 16), j = i - l * (512 * 16), row = j >> 4, ch = j & 15; *((u32x4*)(ws + WS_WUKV + l * WUKV_L + (size_t)row * 512 + 256) + ch) = z4; }
        for (int i = gt; i < SEQ * 48; i += NGT) {
            const int pos = i / 48, q = i - pos * 48; const bool t16 = q < 16; const int fi = t16 ? q : q - 16;
            const float inv = __builtin_amdgcn_exp2f(-(float)fi * (t16 ? (1.0f / 16.0f) : (1.0f / 32.0f)) * 13.287712379549449f);
            const float ang = (float)pos * inv; const double rev = (double)ang * 0.15915494309189535; const float fr = (float)(rev - __builtin_rint(rev));
            const float cs = __builtin_amdgcn_cosf(fr), sn = __builtin_amdgcn_sinf(fr);
            if (t16) { ((float*)(ws + WS_COS16))[pos * 16 + fi] = cs; ((float*)(ws + WS_SIN16))[pos * 16 + fi] = sn; }
            else { ((float*)(ws + WS_COS32))[pos * 32 + fi] = cs; ((float*)(ws + WS_SIN32))[pos * 32 + fi] = sn; } }
        f32x4 g0_[4];
#pragma unroll
        for (int j = 0; j < 4; ++j) g0_[j] = *((const f32x4*)P.in[12] + 64 * j + lane);
        for (int row0 = gw; row0 < M; row0 += 4 * NGW) {
            f32x4 v[4][4];
#pragma unroll
            for (int k = 0; k < 4; ++k) { const int row = row0 + k * NGW < M ? row0 + k * NGW : row0; const f32x4* xr = (const f32x4*)(P.in[0] + (size_t)row * DM) + lane;
#pragma unroll
                for (int j = 0; j < 4; ++j) v[k][j] = xr[64 * j]; }
#pragma unroll
            for (int k = 0; k < 4; ++k) { const int row = row0 + k * NGW; if (row < M) { float ss = 0.f;
#pragma unroll
                for (int j = 0; j < 4; ++j) ss += (v[k][j][0] * v[k][j][0] + v[k][j][1] * v[k][j][1]) + (v[k][j][2] * v[k][j][2] + v[k][j][3] * v[k][j][3]);
                const float rs = rsqrtf(wave_sum(ss) * (1.0f / DM) + NORM_EPS);
#pragma unroll
                for (int j = 0; j < 4; ++j) { const f32x4 g = g0_[j]; const float o[4] = {v[k][j][0] * rs * g[0], v[k][j][1] * rs * g[1], v[k][j][2] * rs * g[2], v[k][j][3] * rs * g[3]};
                    store4(H + (size_t)row * DM + 256 * j + 4 * lane, o);
                    if (FP8_GATE0) *(unsigned*)(ws + WS_H8 + (size_t)row * DM + 256 * j + 4 * lane) = cvt4_fp8(o[0], o[1], o[2], o[3]); } } } }
    }
    SEAM(0);

    layer_body<0>(P, lds, bar, lo, hi, G, bx, vcu, NGW, ws, ctl);
    layer_body<1>(P, lds, bar, lo, hi, G, bx, vcu, NGW, ws, ctl);
#undef IN
#undef SEAM
}

extern "C" void kernel_launch(void* const* d_in, const int* in_sizes, int n_in, void* d_out, int out_size, void* d_ws, size_t ws_size, hipStream_t stream) {
    static int grid = 0;
    if (grid == 0) {
        if (n_in != 27 || out_size != M * DM || ws_size < WS_END) { fprintf(stderr, "kernel_launch: unexpected shapes (n_in %d, out %d, ws %zu < %zu)\n", n_in, out_size, ws_size, (size_t)WS_END); grid = -1; return; }
        int dev = 0, cus = 0, per_cu = 0;
        if (hipGetDevice(&dev) != hipSuccess || hipDeviceGetAttribute(&cus, hipDeviceAttributeMultiprocessorCount, dev) != hipSuccess) { grid = -1; return; }
        if (hipFuncSetAttribute((const void*)fwd_kernel, hipFuncAttributeMaxDynamicSharedMemorySize, LDS_BYTES) != hipSuccess) { fprintf(stderr, "kernel_launch: hipFuncSetAttribute failed\n"); grid = -1; return; }
        if (hipOccupancyMaxActiveBlocksPerMultiprocessor(&per_cu, (const void*)fwd_kernel, NWAVES * 64, LDS_BYTES) != hipSuccess || per_cu < 1) { fprintf(stderr, "kernel_launch: occupancy query says %d\n", per_cu); per_cu = 1; }
        (void)hipGetLastError();
        grid = cus;
    }
    if (grid < 0) return;
    (void)hipMemsetAsync((char*)d_ws + WS_CTL, 0, CTL_ZERO_BYTES, stream);
    Params p{};
    for (int i = 0; i < 27; ++i) p.in[i] = (const float*)d_in[i];
    p.out = (float*)d_out; p.ws = (unsigned char*)d_ws;
#if MK_PER_PHASE
    for (int k = 0; k < N_PHASES; ++k) { p.ph_lo = k; p.ph_hi = k + 1; hipLaunchKernelGGL(fwd_kernel, dim3(grid), dim3(NWAVES * 64), LDS_BYTES, stream, p); }
#else
    p.ph_lo = 0; p.ph_hi = N_PHASES;
    hipLaunchKernelGGL(fwd_kernel, dim3(grid), dim3(NWAVES * 64), LDS_BYTES, stream, p);
#endif
}
```

```cpp
#include <hip/hip_runtime.h>
#include <cstdio>
#include <cstdint>
#include <type_traits>

#define LAS __attribute__((address_space(3)))
#define GAS __attribute__((address_space(1)))
typedef unsigned short bf16_t;
typedef short bf16x8 __attribute__((ext_vector_type(8)));
typedef short s16x4 __attribute__((ext_vector_type(4)));
typedef float f32x4 __attribute__((ext_vector_type(4)));
typedef float f32x16 __attribute__((ext_vector_type(16)));
typedef unsigned u32x4 __attribute__((ext_vector_type(4)));
typedef unsigned u32x2 __attribute__((ext_vector_type(2)));

#ifndef PHMASK
#define PHMASK 0xFFFFFFFFu
#endif
#define PHEN(i) (((PHMASK) >> (i)) & 1u)
#ifndef DUPMASK
#define DUPMASK 0u
#endif
#define DUPREP(i) for (int rep_ = 0; rep_ < 1 + (int)(((DUPMASK) >> (i)) & 1u); ++rep_)
#ifndef MK_PER_PHASE
#define MK_PER_PHASE 0
#endif

constexpr int DM = 1024, BATCH = 4, SEQ = 8192, DEPTH = 2, M = BATCH * SEQ;
constexpr int ZP = 3840;
constexpr int ZC_B = 416, ZC_C = 928, ZC_D = 3232, ZN = 3744, IN_COLS = 7840;
constexpr int DFF = 4096, MFF = 3584, NE = 8;
constexpr float NORM_EPS = 1e-6f;
constexpr float LOG2E = 1.4426950408889634f;
constexpr int MOE_MAXT = 264;
constexpr int MOE_C0 = MOE_MAXT, MOE_CH = MOE_MAXT, MOE_NCH = 1;

constexpr size_t MiB = 1u << 20;
constexpr size_t WS_CTL = 0, CTL_ZERO_BYTES = 2 * MiB;
constexpr size_t WS_ROWTOK = 1 * MiB;
constexpr size_t WS_COS16 = 2 * MiB, WS_SIN16 = WS_COS16 + 512 * 1024, WS_COS32 = 3 * MiB, WS_SIN32 = 4 * MiB;
constexpr size_t WS_TI_E = 5 * MiB, WS_TI_P0 = WS_TI_E + 128 * 1024, WS_TI_P1 = WS_TI_P0 + 128 * 1024, WS_TI_G0 = WS_TI_P1 + 128 * 1024, WS_TI_G1 = WS_TI_G0 + 128 * 1024;
constexpr size_t WS_TOKROW = 6 * MiB, WS_ROWG = WS_TOKROW + 256 * 1024, WS_WGBASE = 7 * MiB;
constexpr size_t WS_WIN = 8 * MiB, WIN_L = (size_t)ZP * DM * 2;
constexpr size_t WS_WG = 23 * MiB, WG_L = 8 * MiB;
constexpr size_t WS_WB = 39 * MiB, WB_L = 2 * MiB;
constexpr size_t WS_WOUT = 43 * MiB, WOUT_L = 2 * MiB;
constexpr size_t WS_WPG = 47 * MiB, WPG_L = 2 * MiB;
constexpr size_t WS_WP = 51 * MiB, WP_L = 512 * 1024;
constexpr size_t WS_WUQ = 52 * MiB, WUQ_L = 256 * 1024;
constexpr size_t WS_WUKV = WS_WUQ + 512 * 1024, WUKV_L = 256 * 1024;
constexpr size_t WS_FGU = 53 * MiB, WS_FD = 69 * MiB;
constexpr size_t WS_PBF = 77 * MiB;
constexpr size_t A0 = 93 * MiB;
constexpr size_t WS_H = A0, WS_Z = 157 * MiB, WS_QA = 397 * MiB, WS_KA = 421 * MiB, WS_VA = 445 * MiB, WS_OCAT = 461 * MiB, WS_OCG = 525 * MiB, OCG_G = 16 * MiB, WS_LG = 573 * MiB, LG_G = 512 * 1024;
constexpr size_t WS_H8 = 600 * MiB;
constexpr int FP8_GATE_LAYER = 1;
constexpr bool FP8_PLE = true;
constexpr size_t WS_XB8_DENSE = 397 * MiB, WS_XB8_MOE = 157 * MiB;
constexpr bool FP8_DENSE_DOWN = true;
constexpr bool FP8_GATE0 = true;
__host__ __device__ constexpr bool gate_fp8(int l) { return l == FP8_GATE_LAYER || (l == 0 && FP8_GATE0); }
constexpr int FP8_IN_LAYER = 1;
constexpr size_t WS_PB = 157 * MiB, WS_MERGED = 525 * MiB, WS_MIX = A0, WS_H2 = 461 * MiB;
constexpr size_t WS_HID = 157 * MiB, WS_FB = 525 * MiB, WS_XB = A0, WS_PP = 461 * MiB;
constexpr size_t WS_MGU = 157 * MiB, MGU_E = 7 * MiB, WS_MD = 269 * MiB, MD_E = 7 * MiB / 2, WS_Y = 325 * MiB, WS_XG = A0, WS_HIDC = A0;
constexpr size_t OUT_HALF = (size_t)M * DM * 2;
constexpr size_t MOEW_MD = OUT_HALF, MOEW_GU = OUT_HALF + 8 * MD_E, WS_MGU_HI = WS_FGU;
constexpr int MOE_ESPLIT = 5;
static_assert(MOEW_GU + MOE_ESPLIT * MGU_E <= 2 * OUT_HALF && WS_MGU_HI + (NE - MOE_ESPLIT) * MGU_E <= WS_PBF, "expert weight copies");
constexpr size_t WS_XSLOT = 644 * MiB, XSLOT_B = 2 * MiB;
constexpr size_t WS_END = 648 * MiB;
static_assert(WS_HIDC + (size_t)MOE_CH * 256 * MFF <= WS_Y, "hidden (fp8)");
static_assert(WS_Y + (size_t)MOE_MAXT * 256 * DM * 2 <= WS_H2, "y");
constexpr int CW_CNT = 64;
constexpr int CW_BAR = 4096;
constexpr int CW_PANEL = 16384;

__device__ __forceinline__ unsigned cvt_pk_bf16(float lo, float hi) { unsigned r; asm volatile("v_cvt_pk_bf16_f32 %0, %1, %2" : "=v"(r) : "v"(lo), "v"(hi)); return r; }
__device__ __forceinline__ float bf_lo(unsigned u) { return __uint_as_float(u << 16); }
__device__ __forceinline__ float bf_hi(unsigned u) { return __uint_as_float(u & 0xffff0000u); }
__device__ __forceinline__ u32x4 pack8(const float (&v)[8]) { u32x4 w; w.x = cvt_pk_bf16(v[0], v[1]); w.y = cvt_pk_bf16(v[2], v[3]); w.z = cvt_pk_bf16(v[4], v[5]); w.w = cvt_pk_bf16(v[6], v[7]); return w; }
__device__ __forceinline__ void unpack8(const u32x4 w, float (&v)[8]) { v[0] = bf_lo(w.x); v[1] = bf_hi(w.x); v[2] = bf_lo(w.y); v[3] = bf_hi(w.y); v[4] = bf_lo(w.z); v[5] = bf_hi(w.z); v[6] = bf_lo(w.w); v[7] = bf_hi(w.w); }
__device__ __forceinline__ float sigmoidf_(float x) { return __builtin_amdgcn_rcpf(1.0f + __builtin_amdgcn_exp2f(-x * LOG2E)); }
__device__ __forceinline__ float wave_sum(float v) {
#pragma unroll
    for (int o = 1; o < 64; o <<= 1) v += __shfl_xor(v, o);
    return v;
}
__device__ __forceinline__ unsigned cvt4_fp8(float a, float b, float c, float d) { int w = 0; w = __builtin_amdgcn_cvt_pk_fp8_f32(a, b, w, false); w = __builtin_amdgcn_cvt_pk_fp8_f32(c, d, w, true); return (unsigned)w; }
#define LDS_WAIT() asm volatile("s_waitcnt lgkmcnt(0)" ::: "memory")
#define VM_WAIT() asm volatile("s_waitcnt vmcnt(0)" ::: "memory")

#define XB_TMO      128
#define XB_XCNT(j)  (256  + 64 * (j))
#define XB_XSUB(j)  (1280 + 64 * (j))
#define XB_XGEN(j)  (2304 + 64 * (j))
#define XB_TOP      3328
#define XB_TOPGEN   3392
#define XCD_BAR_WORDS 3456
#define XB_SPIN_CAP (1u << 18)
__device__ __forceinline__ unsigned xb_ld(unsigned* p)              { return __hip_atomic_load(p, __ATOMIC_RELAXED, __HIP_MEMORY_SCOPE_AGENT); }
__device__ __forceinline__ unsigned xb_add(unsigned* p, unsigned v) { return __hip_atomic_fetch_add(p, v, __ATOMIC_RELAXED, __HIP_MEMORY_SCOPE_AGENT); }
__device__ __forceinline__ unsigned xb_xcc_id() { return (unsigned)__builtin_amdgcn_s_getreg((3 << 11) | 20) & 0xFu; }
#define XB_SPIN(cond, bar) do { unsigned _sp = 0; while (cond) { __builtin_amdgcn_s_sleep(1); \
    if ((++_sp & 255u) == 0u) { if (xb_ld(&(bar)[XB_TMO])) break; if (_sp > XB_SPIN_CAP) { atomicAdd(&(bar)[XB_TMO], 1u); break; } } } } while (0)
struct XcdBarrier { unsigned* bar; unsigned x; volatile LAS unsigned* st; };
__device__ __forceinline__ XcdBarrier xcd_barrier_post(unsigned* bar, volatile LAS unsigned* st) {
    XcdBarrier b; b.bar = bar; b.x = xb_xcc_id(); b.st = st;
    if (threadIdx.x == 0) (void)xb_add(&bar[XB_XCNT(b.x)], 1u);
    return b;
}
__device__ __forceinline__ void xcd_barrier_complete(unsigned* bar, unsigned x, unsigned& nloc, unsigned& nx) {
    const unsigned G = gridDim.x * gridDim.y * gridDim.z;
    unsigned sum, cnt, mine, sp = 0u;
    for (;;) {
        sum = 0u; cnt = 0u; mine = 0u;
#pragma unroll
        for (unsigned j = 0; j < 16; ++j) { const unsigned c = xb_ld(&bar[XB_XCNT(j)]); sum += c; cnt += (c > 0u) ? 1u : 0u; mine = (j == x) ? c : mine; }
        if (sum == G) break;
        __builtin_amdgcn_s_sleep(1);
        if ((++sp & 255u) == 0u) { if (xb_ld(&bar[XB_TMO])) break; if (sp > XB_SPIN_CAP) { atomicAdd(&bar[XB_TMO], 1u); break; } }
    }
    nloc = mine > 0u ? mine : 1u; nx = cnt > 0u ? cnt : 1u;
}
__device__ __forceinline__ void xcd_barrier(const XcdBarrier& b) {
    asm volatile("s_waitcnt vmcnt(0)" ::: "memory");
    __syncthreads();
    if (threadIdx.x == 0) {
        unsigned* bar = b.bar;
        __builtin_amdgcn_s_waitcnt(0);
        unsigned nloc = b.st[0], nx = b.st[1];
        if (nloc == 0u) { xcd_barrier_complete(bar, b.x, nloc, nx); b.st[0] = nloc; b.st[1] = nx; }
        const unsigned old = xb_add(&bar[XB_XSUB(b.x)], 1u);
        const unsigned gen = old / nloc;
        if (old + 1u == (gen + 1u) * nloc) {
            __builtin_amdgcn_fence(__ATOMIC_RELEASE, "agent");
            asm volatile("s_waitcnt vmcnt(0)" ::: "memory");
            const unsigned og = xb_add(&bar[XB_TOP], 1u);
            const unsigned tg = og / nx;
            if (og + 1u == (tg + 1u) * nx) xb_add(&bar[XB_TOPGEN], 1u);
            else XB_SPIN(xb_ld(&bar[XB_TOPGEN]) == tg, bar);
            __builtin_amdgcn_fence(__ATOMIC_ACQUIRE, "agent");
            xb_add(&bar[XB_XGEN(b.x)], 1u);
            asm volatile("s_waitcnt vmcnt(0)" ::: "memory");
        } else {
            XB_SPIN(xb_ld(&bar[XB_XGEN(b.x)]) == gen, bar);
            __builtin_amdgcn_fence(__ATOMIC_ACQUIRE, "agent");
            asm volatile("s_waitcnt vmcnt(0)" ::: "memory");
        }
    }
    __syncthreads();
}

namespace pg8 {
constexpr int BM = 256, BK = 64, HALF = 128, HTB = HALF * BK * 2, STAGE_BYTES = 8 * HTB, NXCD = 8, WGM = 8;
__host__ __device__ __forceinline__ int lds_byte(int r, int c) { const int st = (r >> 4) * 2 + (c >> 5), rr = r & 15, cc = c & 31, ob = rr * 64 + cc * 2; return st * 1024 + (ob ^ (((ob >> 9) & 1) << 5)); }
__host__ __device__ __forceinline__ void stage_rc(int b, int& R, int& C) { const int st = b / 1024, sb = b % 1024, swz = sb ^ (((sb >> 9) & 1) << 5); R = (st >> 1) * 16 + swz / 64; C = (st & 1) * 32 + (swz % 64) / 2; }
__host__ __device__ __forceinline__ int perm32(int rho) { const int n = rho >> 4, i = rho & 15; return 8 * (i >> 2) + 4 * n + (i & 3); }

struct Unit { int pm, pn, aux; long aoff, boff; };
struct Gemm { const bf16_t* A; const bf16_t* Bt; int lda, ldb, K; const int* rowtok = nullptr; };

__device__ __forceinline__ bool grid_map(long L, int nM, int nN, int& pm, int& pn) {
    const int nwg = nM * nN; if (L >= nwg) return false;
    int wgid = (int)L; { const int q = nwg / NXCD, r = nwg % NXCD, xcd = wgid % NXCD, off = wgid / NXCD; wgid = (xcd < r ? xcd * (q + 1) : r * (q + 1) + (xcd - r) * q) + off; }
    const int nig = WGM * nN, gid = wgid / nig, fm = gid * WGM, gsz = (nM - fm) < WGM ? (nM - fm) : WGM;
    pm = fm + ((wgid % nig) % gsz); pn = (wgid % nig) / gsz; return true;
}
struct GridOrder {
    int nM, nN, G, c, lda, ldb, esz; int rev = 0;
    __device__ __forceinline__ bool next(int i, Unit& u) const {
        if (!grid_map((long)i * G + c, nM, nN, u.pm, u.pn)) return false;
        if (rev) u.pm = nM - 1 - u.pm;
        u.aux = 0; u.aoff = (long)u.pm * BM * lda * esz; u.boff = (long)u.pn * BM * ldb * esz; return true; }
};
struct BranchOrder {
    int G, c;
    __device__ __forceinline__ bool next(int i, Unit& u) const {
        if (!grid_map((long)i * G + c, M / BM, 16, u.pm, u.pn)) return false;
        u.aux = 0; u.aoff = (long)u.pm * BM * DM * 2 + (long)(u.pn >> 2) * 512; u.boff = (long)u.pn * BM * 256 * 2; return true; }
};
struct GateOrder {
    int G, c;
    __device__ __forceinline__ bool next(int i, Unit& u) const {
        int pc; if (!grid_map((long)(i >> 2) * G + c, M / BM, 4, u.pm, pc)) return false;
        u.pn = (i & 3) * 4 + pc; u.aux = 0; u.aoff = (long)u.pm * BM * DM * 2; u.boff = (long)u.pn * BM * DM * 2; return true; }
};
struct PanelOrder {
    int G, vcu, lda, ldb, esz;
    __device__ __forceinline__ bool next(int i, Unit& u) const {
        const int per = G >> 2, pm = i * per + (vcu >> 2); if ((vcu >> 2) >= per || pm >= M / BM) return false;
        u.pm = pm; u.pn = vcu & 3; u.aux = 0; u.aoff = (long)pm * BM * lda * esz; u.boff = (long)u.pn * BM * ldb * esz; return true; }
};
struct MoeOrder {
    int nT, tile0, nN, G, c, lda, ldb, esz; long estride; int tend[NE]; int esplit = NE; long edelta = 0; int rev = 0;
    __device__ __forceinline__ bool next(int i, Unit& u) const {
        if (!grid_map((long)i * G + c, nT, nN, u.pm, u.pn)) return false;
        if (rev) u.pm = nT - 1 - u.pm;
        const int tile = tile0 + u.pm; int e = 0;
#pragma unroll
        for (int j = 0; j < NE - 1; ++j) e += (tile >= tend[j]) ? 1 : 0;
        u.aux = tile; u.aoff = (long)u.pm * BM * lda * esz; u.boff = (long)e * estride + (e >= esplit ? edelta : 0L) + (long)u.pn * BM * ldb * esz; return true; }
};

template <class T, class = void> struct has_probe : std::false_type {};
template <class T> struct has_probe<T, std::void_t<decltype(T::PROBE)>> : std::true_type {};
template <class T, class = void> struct has_prep : std::false_type {};
template <class T> struct has_prep<T, std::void_t<decltype(T::PREP)>> : std::true_type {};
template <class T, class = void> struct has_gate2 : std::false_type {};
template <class T> struct has_gate2<T, std::void_t<decltype(T::GATE2)>> : std::true_type {};
template <class T, class = void> struct has_normx : std::false_type {};
template <class T> struct has_normx<T, std::void_t<decltype(T::NORMX)>> : std::true_type {};
__device__ __forceinline__ void panel_exchange(const f32x4 (&acc)[2][2][4][2], float* slots, unsigned* cnt, int pm, int pn, int wr, int wc, int fr, int fq, float (&rs)[2][4]) {
#pragma unroll
    for (int ai = 0; ai < 2; ++ai)
#pragma unroll
        for (int m = 0; m < 4; ++m) { float q = 0.f;
#pragma unroll
            for (int bj = 0; bj < 2; ++bj)
#pragma unroll
                for (int n = 0; n < 2; ++n) { const f32x4 a = acc[ai][bj][m][n]; q += (a[0] * a[0] + a[1] * a[1]) + (a[2] * a[2] + a[3] * a[3]); }
            auto s1 = __builtin_amdgcn_permlane16_swap(__float_as_uint(q), __float_as_uint(q), false, false); q = __uint_as_float(s1[0]) + __uint_as_float(s1[1]);
            auto s2 = __builtin_amdgcn_permlane32_swap(__float_as_uint(q), __float_as_uint(q), false, false); q = __uint_as_float(s2[0]) + __uint_as_float(s2[1]);
            if (fq == 0) __hip_atomic_store(slots + (size_t)(pm * 256 + ai * HALF + wr * 64 + m * 16 + fr) * 16 + pn * 4 + wc, q, __ATOMIC_RELAXED, __HIP_MEMORY_SCOPE_AGENT); }
    asm volatile("s_waitcnt vmcnt(0)\n\ts_barrier" ::: "memory");
    unsigned* c = cnt + pm * 16;
    if (wr == 0 && wc == 0) {
        if (fr + 16 * fq == 0) __hip_atomic_fetch_add(c, 1u, __ATOMIC_RELAXED, __HIP_MEMORY_SCOPE_AGENT);
        for (unsigned sp = 0; sp < (1u << 20); ++sp) {
            if ((unsigned)__builtin_amdgcn_readfirstlane(__hip_atomic_load(c, __ATOMIC_RELAXED, __HIP_MEMORY_SCOPE_AGENT)) >= 4u) break;
            __builtin_amdgcn_s_sleep(1); } }
    asm volatile("s_waitcnt vmcnt(0)\n\ts_barrier" ::: "memory");
#pragma unroll
    for (int ai = 0; ai < 2; ++ai) { u32x4 w[4][4];
#pragma unroll
        for (int m = 0; m < 4; ++m) { const float* sl = slots + (size_t)(pm * 256 + ai * HALF + wr * 64 + m * 16 + fr) * 16;
#pragma unroll
            for (int k = 0; k < 4; ++k) asm volatile("global_load_dwordx4 %0, %1, off offset:%c2 sc1" : "=&v"(w[m][k]) : "v"(sl), "i"(k * 16) : "memory"); }
        asm volatile("s_waitcnt vmcnt(0)" : "+v"(w[0][0]), "+v"(w[0][1]), "+v"(w[0][2]), "+v"(w[0][3]), "+v"(w[1][0]), "+v"(w[1][1]), "+v"(w[1][2]), "+v"(w[1][3]),
                                            "+v"(w[2][0]), "+v"(w[2][1]), "+v"(w[2][2]), "+v"(w[2][3]), "+v"(w[3][0]), "+v"(w[3][1]), "+v"(w[3][2]), "+v"(w[3][3]) :: "memory");
#pragma unroll
        for (int m = 0; m < 4; ++m) { float tot = 0.f;
#pragma unroll
            for (int k = 0; k < 4; ++k) { tot += __uint_as_float(w[m][k].x); tot += __uint_as_float(w[m][k].y); tot += __uint_as_float(w[m][k].z); tot += __uint_as_float(w[m][k].w); }
            rs[ai][m] = rsqrtf(tot * (1.0f / 1024.0f) + NORM_EPS); } }
}
template <class T, class = void> struct has_staged8 : std::false_type {};
template <class T> struct has_staged8<T, std::void_t<decltype(T::STAGED8)>> : std::true_type {};
template <class T, class = void> struct has_staged4 : std::false_type {};
template <class T> struct has_staged4<T, std::void_t<decltype(T::STAGED4)>> : std::true_type {};
template <class T, class = void> struct has_staged : std::false_type {};
template <class T> struct has_staged<T, std::void_t<decltype(T::STAGED)>> : std::true_type {};
constexpr int EPI_STG_OFF = 131072 + 1024, EPI_STG_WAVE = 2048;
struct EpiLd { f32x4 a, b; };
template <class F> struct Epi8 {
    static constexpr bool PERM = true;
    F f;
    template <bool STORE = true>
    __device__ __forceinline__ void run(f32x4 (&acc)[2][2][4][2], const Unit& u, int wr, int wc, int fr0, int fq0, LAS unsigned char* stg) const {
        int fr = fr0, fq = fq0; asm volatile("" : "+v"(fr), "+v"(fq));
        if constexpr (has_normx<F>::value) {
#define EPI_ROW(ai_, m_) ((ai_) * HALF + wr * 64 + (m_) * 16 + fr)
#define EPI_COL(bj_) ((bj_) * HALF + wc * 32 + 8 * fq)
#define EPI_GETV(ai_, bj_, m_) const f32x4 a_ = acc[ai_][bj_][m_][0], b_ = acc[ai_][bj_][m_][1]; float v[8] = {a_[0], a_[1], a_[2], a_[3], b_[0], b_[1], b_[2], b_[3]}
#define EPI_PUTV(ai_, bj_, m_) acc[ai_][bj_][m_][0] = (f32x4){v[0], v[1], v[2], v[3]}; acc[ai_][bj_][m_][1] = (f32x4){v[4], v[5], v[6], v[7]}
#pragma unroll
            for (int am = 0; am < 4; ++am) { const int ai = am >> 1, m0 = (am & 1) * 2; EpiLd w[2][2];
#pragma unroll
                for (int mm = 0; mm < 2; ++mm)
#pragma unroll
                    for (int bj = 0; bj < 2; ++bj) w[mm][bj] = f.tload(u, EPI_ROW(ai, m0 + mm), EPI_COL(bj));
#pragma unroll
                for (int mm = 0; mm < 2; ++mm)
#pragma unroll
                    for (int bj = 0; bj < 2; ++bj) { const int m = m0 + mm; EPI_GETV(ai, bj, m); f.tval(u, EPI_ROW(ai, m), EPI_COL(bj), v, w[mm][bj]); EPI_PUTV(ai, bj, m); } }
            float rs[2][4];
            panel_exchange(acc, f.slotp(0), f.cntp(0), u.pm, u.pn, wr, wc, fr, fq, rs);
            asm volatile("" : "+v"(fr), "+v"(fq));
            if constexpr (F::NORMX == 2) {
                f32x4 g[2][2];
#pragma unroll
                for (int bj = 0; bj < 2; ++bj) f.gains(u, EPI_COL(bj), 1, g[bj][0], g[bj][1]);
#pragma unroll
                for (int am = 0; am < 4; ++am) { const int ai = am >> 1, m0 = (am & 1) * 2; EpiLd w[2][2];
#pragma unroll
                    for (int mm = 0; mm < 2; ++mm)
#pragma unroll
                        for (int bj = 0; bj < 2; ++bj) w[mm][bj] = f.mload(u, EPI_ROW(ai, m0 + mm), EPI_COL(bj));
#pragma unroll
                    for (int mm = 0; mm < 2; ++mm)
#pragma unroll
                        for (int bj = 0; bj < 2; ++bj) { const int m = m0 + mm; EPI_GETV(ai, bj, m); f.mid(u, EPI_ROW(ai, m), EPI_COL(bj), v, rs[ai][m], w[mm][bj], g[bj][0], g[bj][1]); EPI_PUTV(ai, bj, m); } }
                panel_exchange(acc, f.slotp(1), f.cntp(1), u.pm, u.pn, wr, wc, fr, fq, rs);
                asm volatile("" : "+v"(fr), "+v"(fq));
            }
            { f32x4 g[2][2];
#pragma unroll
              for (int bj = 0; bj < 2; ++bj) f.gains(u, EPI_COL(bj), 2, g[bj][0], g[bj][1]);
#pragma unroll
              for (int am = 0; am < 4; ++am) { const int ai = am >> 1, m0 = (am & 1) * 2; EpiLd w[2][2];
#pragma unroll
                  for (int mm = 0; mm < 2; ++mm)
#pragma unroll
                      for (int bj = 0; bj < 2; ++bj) w[mm][bj] = f.fload(u, EPI_ROW(ai, m0 + mm), EPI_COL(bj));
#pragma unroll
                  for (int mm = 0; mm < 2; ++mm)
#pragma unroll
                      for (int bj = 0; bj < 2; ++bj) { const int m = m0 + mm; EPI_GETV(ai, bj, m); f.finish(u, EPI_ROW(ai, m), EPI_COL(bj), v, rs[ai][m], w[mm][bj], g[bj][0], g[bj][1]); } } }
#undef EPI_ROW
#undef EPI_COL
#undef EPI_GETV
#undef EPI_PUTV
            return;
        }
        if constexpr (has_gate2<F>::value) {
#pragma unroll
            for (int ai = 0; ai < 2; ++ai) { u32x4 pw[4][2];
#pragma unroll
                for (int m = 0; m < 4; ++m) f.loadp(u, ai, m, wr, wc, fr, fq, pw[m][0], pw[m][1]);
#pragma unroll
                for (int m = 0; m < 4; ++m) { const f32x4 a0 = acc[ai][0][m][0], b0 = acc[ai][0][m][1], a1 = acc[ai][1][m][0], b1 = acc[ai][1][m][1];
                    float v0[8] = {a0[0], a0[1], a0[2], a0[3], b0[0], b0[1], b0[2], b0[3]}, v1[8] = {a1[0], a1[1], a1[2], a1[3], b1[0], b1[1], b1[2], b1[3]};
                    f.pair(u, ai, m, wr, wc, fr, fq, v0, v1, pw[m][0], pw[m][1]); } }
            return;
        }
        if constexpr (has_staged8<F>::value) {
            const int lane = fr + 16 * fq;
#pragma unroll
            for (int ai = 0; ai < 2; ++ai)
#pragma unroll
                for (int bj = 0; bj < 2; ++bj)
#pragma unroll
                    for (int mp = 0; mp < 2; ++mp) { const int row0 = ai * HALF + wr * 64 + mp * 32, cb = bj * HALF + wc * 32;
#pragma unroll
                        for (int mm = 0; mm < 2; ++mm) { const f32x4 a = acc[ai][bj][2 * mp + mm][0], b = acc[ai][bj][2 * mp + mm][1];
                            float v[8] = {a[0], a[1], a[2], a[3], b[0], b[1], b[2], b[3]};
                            *(LAS u32x2*)(stg + ((mm * 16 + fr) * 4 + fq) * 8) = f.pack8b(u, row0 + mm * 16 + fr, cb + 8 * fq, v); }
                        { const int lrow = lane >> 1, hf = lane & 1; const u32x4 w = *(const LAS u32x4*)(stg + lrow * 32 + hf * 16);
                          *(u32x4*)f.dst(u, row0 + lrow, cb + 16 * hf) = w; } }
            return;
        }
        if constexpr (has_staged4<F>::value) {
            const int lane = fr + 16 * fq;
#pragma unroll
            for (int ai = 0; ai < 2; ++ai)
#pragma unroll
                for (int bj = 0; bj < 2; ++bj) { const int row0 = ai * HALF + wr * 64, cb = bj * HALF + wc * 32;
#pragma unroll
                    for (int m = 0; m < 4; ++m) { const f32x4 a = acc[ai][bj][m][0], b = acc[ai][bj][m][1];
                        float v[8] = {a[0], a[1], a[2], a[3], b[0], b[1], b[2], b[3]};
                        *(LAS unsigned*)(stg + ((m * 16 + fr) * 4 + fq) * 4) = f.pack4b(u, row0 + m * 16 + fr, cb + 8 * fq, v); }
                    { const u32x4 w = *(const LAS u32x4*)(stg + lane * 16);
                      *(u32x4*)f.dst(u, row0 + lane, cb) = w; } }
            return;
        }
        if constexpr (has_staged<F>::value && has_prep<F>::value) {
            const int lane = fr + 16 * fq;
            EpiLd cur[2], nxt[2];
#pragma unroll
            for (int mm = 0; mm < 2; ++mm) cur[mm] = f.prep(u, wr * 64 + mm * 16 + fr, wc * 32 + 8 * fq);
#pragma unroll
            for (int k = 0; k < 8; ++k) { const int ai = k >> 2, bj = (k >> 1) & 1, mp = k & 1, row0 = ai * HALF + wr * 64 + mp * 32, cb = bj * HALF + wc * 32;
#pragma unroll
                for (int mm = 0; mm < 2; ++mm) { const f32x4 a = acc[ai][bj][2 * mp + mm][0], b = acc[ai][bj][2 * mp + mm][1];
                    float v[8] = {a[0], a[1], a[2], a[3], b[0], b[1], b[2], b[3]};
                    *(LAS u32x4*)(stg + ((mm * 16 + fr) * 4 + fq) * 16) = f.pack(u, row0 + mm * 16 + fr, cb + 8 * fq, v, cur[mm]); }
                if (k + 1 < 8) { const int k1 = k + 1, ai1 = k1 >> 2, bj1 = (k1 >> 1) & 1, mp1 = k1 & 1;
#pragma unroll
                    for (int mm = 0; mm < 2; ++mm) nxt[mm] = f.prep(u, ai1 * HALF + wr * 64 + mp1 * 32 + mm * 16 + fr, bj1 * HALF + wc * 32 + 8 * fq); }
#pragma unroll
                for (int ps = 0; ps < 2; ++ps) { const int lrow = ps * 16 + (lane >> 2), ch = lane & 3;
                    const u32x4 w = *(const LAS u32x4*)(stg + (lrow * 4 + ch) * 16);
                    *(u32x4*)f.dst(u, row0 + lrow, cb + 8 * ch) = w; }
                cur[0] = nxt[0]; cur[1] = nxt[1]; }
            return;
        }
        if constexpr (has_staged<F>::value && !has_prep<F>::value) {
            const int lane = fr + 16 * fq;
#pragma unroll
            for (int ai = 0; ai < 2; ++ai)
#pragma unroll
                for (int bj = 0; bj < 2; ++bj)
#pragma unroll
                    for (int mp = 0; mp < 2; ++mp) { const int row0 = ai * HALF + wr * 64 + mp * 32, cb = bj * HALF + wc * 32;
#pragma unroll
                        for (int mm = 0; mm < 2; ++mm) { const f32x4 a = acc[ai][bj][2 * mp + mm][0], b = acc[ai][bj][2 * mp + mm][1];
                            float v[8] = {a[0], a[1], a[2], a[3], b[0], b[1], b[2], b[3]};
                            *(LAS u32x4*)(stg + ((mm * 16 + fr) * 4 + fq) * 16) = f.pack(u, row0 + mm * 16 + fr, cb + 8 * fq, v); }
#pragma unroll
                        for (int ps = 0; ps < 2; ++ps) { const int lrow = ps * 16 + (lane >> 2), ch = lane & 3;
                            const u32x4 w = *(const LAS u32x4*)(stg + (lrow * 4 + ch) * 16);
                            if constexpr (STORE) *(u32x4*)f.dst(u, row0 + lrow, cb + 8 * ch) = w; else asm volatile("" :: "v"(w)); } }
            return;
        }
#pragma unroll
        for (int ai = 0; ai < 2; ++ai)
#pragma unroll
            for (int m = 0; m < 4; ++m) { const int row = ai * HALF + wr * 64 + m * 16 + fr;
#pragma unroll
                for (int bj = 0; bj < 2; ++bj) { const f32x4 a = acc[ai][bj][m][0], b = acc[ai][bj][m][1];
                    float v[8] = {a[0], a[1], a[2], a[3], b[0], b[1], b[2], b[3]};
                    f(u, row, bj * HALF + wc * 32 + 8 * fq, v); } }
    }
    __device__ __forceinline__ void operator()(f32x4 (&acc)[2][2][4][2], const Unit& u, int wr, int wc, int fr, int fq, LAS unsigned char* stg) const { run<true>(acc, u, wr, wc, fr, fq, stg); }
};

typedef int v8i32 __attribute__((ext_vector_type(8)));
template <class Epi, class Sched, bool FP8 = false, bool AG = false>
__device__ __forceinline__ void gemm_phase(LAS unsigned char* lds, const Gemm g, const Sched& S, const Epi& E) {
    int tid_ = threadIdx.x; asm volatile("" : "+v"(tid_));
    const int tid = tid_, wid = __builtin_amdgcn_readfirstlane(tid >> 6), lane = tid & 63, wr = wid >> 2, wc = wid & 3, fr = lane & 15, fq = lane >> 4;
    int K_ = g.K; asm volatile("" : "+s"(K_));
    const int K = K_, nt = FP8 ? K / (2 * BK) : K / BK;
    unsigned voffA[2], voffB[2];
#pragma unroll
    for (int i = 0; i < 2; ++i) { int R, C; stage_rc(tid * 16 + i * 8192, R, C); const int Rb = Epi::PERM ? ((R & ~31) + perm32(R & 31)) : R;
        voffA[i] = FP8 ? (unsigned)(R * g.lda + C * 2) : (unsigned)(R * g.lda + C) * 2u; voffB[i] = FP8 ? (unsigned)(Rb * g.ldb + C * 2) : (unsigned)(Rb * g.ldb + C) * 2u; }
    const size_t kstep = (size_t)(BK * 2);
    const size_t hstepA = (size_t)HALF * g.lda * (FP8 ? 1 : 2), hstepB = (size_t)HALF * g.ldb * (FP8 ? 1 : 2);
    const unsigned ldsw = (unsigned)wid * 1024u;
    const int aoff = FP8 ? lds_byte(wr * 64 + fr, fq * 16) : lds_byte(wr * 64 + fr, fq * 8), boff = FP8 ? lds_byte(wc * 32 + fr, fq * 16) : lds_byte(wc * 32 + fr, fq * 8);
    constexpr int KOFF = FP8 ? 16 : 1024;
#define PG8_SA(b, h) (((b) * 2 + (h)) * HTB)
#define PG8_SB(b, h) ((4 + (b) * 2 + (h)) * HTB)
#define PG8_STAGE(bufoff, gbase, voff) do { _Pragma("unroll") for (int _i = 0; _i < 2; ++_i) \
        __builtin_amdgcn_global_load_lds((const unsigned*)((const char*)(gbase) + (voff)[_i]), (LAS unsigned*)(lds + (bufoff) + ldsw + _i * 8192), 16, 0, 0); } while (0)
    unsigned tokA[2], tokN[2];
#define PG8_AGLOAD(un, tk) do { int t_ = tid; asm volatile("" : "+v"(t_)); _Pragma("unroll") for (int _i = 0; _i < 2; ++_i) { int R_, C_; stage_rc(t_ * 16 + _i * 8192, R_, C_); const int* rt_ = g.rowtok + (un).aux * 256 + R_; \
        tk[_i] = (unsigned)rt_[0] | ((unsigned)rt_[HALF] << 16); } } while (0)
#define PG8_STAGE_A(b, h, kptr, nx) do { if constexpr (AG) { int t_ = tid; asm volatile("" : "+v"(t_)); int R_, C_; stage_rc(t_ * 16, R_, C_);       \
          _Pragma("unroll") for (int _i = 0; _i < 2; ++_i) { const unsigned tk_ = (nx) ? tokN[_i] : tokA[_i]; \
            const unsigned vo_ = ((h) ? (tk_ >> 16) : (tk_ & 0xffffu)) * (unsigned)g.lda + (unsigned)(C_ * 2); \
            __builtin_amdgcn_global_load_lds((const unsigned*)((const char*)(kptr) + vo_), (LAS unsigned*)(lds + PG8_SA(b, h) + ldsw + _i * 8192), 16, 0, 0); } } \
        else PG8_STAGE(PG8_SA(b, h), (kptr) + (h) * hstepA, voffA); } while (0)
#define PG8_LDA(dst, b, h) do { _Pragma("unroll") for (int m = 0; m < 4; ++m) _Pragma("unroll") for (int k = 0; k < 2; ++k) dst[m][k] = *(const LAS bf16x8*)(lds + PG8_SA(b, h) + aoff + m * 2048 + k * KOFF); } while (0)
#define PG8_LDB(dst, b, h) do { _Pragma("unroll") for (int n = 0; n < 2; ++n) _Pragma("unroll") for (int k = 0; k < 2; ++k) dst[n][k] = *(const LAS bf16x8*)(lds + PG8_SB(b, h) + boff + n * 2048 + k * KOFF); } while (0)
#define PG8_CAT(x) __builtin_bit_cast(v8i32, __builtin_shufflevector((x)[0], (x)[1], 0, 1, 2, 3, 4, 5, 6, 7, 8, 9, 10, 11, 12, 13, 14, 15))
#define PG8_MMA(ai, bj, At, Bt) do { __builtin_amdgcn_s_setprio(1); _Pragma("unroll") for (int m = 0; m < 4; ++m) _Pragma("unroll") for (int n = 0; n < 2; ++n) { \
        if constexpr (FP8) { const v8i32 b8_ = PG8_CAT(Bt[n]), a8_ = PG8_CAT(At[m]); asm volatile("v_mfma_f32_16x16x128_f8f6f4 %0, %1, %2, %0" : "+v"(acc[ai][bj][m][n]) : "v"(b8_), "v"(a8_)); } \
        else { _Pragma("unroll") for (int k = 0; k < 2; ++k) acc[ai][bj][m][n] = __builtin_amdgcn_mfma_f32_16x16x32_bf16(Bt[n][k], At[m][k], acc[ai][bj][m][n], 0, 0, 0); } } \
        PG8_XMFMA(At, Bt); __builtin_amdgcn_s_setprio(0); } while (0)
#if defined(GEMM_XMFMA)
#define PG8_XMFMA(At, Bt) do { if constexpr (!FP8) { _Pragma("unroll") for (int x_ = 0; x_ < 4; ++x_) xacc_ = __builtin_amdgcn_mfma_f32_16x16x32_bf16(Bt[0][0], At[x_][0], xacc_, 0, 0, 0); asm volatile("" : "+v"(xacc_)); } } while (0)
#else
#define PG8_XMFMA(At, Bt) do { } while (0)
#endif
#define PG8_WAIT_V(n) asm volatile("s_waitcnt vmcnt(" #n ")" ::: "memory")
#define PG8_WAIT_L(n) asm volatile("s_waitcnt lgkmcnt(" #n ")" ::: "memory")
#define PG8_BAR __builtin_amdgcn_s_barrier()
#define PG8_SCHED __builtin_amdgcn_sched_barrier(0)
    Unit cur, nxt; int ui = 0;
    if (!S.next(0, cur)) return;
    f32x4 acc[2][2][4][2];
#pragma unroll
    for (int a = 0; a < 2; ++a)
#pragma unroll
        for (int b = 0; b < 2; ++b)
#pragma unroll
            for (int m = 0; m < 4; ++m)
#pragma unroll
                for (int n = 0; n < 2; ++n) acc[a][b][m][n] = (f32x4){0.f, 0.f, 0.f, 0.f};
    bf16x8 At[4][2], B0[2][2], B1[2][2];
#if defined(GEMM_XMFMA)
    f32x4 xacc_ = (f32x4){0.f, 0.f, 0.f, 0.f};
#endif
    const char* cA = (const char*)g.A + (AG ? 0 : cur.aoff); const char* cB = (const char*)g.Bt + cur.boff;
    if constexpr (AG) { static_assert(!AG || FP8, "gathered A: fp8 rows"); PG8_AGLOAD(cur, tokA); }
    PG8_STAGE(PG8_SB(0, 0), cB, voffB); PG8_STAGE(PG8_SB(0, 1), cB + hstepB, voffB); PG8_STAGE_A(0, 0, cA, false); PG8_STAGE_A(0, 1, cA, false);
    if (wr == 1) PG8_BAR;
    PG8_WAIT_V(2); PG8_BAR;
    PG8_STAGE(PG8_SB(1, 0), cB + kstep, voffB); PG8_STAGE_A(1, 0, cA + kstep, false); PG8_STAGE(PG8_SB(1, 1), cB + hstepB + kstep, voffB);
    PG8_WAIT_V(6); PG8_BAR;
    for (;;) {
        const bool has_next = S.next(ui + 1, nxt);
        const char* nA = (has_next && !AG) ? (const char*)g.A + nxt.aoff : cA; const char* nB = has_next ? (const char*)g.Bt + nxt.boff : cB;
        if constexpr (AG) { if (has_next) PG8_AGLOAD(nxt, tokN); else { tokN[0] = tokA[0]; tokN[1] = tokA[1]; } }
        for (int t = 0; t < nt; t += 2) {
            const bool last = (t == nt - 2);
            const char* a1 = cA + (size_t)(t + 1) * kstep;
            const char* a2 = last ? nA : cA + (size_t)(t + 2) * kstep; const char* b2 = last ? nB : cB + (size_t)(t + 2) * kstep;
            const char* a3 = a2 + kstep; const char* b3 = b2 + kstep;
            PG8_LDB(B0, 0, 0); PG8_LDB(B1, 0, 1); PG8_SCHED; PG8_LDA(At, 0, 0); PG8_STAGE_A(1, 1, a1, false);
            PG8_WAIT_V(8); PG8_WAIT_L(0); PG8_BAR; PG8_MMA(0, 0, At, B0); PG8_MMA(0, 1, At, B1); PG8_BAR; PG8_SCHED;
            PG8_LDA(At, 0, 1); PG8_STAGE(PG8_SB(0, 0), b2, voffB); PG8_STAGE(PG8_SB(0, 1), b2 + hstepB, voffB); PG8_STAGE_A(0, 0, a2, last);
            PG8_WAIT_V(8); PG8_WAIT_L(0); PG8_BAR; PG8_MMA(1, 0, At, B0); PG8_MMA(1, 1, At, B1); PG8_BAR; PG8_SCHED;
            PG8_LDB(B0, 1, 0); PG8_LDB(B1, 1, 1); PG8_SCHED; PG8_LDA(At, 1, 0); PG8_STAGE_A(0, 1, a2, last);
            PG8_WAIT_V(8); PG8_WAIT_L(0); PG8_BAR; PG8_MMA(0, 0, At, B0); PG8_MMA(0, 1, At, B1); PG8_BAR; PG8_SCHED;
            PG8_LDA(At, 1, 1); PG8_STAGE(PG8_SB(1, 0), b3, voffB); PG8_STAGE(PG8_SB(1, 1), b3 + hstepB, voffB); PG8_STAGE_A(1, 0, a3, last);
            PG8_WAIT_V(8); PG8_WAIT_L(0); PG8_BAR; PG8_MMA(1, 0, At, B0); PG8_MMA(1, 1, At, B1); PG8_BAR; PG8_SCHED;
        }
        if (wr == 0) PG8_BAR;
        if constexpr (FP8) asm volatile("s_nop 15\n\ts_nop 15" ::: "memory");
        E(acc, cur, wr, wc, fr, fq, lds + EPI_STG_OFF + wid * EPI_STG_WAVE);
#if defined(EPI_NOSTORE_REP)
        if constexpr (has_probe<decltype(E.f)>::value) E.template run<false>(acc, cur, wr, wc, fr, fq, lds + EPI_STG_OFF + wid * EPI_STG_WAVE);
#endif
#if defined(EPI_STORE_REP)
        if constexpr (has_probe<decltype(E.f)>::value) E.template run<true>(acc, cur, wr, wc, fr, fq, lds + EPI_STG_OFF + wid * EPI_STG_WAVE);
#endif
        if (!has_next) break;
#pragma unroll
        for (int a = 0; a < 2; ++a)
#pragma unroll
            for (int b = 0; b < 2; ++b)
#pragma unroll
                for (int m = 0; m < 4; ++m)
#pragma unroll
                    for (int n = 0; n < 2; ++n) acc[a][b][m][n] = (f32x4){0.f, 0.f, 0.f, 0.f};
        cur = nxt; cA = nA; cB = nB; ++ui;
        if constexpr (AG) { tokA[0] = tokN[0]; tokA[1] = tokN[1]; }
        if (wr == 1) PG8_BAR;
    }
    PG8_WAIT_V(0);
    PG8_BAR;
#undef PG8_SA
#undef PG8_SB
#undef PG8_STAGE
#undef PG8_STAGE_A
#undef PG8_AGLOAD
#undef PG8_LDA
#undef PG8_LDB
#undef PG8_MMA
#undef PG8_XMFMA
#undef PG8_CAT
#undef PG8_WAIT_V
#undef PG8_WAIT_L
#undef PG8_BAR
#undef PG8_SCHED
}
}

__device__ __forceinline__ bool z_is_rope_col(int n, bool& isq) {
    if (n >= ZC_D) { const int r = n - ZC_D; isq = r < 256; return r < 384; }
    if (n >= ZC_C) { const int r = (n - ZC_C) % 768; isq = r < 256; return r < 512; }
    isq = false; return false;
}
__device__ __forceinline__ int z_map(int n) { bool q; if (!z_is_rope_col(n, q)) return n; const int d = (n - ZC_C) & 63; return n - d + ((d < 32) ? 2 * d : 2 * (d - 32) + 1); }

using pg8::Unit;
using pg8::EpiLd;
struct FStore {
    static constexpr int PROBE = 1;
    static constexpr int STAGED = 1;
    bf16_t* dstp; int ld;
    __device__ __forceinline__ u32x4 pack(const Unit&, int, int, float (&v)[8]) const { return pack8(v); }
    __device__ __forceinline__ bf16_t* dst(const Unit& u, int row, int c8) const { return dstp + (size_t)(u.pm * 256 + row) * ld + u.pn * 256 + c8; }
    __device__ __forceinline__ void operator()(const Unit& u, int row, int c8, float (&v)[8]) const {
        __builtin_nontemporal_store(pack8(v), (u32x4*)(dstp + (size_t)(u.pm * 256 + row) * ld + u.pn * 256 + c8)); }
};
struct FIn {
    static constexpr int STAGED = 1;
    bf16_t* z; const float* c32; const float* s32; float wsc;
    static constexpr int PREP = 1;
    __device__ __forceinline__ EpiLd prep(const Unit& u, int row, int c8) const {
        const int col = u.pn * 256 + c8, r = u.pm * 256 + row; bool isq; EpiLd w; w.a = (f32x4){0.f, 0.f, 0.f, 0.f}; w.b = w.a;
        if (z_is_rope_col(col, isq)) { const int t = r & (SEQ - 1), i0 = ((col - ZC_C) & 63) >> 1; w.a = *(const f32x4*)(c32 + t * 32 + i0); w.b = *(const f32x4*)(s32 + t * 32 + i0); }
        return w; }
    __device__ __forceinline__ u32x4 pack(const Unit& u, int row, int c8, float (&v)[8], const EpiLd& w) const {
        const int col = u.pn * 256 + c8; bool isq;
#pragma unroll
        for (int i = 0; i < 8; ++i) v[i] *= wsc;
        if (z_is_rope_col(col, isq)) { const f32x4 c = w.a, s = w.b; const float sc = isq ? 0.125f * LOG2E : 1.0f;
#pragma unroll
            for (int p = 0; p < 4; ++p) { const float x1 = v[2 * p], x2 = v[2 * p + 1]; v[2 * p] = (x1 * c[p] - x2 * s[p]) * sc; v[2 * p + 1] = (x2 * c[p] + x1 * s[p]) * sc; } }
        return pack8(v); }
    __device__ __forceinline__ bf16_t* dst(const Unit& u, int row, int c8) const { return z + (size_t)(u.pm * 256 + row) * ZP + u.pn * 256 + c8; }
    __device__ __forceinline__ void operator()(const Unit& u, int row, int c8, float (&v)[8]) const { *(u32x4*)dst(u, row, c8) = pack(u, row, c8, v, prep(u, row, c8)); }
};
struct FStoreS {
    bf16_t* dst; int ld; float sc;
    __device__ __forceinline__ void operator()(const Unit& u, int row, int c8, float (&v)[8]) const {
#pragma unroll
        for (int i = 0; i < 8; ++i) v[i] *= sc;
        *(u32x4*)(dst + (size_t)(u.pm * 256 + row) * ld + u.pn * 256 + c8) = pack8(v); }
};
struct FSilu8 {
    static constexpr int STAGED4 = 1;
    unsigned char* hid; int ld; float sc;
    __device__ __forceinline__ unsigned pack4b(const Unit&, int, int, float (&v)[8]) const {
        float h[4];
#pragma unroll
        for (int i = 0; i < 4; ++i) { const float g = v[2 * i] * sc; h[i] = g * sigmoidf_(g) * (v[2 * i + 1] * sc); }
        return cvt4_fp8(h[0], h[1], h[2], h[3]); }
    __device__ __forceinline__ unsigned char* dst(const Unit& u, int row, int c8) const { return hid + (size_t)(u.pm * 256 + row) * ld + ((u.pn * 256 + c8) >> 1); }
    __device__ __forceinline__ void operator()(const Unit& u, int row, int c8, float (&v)[8]) const { *(unsigned*)dst(u, row, c8) = pack4b(u, row, c8, v); }
};
__device__ __forceinline__ int gate_map(int nn) { const int n = nn >> 10, ch = nn & 1023; return ((ch >> 6) << 8) + ((n >> 1) << 7) + (((ch >> 4) & 3) << 5) + ((((n & 1) << 1) + ((ch >> 3) & 1)) << 3) + (ch & 7); }
__device__ __forceinline__ size_t pfrag_off(int pm, int pn, int wave, int ai, int m, int half, int lane) { return ((size_t)((((((pm * 16 + pn) * 8 + wave) * 2 + ai) * 4 + m) * 2 + half) * 64 + lane)) * 8; }
struct FStoreP {
    bf16_t* P;
    __device__ __forceinline__ void operator()(const Unit& u, int row, int c8, float (&v)[8]) const {
        const int n = u.pn >> 2, c = (u.pn & 3) * 256 + c8, ai = row >> 7, wr = (row >> 6) & 1, m = (row >> 4) & 3, fr = row & 15;
        *(u32x4*)(P + pfrag_off(u.pm, c >> 6, wr * 4 + ((c >> 4) & 3), ai, m, n >> 1, fr + 16 * ((n & 1) * 2 + ((c >> 3) & 1)))) = pack8(v); }
};
struct FGate {
    static constexpr int GATE2 = 1;
    const bf16_t* P; bf16_t* mg; float sc;
    __device__ __forceinline__ void operator()(const Unit&, int, int, float (&)[8]) const {}
    __device__ __forceinline__ void loadp(const Unit& u, int ai, int m, int wr, int wc, int fr, int fq, u32x4& w0, u32x4& w1) const {
        const bf16_t* pf = P + pfrag_off(u.pm, u.pn, wr * 4 + wc, ai, m, 0, fr + 16 * fq); w0 = *(const u32x4*)pf; w1 = *(const u32x4*)(pf + 512); }
    __device__ __forceinline__ void pair(const Unit& u, int ai, int m, int wr, int wc, int fr, int fq, float (&v0)[8], float (&v1)[8], const u32x4 w0, const u32x4 w1) const {
        const size_t r = (size_t)(u.pm * 256 + ai * 128 + wr * 64 + m * 16 + fr); const int ch = u.pn * 64 + wc * 16 + (fq & 1) * 8;
        float p0[8], p1[8]; unpack8(w0, p0); unpack8(w1, p1);
        const float nsc = -sc * LOG2E;
#pragma unroll
        for (int i = 0; i < 8; ++i) v0[i] = __builtin_amdgcn_rcpf(1.0f + __builtin_amdgcn_exp2f(v0[i] * nsc)) * p0[i] + __builtin_amdgcn_rcpf(1.0f + __builtin_amdgcn_exp2f(v1[i] * nsc)) * p1[i];
        float t[4];
#pragma unroll
        for (int i = 0; i < 4; ++i) { auto b = __builtin_amdgcn_permlane32_swap(__float_as_uint(v0[i]), __float_as_uint(v0[i + 4]), false, false); t[i] = __uint_as_float(b[0]) + __uint_as_float(b[1]); }
        u32x2 o; o.x = cvt_pk_bf16(t[0], t[1]); o.y = cvt_pk_bf16(t[2], t[3]);
        *(u32x2*)(mg + r * DM + ch + (fq >> 1) * 4) = o; }
};
struct FSilu {
    static constexpr int STAGED8 = 1;
    bf16_t* hid; int ld;
    __device__ __forceinline__ u32x2 pack8b(const Unit&, int, int, float (&v)[8]) const {
        float h[4];
#pragma unroll
        for (int i = 0; i < 4; ++i) h[i] = v[2 * i] * sigmoidf_(v[2 * i]) * v[2 * i + 1];
        u32x2 w; w.x = cvt_pk_bf16(h[0], h[1]); w.y = cvt_pk_bf16(h[2], h[3]); return w; }
    __device__ __forceinline__ bf16_t* dst(const Unit& u, int row, int c8) const { return hid + (size_t)(u.pm * 256 + row) * ld + ((u.pn * 256 + c8) >> 1); }
    __device__ __forceinline__ void operator()(const Unit& u, int row, int c8, float (&v)[8]) const { *(u32x2*)dst(u, row, c8) = pack8b(u, row, c8, v); }
};
struct FRowScale {
    static constexpr int STAGED = 1;
    bf16_t* y; const float* rowg; float sc;
    static constexpr int PREP = 1;
    __device__ __forceinline__ EpiLd prep(const Unit& u, int row, int) const { EpiLd w; w.a = (f32x4){rowg[(size_t)(u.aux * 256 + row)], 0.f, 0.f, 0.f}; w.b = w.a; return w; }
    __device__ __forceinline__ u32x4 pack(const Unit&, int, int, float (&v)[8], const EpiLd& w) const { const float g = w.a[0] * sc;
#pragma unroll
        for (int i = 0; i < 8; ++i) v[i] *= g;
        return pack8(v); }
    __device__ __forceinline__ bf16_t* dst(const Unit& u, int row, int c8) const { return y + (size_t)(u.aux * 256 + row) * DM + u.pn * 256 + c8; }
    __device__ __forceinline__ void operator()(const Unit& u, int row, int c8, float (&v)[8]) const {
        const size_t r = (size_t)(u.aux * 256 + row); const float g = rowg[r] * sc;
#pragma unroll
        for (int i = 0; i < 8; ++i) v[i] *= g;
        *(u32x4*)(y + r * DM + u.pn * 256 + c8) = pack8(v); }
};
struct FPle {
    bf16_t* pp; float sc;
    __device__ __forceinline__ void operator()(const Unit& u, int row, int c8, float (&v)[8]) const {
        bf16_t* p = pp + (size_t)(u.pm * 256 + row) * DM + u.pn * 256 + c8;
        float q[8]; unpack8(*(const u32x4*)p, q);
#pragma unroll
        for (int i = 0; i < 8; ++i) q[i] *= sigmoidf_(v[i] * sc);
        *(u32x4*)p = pack8(q); }
};
#define EPI_OFF() ((size_t)(u.pm * 256 + row) * DM + u.pn * 256 + c8)
#define EPI_ACC_MEMBERS \
    __device__ __forceinline__ float* slotp(int k) const { return (float*)(ws + WS_XSLOT + (size_t)k * XSLOT_B); } \
    __device__ __forceinline__ unsigned* cntp(int k) const { return (unsigned*)ws + CW_PANEL + (ci + k) * 4096; } \
    __device__ __forceinline__ void operator()(const Unit&, int, int, float (&)[8]) const {}
__device__ __forceinline__ EpiLd epi_ld16(const bf16_t* p) { EpiLd w; w.a = __builtin_bit_cast(f32x4, *(const u32x4*)p); w.b = w.a; return w; }
__device__ __forceinline__ EpiLd epi_none() { EpiLd w; w.a = (f32x4){0.f, 0.f, 0.f, 0.f}; w.b = w.a; return w; }
__device__ __forceinline__ void epi_gain(const float* g, int col, f32x4& ga, f32x4& gb) { ga = *(const f32x4*)(g + col); gb = *(const f32x4*)(g + col + 4); }
struct FPleOut {
    static constexpr int NORMX = 1;
    unsigned char* ws; const float* g; float* out; int ci; float sc;
    EPI_ACC_MEMBERS
    __device__ __forceinline__ EpiLd tload(const Unit& u, int row, int c8) const { return epi_ld16((const bf16_t*)(ws + WS_PP) + EPI_OFF()); }
    __device__ __forceinline__ void tval(const Unit&, int, int, float (&v)[8], const EpiLd& w) const { float q[8]; unpack8(__builtin_bit_cast(u32x4, w.a), q);
#pragma unroll
        for (int i = 0; i < 8; ++i) v[i] = q[i] * sigmoidf_(v[i] * sc); }
    __device__ __forceinline__ void gains(const Unit& u, int c8, int, f32x4& ga, f32x4& gb) const { epi_gain(g, u.pn * 256 + c8, ga, gb); }
    __device__ __forceinline__ EpiLd fload(const Unit& u, int row, int c8) const { return epi_ld16((const bf16_t*)(ws + WS_XB) + EPI_OFF()); }
    __device__ __forceinline__ void finish(const Unit& u, int row, int c8, float (&v)[8], float rs, const EpiLd& w, f32x4 ga, f32x4 gb) const {
        float x[8]; unpack8(__builtin_bit_cast(u32x4, w.a), x); f32x4 o0, o1;
#pragma unroll
        for (int i = 0; i < 4; ++i) { o0[i] = x[i] + v[i] * rs * ga[i]; o1[i] = x[4 + i] + v[4 + i] * rs * gb[i]; }
        float* o = out + EPI_OFF(); *(f32x4*)o = o0; *(f32x4*)(o + 4) = o1; }
};
template <bool XF32>
struct FMixRes {
    static constexpr int NORMX = 2;
    unsigned char* ws; const float* xf; bf16_t* xs; const float* g1; const float* g2; int ci;
    EPI_ACC_MEMBERS
    __device__ __forceinline__ EpiLd tload(const Unit&, int, int) const { return epi_none(); }
    __device__ __forceinline__ void tval(const Unit&, int, int, float (&)[8], const EpiLd&) const {}
    __device__ __forceinline__ void gains(const Unit& u, int c8, int stage, f32x4& ga, f32x4& gb) const { epi_gain(stage == 1 ? g1 : g2, u.pn * 256 + c8, ga, gb); }
    __device__ __forceinline__ EpiLd mload(const Unit& u, int row, int c8) const {
        if constexpr (XF32) { EpiLd w; const float* p = xf + EPI_OFF(); w.a = *(const f32x4*)p; w.b = *(const f32x4*)(p + 4); return w; } else return epi_ld16(xs + EPI_OFF()); }
    __device__ __forceinline__ void mid(const Unit& u, int row, int c8, float (&v)[8], float rs, const EpiLd& w, f32x4 ga, f32x4 gb) const {
        float x[8];
        if constexpr (XF32) { x[0] = w.a[0]; x[1] = w.a[1]; x[2] = w.a[2]; x[3] = w.a[3]; x[4] = w.b[0]; x[5] = w.b[1]; x[6] = w.b[2]; x[7] = w.b[3]; } else unpack8(__builtin_bit_cast(u32x4, w.a), x);
#pragma unroll
        for (int i = 0; i < 4; ++i) { v[i] = x[i] + v[i] * rs * ga[i]; v[4 + i] = x[4 + i] + v[4 + i] * rs * gb[i]; }
        *(u32x4*)(xs + EPI_OFF()) = pack8(v); }
    __device__ __forceinline__ EpiLd fload(const Unit&, int, int) const { return epi_none(); }
    __device__ __forceinline__ void finish(const Unit& u, int row, int c8, float (&v)[8], float rs, const EpiLd&, f32x4 ga, f32x4 gb) const {
#pragma unroll
        for (int i = 0; i < 4; ++i) { v[i] *= rs * ga[i]; v[4 + i] *= rs * gb[i]; }
        *(u32x4*)((bf16_t*)(ws + WS_H2) + EPI_OFF()) = pack8(v); }
};
struct FFfnRes {
    static constexpr int NORMX = 1;
    unsigned char* ws; const bf16_t* xs; const float* g; int ci; float sc;
    EPI_ACC_MEMBERS
    __device__ __forceinline__ EpiLd tload(const Unit&, int, int) const { return epi_none(); }
    __device__ __forceinline__ void tval(const Unit&, int, int, float (&v)[8], const EpiLd&) const {
#pragma unroll
        for (int i = 0; i < 8; ++i) v[i] *= sc; }
    __device__ __forceinline__ void gains(const Unit& u, int c8, int, f32x4& ga, f32x4& gb) const { epi_gain(g, u.pn * 256 + c8, ga, gb); }
    __device__ __forceinline__ EpiLd fload(const Unit& u, int row, int c8) const { return epi_ld16(xs + EPI_OFF()); }
    __device__ __forceinline__ void finish(const Unit& u, int row, int c8, float (&v)[8], float rs, const EpiLd& w, f32x4 ga, f32x4 gb) const {
        float x[8]; unpack8(__builtin_bit_cast(u32x4, w.a), x);
#pragma unroll
        for (int i = 0; i < 4; ++i) { v[i] = x[i] + v[i] * rs * ga[i]; v[4 + i] = x[4 + i] + v[4 + i] * rs * gb[i]; }
        const size_t off = EPI_OFF();
        *(u32x4*)((bf16_t*)(ws + WS_XB) + off) = pack8(v);
        if constexpr (FP8_PLE) { u32x2 o; o.x = cvt4_fp8(v[0], v[1], v[2], v[3]); o.y = cvt4_fp8(v[4], v[5], v[6], v[7]); *(u32x2*)(ws + WS_XB8_DENSE + off) = o; } }
};
template <bool HBF, bool H8>
struct FPleRes {
    static constexpr int NORMX = 2;
    unsigned char* ws; bf16_t* xs; const float* g1; const float* g2; int ci; float sc;
    EPI_ACC_MEMBERS
    __device__ __forceinline__ EpiLd tload(const Unit& u, int row, int c8) const { return epi_ld16((const bf16_t*)(ws + WS_PP) + EPI_OFF()); }
    __device__ __forceinline__ void tval(const Unit&, int, int, float (&v)[8], const EpiLd& w) const { float q[8]; unpack8(__builtin_bit_cast(u32x4, w.a), q);
#pragma unroll
        for (int i = 0; i < 8; ++i) v[i] = q[i] * sigmoidf_(v[i] * sc); }
    __device__ __forceinline__ void gains(const Unit& u, int c8, int stage, f32x4& ga, f32x4& gb) const { epi_gain(stage == 1 ? g1 : g2, u.pn * 256 + c8, ga, gb); }
    __device__ __forceinline__ EpiLd mload(const Unit& u, int row, int c8) const { return epi_ld16((const bf16_t*)(ws + WS_XB) + EPI_OFF()); }
    __device__ __forceinline__ void mid(const Unit& u, int row, int c8, float (&v)[8], float rs, const EpiLd& w, f32x4 ga, f32x4 gb) const {
        float x[8]; unpack8(__builtin_bit_cast(u32x4, w.a), x);
#pragma unroll
        for (int i = 0; i < 4; ++i) { v[i] = x[i] + v[i] * rs * ga[i]; v[4 + i] = x[4 + i] + v[4 + i] * rs * gb[i]; }
        *(u32x4*)(xs + EPI_OFF()) = pack8(v); }
    __device__ __forceinline__ EpiLd fload(const Unit&, int, int) const { return epi_none(); }
    __device__ __forceinline__ void finish(const Unit& u, int row, int c8, float (&v)[8], float rs, const EpiLd&, f32x4 ga, f32x4 gb) const {
#pragma unroll
        for (int i = 0; i < 4; ++i) { v[i] *= rs * ga[i]; v[4 + i] *= rs * gb[i]; }
        const size_t off = EPI_OFF();
        if constexpr (HBF) *(u32x4*)((bf16_t*)(ws + WS_H) + off) = pack8(v);
        if constexpr (H8) { u32x2 o; o.x = cvt4_fp8(v[0], v[1], v[2], v[3]); o.y = cvt4_fp8(v[4], v[5], v[6], v[7]); *(u32x2*)(ws + WS_H8 + off) = o; } }
};
#undef EPI_OFF
#undef EPI_ACC_MEMBERS
struct FUq {
    bf16_t* qa; const float* c16; const float* s16; float scale;
    __device__ __forceinline__ void operator()(const Unit& u, int row, int c8, float (&v)[8]) const {
        const int n = u.pn * 256 + c8; if (n >= 384) return;
        const int r = u.pm * 256 + row, pos = r & (SEQ - 1), j = n % 96;
        if (j >= 64) { const int i0 = (j - 64) >> 1; const f32x4 c = *(const f32x4*)(c16 + pos * 16 + i0), s = *(const f32x4*)(s16 + pos * 16 + i0);
#pragma unroll
            for (int p = 0; p < 4; ++p) { const float x1 = v[2 * p], x2 = v[2 * p + 1]; v[2 * p] = x1 * c[p] - x2 * s[p]; v[2 * p + 1] = x2 * c[p] + x1 * s[p]; } }
#pragma unroll
        for (int i = 0; i < 8; ++i) v[i] *= scale;
        *(u32x4*)(qa + (size_t)r * 384 + n) = pack8(v); }
};
struct FUkv {
    bf16_t* ka; bf16_t* va;
    __device__ __forceinline__ void operator()(const Unit& u, int row, int c8, float (&v)[8]) const {
        const int n = u.pn * 256 + c8, h = n >> 7, j = n & 127; const size_t r = (size_t)(u.pm * 256 + row);
        bf16_t* d = (j < 64) ? ka + r * 384 + h * 96 + j : va + r * 256 + h * 64 + (j - 64);
        *(u32x4*)d = pack8(v); }
};

struct AttnDesc { const bf16_t* Q; const bf16_t* K; const bf16_t* V; bf16_t* O; float* lse; int qs, ks, vs, os, lss, q0, L, band; float m0, l0; };
constexpr int ATT_K = 0, ATT_KSLOT = 12288, ATT_V = 3 * ATT_KSLOT, ATT_VSLOT = 8192, ATT_WS = ATT_V + 3 * ATT_VSLOT, ATT_OST = ATT_WS + 8 * 256, ATT_BYTES = ATT_OST + 8 * 4096;
__device__ __forceinline__ int crow(int r, int hi) { return (r & 3) + 8 * (r >> 2) + 4 * hi; }
__device__ __forceinline__ void att_pv(f32x16 (&o)[2], int vb, bf16x8 pa0, bf16x8 pa1, bf16x8 pa2, bf16x8 pa3) {
#pragma unroll
    for (int d0 = 0; d0 < 2; ++d0) { s16x4 lo[4], hi[4];
#pragma unroll
        for (int ks = 0; ks < 4; ++ks) {
            asm volatile("ds_read_b64_tr_b16 %0,%1 offset:%c2" : "=&v"(lo[ks]) : "v"(vb), "i"(d0 * 4096 + ks * 1024) : "memory");
            asm volatile("ds_read_b64_tr_b16 %0,%1 offset:%c2" : "=&v"(hi[ks]) : "v"(vb), "i"(d0 * 4096 + ks * 1024 + 512) : "memory"); }
        asm volatile("s_waitcnt lgkmcnt(0)" ::: "memory"); __builtin_amdgcn_sched_barrier(0);
#define ATT_PK(k) (bf16x8){lo[k][0], lo[k][1], lo[k][2], lo[k][3], hi[k][0], hi[k][1], hi[k][2], hi[k][3]}
        o[d0] = __builtin_amdgcn_mfma_f32_32x32x16_bf16(pa0, ATT_PK(0), o[d0], 0, 0, 0);
        o[d0] = __builtin_amdgcn_mfma_f32_32x32x16_bf16(pa1, ATT_PK(1), o[d0], 0, 0, 0);
        o[d0] = __builtin_amdgcn_mfma_f32_32x32x16_bf16(pa2, ATT_PK(2), o[d0], 0, 0, 0);
        o[d0] = __builtin_amdgcn_mfma_f32_32x32x16_bf16(pa3, ATT_PK(3), o[d0], 0, 0, 0);
#undef ATT_PK
    }
}
template <int DQK>
__device__ __forceinline__ void attn_unit(LAS unsigned char* lds, const AttnDesc u) {
    constexpr int ND = DQK / 16, NCH = DQK / 8;
    int tid_ = threadIdx.x; asm volatile("" : "+v"(tid_));
    const int tid = tid_, lane = tid & 63, r32 = lane & 31, hi = lane >> 5, wid = __builtin_amdgcn_readfirstlane(tid >> 6);
    const int qw0 = u.q0 + wid * 32, band = u.band;
    int t_lo = 0, t_hi = u.L / 64 - 1;
    if (band >= 0) { const int a = u.q0 - band; t_lo = a > 0 ? (a >> 6) : 0; const int b = (u.q0 + 255 + band) >> 6; t_hi = b < t_hi ? b : t_hi; }
    static_assert(DQK == 64, "the banded body stages exactly one K piece and one V piece per wave and tile (its counted wait depends on it)");
#define ATT_DMA(t_, slot_) do { const int tt_ = (t_) < t_hi ? (t_) : t_hi;                   \
        const bf16_t* kg_ = u.K + (size_t)(tt_ * 64 + lane) * u.ks; \
        __builtin_amdgcn_global_load_lds((const unsigned*)(kg_ + wid * 8), (LAS unsigned*)(lds + ATT_K + (slot_) * ATT_KSLOT + wid * 1024), 16, 0, 0); \
        const bf16_t* vg_ = u.V + (size_t)(tt_ * 64 + 16 * (wid & 3) + (lane >> 2)) * u.vs + (wid >> 2) * 32 + (lane & 3) * 8; \
        __builtin_amdgcn_global_load_lds((const unsigned*)vg_, (LAS unsigned*)(lds + ATT_V + (slot_) * ATT_VSLOT + wid * 1024), 16, 0, 0); } while (0)
    ATT_DMA(t_lo, 0); ATT_DMA(t_lo + 1, 1);
    bf16x8 qr[ND];
    { const bf16_t* qp = u.Q + (size_t)(qw0 + r32) * u.qs + hi * 8;
#pragma unroll
      for (int d0 = 0; d0 < ND; ++d0) qr[d0] = *(const bf16x8*)(qp + d0 * 16); }
    float m = u.m0, l = (hi == 0) ? u.l0 : 0.f;
    f32x16 o[2];
#pragma unroll
    for (int r = 0; r < 16; ++r) { o[0][r] = 0.f; o[1][r] = 0.f; }
    LAS float* wsf = (LAS float*)(lds + ATT_WS) + wid * 64;
    const int vb0 = (int)(unsigned)(uintptr_t)(lds + ATT_V) + ((lane >> 4) & 1) * 32 + (lane & 3) * 8 + (4 * hi + ((lane & 15) >> 2)) * 64;
    int slot = 0, fslot = 2;
    for (int t = t_lo; t <= t_hi; ++t) {
        asm volatile("s_waitcnt vmcnt(2) lgkmcnt(0)\n\ts_barrier" ::: "memory");
        ATT_DMA(t + 2, fslot);
        const bool active = band < 0 || (t * 64 + 63 >= qw0 - band && t * 64 <= qw0 + 31 + band);
        if (active) {
            const LAS unsigned char* kp = lds + ATT_K + slot * ATT_KSLOT + hi * 1024 + r32 * 16;
            f32x16 p0, p1;
#pragma unroll
            for (int r = 0; r < 16; ++r) { p0[r] = 0.f; p1[r] = 0.f; }
#pragma unroll
            for (int d0 = 0; d0 < ND; ++d0) {
                const bf16x8 b0 = *(const LAS bf16x8*)(kp + d0 * 2048), b1 = *(const LAS bf16x8*)(kp + d0 * 2048 + 512);
                p0 = __builtin_amdgcn_mfma_f32_32x32x16_bf16(b0, qr[d0], p0, 0, 0, 0);
                p1 = __builtin_amdgcn_mfma_f32_32x32x16_bf16(b1, qr[d0], p1, 0, 0, 0); }
            if (band >= 0) { const int kb = t * 64 + 4 * hi - (qw0 + r32);
#pragma unroll
                for (int r = 0; r < 16; ++r) { const int d = kb + (r & 3) + 8 * (r >> 2);
                    if (d > band || d < -band) p0[r] = -INFINITY;
                    if (d + 32 > band || d + 32 < -band) p1[r] = -INFINITY; } }
            float mx = fmaxf(p0[0], p1[0]);
#pragma unroll
            for (int r = 1; r < 16; ++r) mx = fmaxf(mx, fmaxf(p0[r], p1[r]));
            mx = fmaxf(mx, __shfl_xor(mx, 32));
            const float mn = fmaxf(m, mx), alpha = __builtin_amdgcn_exp2f(m - mn);
            m = mn;
            float s = 0.f;
#pragma unroll
            for (int r = 0; r < 16; ++r) { p0[r] = __builtin_amdgcn_exp2f(p0[r] - mn); p1[r] = __builtin_amdgcn_exp2f(p1[r] - mn); s += p0[r] + p1[r]; }
            l = l * alpha + s;
            if (__any(alpha != 1.0f)) {
                if (hi == 0) wsf[r32] = alpha;
#pragma unroll
                for (int r = 0; r < 16; ++r) { const float a = wsf[crow(r, hi)]; o[0][r] *= a; o[1][r] *= a; } }
            u32x4 pw0, pw1, pw2, pw3;
            pw0.x = cvt_pk_bf16(p0[0], p0[1]); pw0.y = cvt_pk_bf16(p0[2], p0[3]); pw0.z = cvt_pk_bf16(p0[4], p0[5]); pw0.w = cvt_pk_bf16(p0[6], p0[7]);
            pw1.x = cvt_pk_bf16(p0[8], p0[9]); pw1.y = cvt_pk_bf16(p0[10], p0[11]); pw1.z = cvt_pk_bf16(p0[12], p0[13]); pw1.w = cvt_pk_bf16(p0[14], p0[15]);
            pw2.x = cvt_pk_bf16(p1[0], p1[1]); pw2.y = cvt_pk_bf16(p1[2], p1[3]); pw2.z = cvt_pk_bf16(p1[4], p1[5]); pw2.w = cvt_pk_bf16(p1[6], p1[7]);
            pw3.x = cvt_pk_bf16(p1[8], p1[9]); pw3.y = cvt_pk_bf16(p1[10], p1[11]); pw3.z = cvt_pk_bf16(p1[12], p1[13]); pw3.w = cvt_pk_bf16(p1[14], p1[15]);
            att_pv(o, vb0 + slot * ATT_VSLOT, __builtin_bit_cast(bf16x8, pw0), __builtin_bit_cast(bf16x8, pw1), __builtin_bit_cast(bf16x8, pw2), __builtin_bit_cast(bf16x8, pw3));
        }
        slot = (slot == 2) ? 0 : slot + 1; fslot = (fslot == 2) ? 0 : fslot + 1;
    }
    asm volatile("s_waitcnt vmcnt(0)" ::: "memory");
#undef ATT_DMA
    l += __shfl_xor(l, 32);
    if (hi == 0) wsf[32 + r32] = l;
    LAS bf16_t* stg = (LAS bf16_t*)(lds + ATT_OST) + wid * 2048;
#pragma unroll
    for (int r = 0; r < 16; ++r) { const int orow = crow(r, hi); const float rl = __builtin_amdgcn_rcpf(wsf[32 + orow]);
        stg[orow * 64 + r32] = (bf16_t)cvt_pk_bf16(o[0][r] * rl, 0.f); stg[orow * 64 + 32 + r32] = (bf16_t)cvt_pk_bf16(o[1][r] * rl, 0.f); }
    LDS_WAIT();
#pragma unroll
    for (int i = 0; i < 4; ++i) { const int row = i * 8 + (lane >> 3), ch = lane & 7; const u32x4 v = *(const LAS u32x4*)(stg + row * 64 + ch * 8);
        *(u32x4*)(u.O + (size_t)(qw0 + row) * u.os + ch * 8) = v; }
    if (u.lse != nullptr && hi == 0) u.lse[(size_t)(qw0 + r32) * u.lss] = m + __builtin_amdgcn_logf(l);
    asm volatile("s_waitcnt lgkmcnt(0)\n\ts_barrier" ::: "memory");
}

__device__ __forceinline__ float att_rowmax(const f32x16& a, const f32x16& b) {
    float x = fmaxf(fmaxf(a[0], a[1]), b[0]), y = fmaxf(fmaxf(a[2], a[3]), b[1]); x = fmaxf(fmaxf(x, b[2]), b[3]);
#pragma unroll
    for (int r = 4; r < 16; r += 4) { x = fmaxf(fmaxf(x, a[r]), a[r + 1]); y = fmaxf(fmaxf(y, a[r + 2]), a[r + 3]); x = fmaxf(fmaxf(x, b[r]), b[r + 1]); y = fmaxf(fmaxf(y, b[r + 2]), b[r + 3]); }
    const float mm = fmaxf(x, y);
    auto rr = __builtin_amdgcn_permlane32_swap(__float_as_uint(mm), __float_as_uint(mm), false, false);
    return fmaxf(__uint_as_float(rr[0]), __uint_as_float(rr[1]));
}
template <int DQK>
__device__ __forceinline__ void att_step(f32x16& c0, f32x16& c1, f32x16& n0, f32x16& n1, const bf16x8 (&qr)[DQK / 16], f32x16& negm, f32x16 (&o)[2], float& m, float& l,
                                         const u32x4 (&pwp)[4], u32x4 (&pwn)[4], LAS float* wsf, const LAS unsigned char* kpn, int vbp, int r32, int hi) {
    constexpr int ND = DQK / 16, NS = 2 * ND;
    const float mx = att_rowmax(c0, c1);
    const bool resc = __any(mx > 8.0f);
    if (__builtin_expect(resc, 0)) {
        const float dl = fmaxf(mx, 0.f); m += dl;
#pragma unroll
        for (int r = 0; r < 16; ++r) { c0[r] -= dl; c1[r] -= dl; negm[r] = -m; }
        const float f = __builtin_amdgcn_exp2f(-dl); l *= f;
        if (hi == 0) wsf[r32] = f;
    }
    float sacc = 0.f;
    bf16x8 kf[NS]; s16x4 vlo[8], vhi[8];
    kf[0] = *(const LAS bf16x8*)(kpn); kf[1] = *(const LAS bf16x8*)(kpn + 512);
    asm volatile("ds_read_b64_tr_b16 %0,%1 offset:0" : "=&v"(vlo[0]) : "v"(vbp) : "memory");
    asm volatile("ds_read_b64_tr_b16 %0,%1 offset:512" : "=&v"(vhi[0]) : "v"(vbp) : "memory");
    asm volatile("" : "+v"(c0[0]), "+v"(c0[1]), "+v"(c1[0]), "+v"(c1[1]));
    asm volatile("" : "+v"(kf[0]));
    __builtin_amdgcn_sched_barrier(0);
#pragma unroll
    for (int i = 0; i < 8; ++i) {
        const int q0 = (NS == 8) ? i : (3 * i) / 2, q1 = (NS == 8) ? i + 1 : (3 * (i + 1)) / 2;
#pragma unroll
        for (int q = q0; q < q1; ++q) { const int d0 = q >> 1;
            if ((q & 1) == 0) n0 = __builtin_amdgcn_mfma_f32_32x32x16_bf16(kf[q], qr[d0], d0 == 0 ? negm : n0, 0, 0, 0);
            else              n1 = __builtin_amdgcn_mfma_f32_32x32x16_bf16(kf[q], qr[d0], d0 == 0 ? negm : n1, 0, 0, 0);
            if (q + 2 < NS) kf[q + 2] = *(const LAS bf16x8*)(kpn + ((q + 2) >> 1) * 2048 + ((q + 2) & 1) * 512); }
        { const int ra = 2 * i, rb = 2 * i + 1;
            c0[ra] = __builtin_amdgcn_exp2f(c0[ra]); c0[rb] = __builtin_amdgcn_exp2f(c0[rb]); c1[ra] = __builtin_amdgcn_exp2f(c1[ra]); c1[rb] = __builtin_amdgcn_exp2f(c1[rb]);
            sacc += (c0[ra] + c0[rb]) + (c1[ra] + c1[rb]);
            const unsigned wa = cvt_pk_bf16(c0[ra], c0[rb]), wb = cvt_pk_bf16(c1[ra], c1[rb]);
            if (i < 4) { pwn[0][i] = wa; pwn[2][i] = wb; } else { pwn[1][i - 4] = wa; pwn[3][i - 4] = wb; } }
        { const int newer = ((q0 + 2 < NS) ? 1 : 0) + ((q1 - q0 > 1 && q0 + 3 < NS) ? 1 : 0);
          if (newer == 2) asm volatile("s_waitcnt lgkmcnt(2)" : "+v"(vlo[i]), "+v"(vhi[i]) :: "memory");
          else if (newer == 1) asm volatile("s_waitcnt lgkmcnt(1)" : "+v"(vlo[i]), "+v"(vhi[i]) :: "memory");
          else asm volatile("s_waitcnt lgkmcnt(0)" : "+v"(vlo[i]), "+v"(vhi[i]) :: "memory"); }
        { const bf16x8 vf = (bf16x8){vlo[i][0], vlo[i][1], vlo[i][2], vlo[i][3], vhi[i][0], vhi[i][1], vhi[i][2], vhi[i][3]};
          o[i & 1] = __builtin_amdgcn_mfma_f32_32x32x16_bf16(__builtin_bit_cast(bf16x8, pwp[i >> 1]), vf, o[i & 1], 0, 0, 0); }
        if (i + 1 < 8) { const int j = i + 1;
            asm volatile("ds_read_b64_tr_b16 %0,%1 offset:%c2" : "=&v"(vlo[j]) : "v"(vbp), "i"((j & 1) * 4096 + (j >> 1) * 1024) : "memory");
            asm volatile("ds_read_b64_tr_b16 %0,%1 offset:%c2" : "=&v"(vhi[j]) : "v"(vbp), "i"((j & 1) * 4096 + (j >> 1) * 1024 + 512) : "memory"); }
        asm volatile("" : "+v"(c0[2 * i]), "+v"(c0[2 * i + 1]), "+v"(c1[2 * i]), "+v"(c1[2 * i + 1]), "+v"(sacc));
        if (i + 1 < 8) asm volatile("" : "+v"(c0[2 * i + 2]), "+v"(c0[2 * i + 3]), "+v"(c1[2 * i + 2]), "+v"(c1[2 * i + 3]));
        if (q1 < NS) asm volatile("" : "+v"(kf[q1]));
        __builtin_amdgcn_sched_barrier(0);
    }
    l += sacc;
    if (__builtin_expect(resc, 0)) {
#pragma unroll
        for (int r = 0; r < 16; ++r) { const float a = wsf[crow(r, hi)]; o[0][r] *= a; o[1][r] *= a; }
    }
}
constexpr int ATD_K0 = 0, ATD_V0 = 3 * ATT_KSLOT, ATD_WS = ATD_V0 + 3 * ATT_VSLOT, ATD_OST = ATD_WS + 8 * 256, ATD_BYTES = ATD_OST + 8 * 4096;
template <int DQK>
__device__ __forceinline__ void attn_dense(LAS unsigned char* lds, const AttnDesc u) {
    constexpr int ND = DQK / 16, NCH = DQK / 8;
    int tid_ = threadIdx.x; asm volatile("" : "+v"(tid_));
    const int tid = tid_, lane = tid & 63, r32 = lane & 31, hi = lane >> 5, wid = __builtin_amdgcn_readfirstlane(tid >> 6);
    const int qw0 = u.q0 + wid * 32, NT = u.L / 64;
    const bool two_k = (NCH > 8) && (wid < NCH - 8);
#define ATD_K(t_, slot_) do { const bf16_t* kg_ = u.K + (size_t)((t_) * 64 + lane) * u.ks; \
        __builtin_amdgcn_global_load_lds((const unsigned*)(kg_ + wid * 8), (LAS unsigned*)(lds + ATD_K0 + (slot_) * ATT_KSLOT + wid * 1024), 16, 0, 0); \
        if (two_k) __builtin_amdgcn_global_load_lds((const unsigned*)(kg_ + (wid + 8) * 8), (LAS unsigned*)(lds + ATD_K0 + (slot_) * ATT_KSLOT + (wid + 8) * 1024), 16, 0, 0); } while (0)
#define ATD_V(t_, slot_) do { const bf16_t* vg_ = u.V + (size_t)((t_) * 64 + 16 * (wid & 3) + (lane >> 2)) * u.vs + (wid >> 2) * 32 + (lane & 3) * 8; \
        __builtin_amdgcn_global_load_lds((const unsigned*)vg_, (LAS unsigned*)(lds + ATD_V0 + (slot_) * ATT_VSLOT + wid * 1024), 16, 0, 0); } while (0)
#define ATD_WAITBAR() do { if (two_k) asm volatile("s_waitcnt vmcnt(3) lgkmcnt(0)\n\ts_barrier" ::: "memory"); else asm volatile("s_waitcnt vmcnt(2) lgkmcnt(0)\n\ts_barrier" ::: "memory"); } while (0)
#define ATD_ROT(x) x = (x == 2) ? 0 : x + 1
    ATD_K(0, 0); ATD_V(0, 2);
    bf16x8 qr[ND];
    { const bf16_t* qp = u.Q + (size_t)(qw0 + r32) * u.qs + hi * 8;
#pragma unroll
      for (int d0 = 0; d0 < ND; ++d0) qr[d0] = *(const bf16x8*)(qp + d0 * 16); }
    float m = 0.f, l = 0.f;
    f32x16 o[2], negm, pA0, pA1, pB0, pB1; u32x4 pwA[4], pwB[4];
#pragma unroll
    for (int r = 0; r < 16; ++r) { o[0][r] = 0.f; o[1][r] = 0.f; negm[r] = 0.f; pA0[r] = 0.f; pA1[r] = 0.f; }
#pragma unroll
    for (int k = 0; k < 4; ++k) pwB[k] = (u32x4){0u, 0u, 0u, 0u};
    LAS float* wsf = (LAS float*)(lds + ATD_WS) + wid * 64;
    const int vb0 = (int)(unsigned)(uintptr_t)(lds + ATD_V0) + ((lane >> 4) & 1) * 32 + (lane & 3) * 8 + (4 * hi + ((lane & 15) >> 2)) * 64;
    const LAS unsigned char* kp0 = lds + ATD_K0 + hi * 1024 + r32 * 16;
    asm volatile("s_waitcnt vmcnt(0) lgkmcnt(0)\n\ts_barrier" ::: "memory");
    ATD_K(1, 1); ATD_V(0, 0); ATD_K(2, 2);
#pragma unroll
    for (int d0 = 0; d0 < ND; ++d0) {
        const bf16x8 b0 = *(const LAS bf16x8*)(kp0 + d0 * 2048), b1 = *(const LAS bf16x8*)(kp0 + d0 * 2048 + 512);
        pA0 = __builtin_amdgcn_mfma_f32_32x32x16_bf16(b0, qr[d0], pA0, 0, 0, 0);
        pA1 = __builtin_amdgcn_mfma_f32_32x32x16_bf16(b1, qr[d0], pA1, 0, 0, 0); }
    { const float mx = att_rowmax(pA0, pA1); m = mx;
#pragma unroll
      for (int r = 0; r < 16; ++r) { pA0[r] -= mx; pA1[r] -= mx; negm[r] = -mx; } }
    int kn = 1, kf = 0, vp = 2, vf = 1;
    for (int t = 0; t < NT; t += 2) {
        ATD_WAITBAR();
        { const int tk = t + 3 < NT ? t + 3 : NT - 1, tv = t + 1; ATD_K(tk, kf); ATD_V(tv, vf); }
        att_step<DQK>(pA0, pA1, pB0, pB1, qr, negm, o, m, l, pwB, pwA, wsf, kp0 + kn * ATT_KSLOT, vb0 + vp * ATT_VSLOT, r32, hi);
        ATD_ROT(kn); ATD_ROT(kf); ATD_ROT(vp); ATD_ROT(vf);
        ATD_WAITBAR();
        { const int tk = t + 4 < NT ? t + 4 : NT - 1, tv = t + 2 < NT ? t + 2 : NT - 1; ATD_K(tk, kf); ATD_V(tv, vf); }
        att_step<DQK>(pB0, pB1, pA0, pA1, qr, negm, o, m, l, pwA, pwB, wsf, kp0 + kn * ATT_KSLOT, vb0 + vp * ATT_VSLOT, r32, hi);
        ATD_ROT(kn); ATD_ROT(kf); ATD_ROT(vp); ATD_ROT(vf);
    }
    asm volatile("s_waitcnt vmcnt(0) lgkmcnt(0)\n\ts_barrier" ::: "memory");
    att_pv(o, vb0 + vp * ATT_VSLOT, __builtin_bit_cast(bf16x8, pwB[0]), __builtin_bit_cast(bf16x8, pwB[1]), __builtin_bit_cast(bf16x8, pwB[2]), __builtin_bit_cast(bf16x8, pwB[3]));
#undef ATD_K
#undef ATD_V
#undef ATD_WAITBAR
#undef ATD_ROT
    l += __shfl_xor(l, 32);
    if (hi == 0) wsf[32 + r32] = l;
    LAS bf16_t* stg = (LAS bf16_t*)(lds + ATD_OST) + wid * 2048;
#pragma unroll
    for (int r = 0; r < 16; ++r) { const int orow = crow(r, hi); const float rl = __builtin_amdgcn_rcpf(wsf[32 + orow]);
        stg[orow * 64 + r32] = (bf16_t)cvt_pk_bf16(o[0][r] * rl, 0.f); stg[orow * 64 + 32 + r32] = (bf16_t)cvt_pk_bf16(o[1][r] * rl, 0.f); }
    LDS_WAIT();
#pragma unroll
    for (int i = 0; i < 4; ++i) { const int row = i * 8 + (lane >> 3), ch = lane & 7; const u32x4 v = *(const LAS u32x4*)(stg + row * 64 + ch * 8);
        *(u32x4*)(u.O + (size_t)(qw0 + row) * u.os + ch * 8) = v; }
    asm volatile("s_waitcnt vmcnt(0) lgkmcnt(0)\n\ts_barrier" ::: "memory");
}

__device__ __forceinline__ void load4(const bf16_t* p, float (&v)[4]) { const u32x2 w = *(const u32x2*)p; v[0] = bf_lo(w.x); v[1] = bf_hi(w.x); v[2] = bf_lo(w.y); v[3] = bf_hi(w.y); }
__device__ __forceinline__ void store4(bf16_t* p, const float (&v)[4]) { u32x2 w; w.x = cvt_pk_bf16(v[0], v[1]); w.y = cvt_pk_bf16(v[2], v[3]); *(u32x2*)p = w; }

__device__ __forceinline__ int uq_map(int n) { const int h = n / 96, j = n - h * 96; if (j < 64) return n; const int jj = j - 64; return h * 96 + 64 + 2 * (jj & 15) + (jj >> 4); }
__device__ __forceinline__ void tr_item(const float* W, int ldw, int ncol0, int Nsub, bf16_t* WT, int ldt, int rbase, int rmul, int mode, LAS float* scr, int item, int lane0) {
    int lane = lane0; asm volatile("" : "+v"(lane));
    const int nblk = Nsub / 32, kb = item / nblk, nb = item - kb * nblk, k0 = 64 * kb, n0 = 32 * nb;
    { f32x4 v[8];
#pragma unroll
      for (int i = 0; i < 8; ++i) v[i] = *(const f32x4*)(W + (size_t)(k0 + 8 * i + (lane >> 3)) * ldw + ncol0 + n0 + 4 * (lane & 7));
#pragma unroll
      for (int i = 0; i < 8; ++i) { LAS float* d = scr + (8 * i + (lane >> 3)) * 33 + 4 * (lane & 7); d[0] = v[i][0]; d[1] = v[i][1]; d[2] = v[i][2]; d[3] = v[i][3]; } }
    LDS_WAIT();
    const int c = lane & 7;
#pragma unroll
    for (int j = 0; j < 4; ++j) { const int n = (lane >> 3) + 8 * j; const LAS float* s = scr + (8 * c) * 33 + n;
        u32x4 o; o.x = cvt_pk_bf16(s[0 * 33], s[1 * 33]); o.y = cvt_pk_bf16(s[2 * 33], s[3 * 33]); o.z = cvt_pk_bf16(s[4 * 33], s[5 * 33]); o.w = cvt_pk_bf16(s[6 * 33], s[7 * 33]);
        const int nn = n0 + n, dest = mode == 1 ? uq_map(nn) : (mode == 2 ? gate_map(nn) : (mode == 3 ? z_map(nn) : rbase + nn * rmul));
        *(u32x4*)(WT + (size_t)dest * ldt + k0 + 8 * c) = o; }
    LDS_WAIT();
}

__device__ __forceinline__ void tr_load(const float* W, int ldw, int Nsub, int item, int lane0, f32x4 (&v)[8]) {
    int lane = lane0; asm volatile("" : "+v"(lane));
    const int nblk = Nsub / 32, kb = item / nblk, nb = item - kb * nblk, k0 = 64 * kb, n0 = 32 * nb;
#pragma unroll
    for (int i = 0; i < 8; ++i) v[i] = *(const f32x4*)(W + (size_t)(k0 + 8 * i + (lane >> 3)) * ldw + n0 + 4 * (lane & 7));
}
__device__ __forceinline__ void tr_finish8(const f32x4 (&v)[8], int Nsub, unsigned char* WT, int ldt, int rbase, int rmul, float scale, LAS float* scr, int item, int lane0, int mode = 0) {
    int lane = lane0; asm volatile("" : "+v"(lane));
    const int nblk = Nsub / 32, kb = item / nblk, nb = item - kb * nblk, k0 = 64 * kb, n0 = 32 * nb;
#pragma unroll
    for (int i = 0; i < 8; ++i) { LAS float* d = scr + (8 * i + (lane >> 3)) * 33 + 4 * (lane & 7); d[0] = v[i][0]; d[1] = v[i][1]; d[2] = v[i][2]; d[3] = v[i][3]; }
    LDS_WAIT();
    const int c = lane & 7;
#pragma unroll
    for (int j = 0; j < 4; ++j) { const int n = (lane >> 3) + 8 * j; const LAS float* q = scr + (8 * c) * 33 + n;
        u32x2 o; o.x = cvt4_fp8(q[0 * 33] * scale, q[1 * 33] * scale, q[2 * 33] * scale, q[3 * 33] * scale); o.y = cvt4_fp8(q[4 * 33] * scale, q[5 * 33] * scale, q[6 * 33] * scale, q[7 * 33] * scale);
        const int nn = n0 + n, dest = mode == 1 ? gate_map(nn) : (mode == 2 ? z_map(nn) : rbase + nn * rmul);
        *(u32x2*)(WT + (size_t)dest * ldt + k0 + 8 * c) = o; }
    LDS_WAIT();
}
__device__ __forceinline__ void tr_item8(const float* W, int ldw, int Nsub, unsigned char* WT, int ldt, int rbase, int rmul, float scale, LAS float* scr, int item, int lane, int mode = 0) {
    f32x4 v[8]; tr_load(W, ldw, Nsub, item, lane, v); tr_finish8(v, Nsub, WT, ldt, rbase, rmul, scale, scr, item, lane, mode);
}

template <int ROPE, bool NORM>
__device__ __forceinline__ void head_compute(float (&v)[4], int lane, const f32x4 g, const f32x4 c, const f32x4 s, float scale) {
    const int jj = lane & 15;
    if (NORM) { float ss = (v[0] * v[0] + v[1] * v[1]) + (v[2] * v[2] + v[3] * v[3]);
        ss += __shfl_xor(ss, 1); ss += __shfl_xor(ss, 2); ss += __shfl_xor(ss, 4); ss += __shfl_xor(ss, 8);
        const float rs = rsqrtf(ss * (1.0f / 64.0f) + NORM_EPS);
#pragma unroll
        for (int e = 0; e < 4; ++e) v[e] *= rs * g[e]; }
    if (ROPE != 0) { const bool first = (ROPE == 1) ? ((jj & 4) == 0) : ((jj & 8) == 0);
#pragma unroll
        for (int e = 0; e < 4; ++e) { const float pe = __shfl_xor(v[e], ROPE == 1 ? 4 : 8); v[e] = first ? v[e] * c[e] - pe * s[e] : v[e] * c[e] + pe * s[e]; } }
#pragma unroll
    for (int e = 0; e < 4; ++e) v[e] *= scale;
}

struct PostArgs { bf16_t* z; bf16_t* ka; const float *c16, *s16, *qa_g, *kva_g, *bq_g, *bk_g; };
struct PostRegs { float v[5][4]; f32x4 cax, sax, ckr, skr; };
struct PostGains { f32x4 qa, kva, bq, bk; };
__device__ __forceinline__ PostGains post_gains(const PostArgs a, int lane) { PostGains g; g.qa = *(const f32x4*)(a.qa_g + 4 * lane); g.kva = *(const f32x4*)(a.kva_g + 4 * (lane & 31));
    g.bq = *(const f32x4*)(a.bq_g + 4 * (lane & 15)); g.bk = *(const f32x4*)(a.bk_g + 4 * (lane & 15)); return g; }
__device__ __forceinline__ void post_load(const PostArgs a, int row, int lane, PostRegs& p) {
    const bf16_t* zr = a.z + (size_t)row * ZP; const int t = row & (SEQ - 1), trow = t >> 6, tcol = t & 63, jj = lane & 15; const bool h32 = lane < 32;
#pragma unroll
    for (int i = 0; i < 5; ++i) { p.v[i][0] = 0.f; p.v[i][1] = 0.f; p.v[i][2] = 0.f; p.v[i][3] = 0.f; }
    load4(zr + 4 * lane, p.v[0]);
    if (h32) load4(zr + 256 + 4 * lane, p.v[1]);
    if (lane < 8) load4(zr + 384 + 4 * lane, p.v[2]);
    load4(zr + ZC_B + 4 * lane, p.v[3]);
    if (h32) load4(zr + ZC_B + 256 + 4 * lane, p.v[4]);
    const int pax = (jj < 8) ? trow : tcol;
    p.cax = *(const f32x4*)(a.c16 + pax * 16 + 4 * (jj & 3)); p.sax = *(const f32x4*)(a.s16 + pax * 16 + 4 * (jj & 3));
    p.ckr = *(const f32x4*)(a.c16 + t * 16 + 4 * (lane & 3)); p.skr = *(const f32x4*)(a.s16 + t * 16 + 4 * (lane & 3));
}
__device__ __forceinline__ void post_finish(const PostArgs a, const PostGains& pg, int row, int lane, PostRegs& p) {
    bf16_t* zr = a.z + (size_t)row * ZP; const float QS = 0.125f * LOG2E; const bool h32 = lane < 32;
    float (&v)[5][4] = p.v; const f32x4 cax = p.cax, sax = p.sax, ckr = p.ckr, skr = p.skr;
    { const float ss = wave_sum((v[0][0] * v[0][0] + v[0][1] * v[0][1]) + (v[0][2] * v[0][2] + v[0][3] * v[0][3])); const float rs = rsqrtf(ss * (1.0f / 256.0f) + NORM_EPS); const f32x4 g = pg.qa;
#pragma unroll
      for (int e = 0; e < 4; ++e) v[0][e] *= rs * g[e]; }
    { float ss = (v[1][0] * v[1][0] + v[1][1] * v[1][1]) + (v[1][2] * v[1][2] + v[1][3] * v[1][3]);
      ss += __shfl_xor(ss, 1); ss += __shfl_xor(ss, 2); ss += __shfl_xor(ss, 4); ss += __shfl_xor(ss, 8); ss += __shfl_xor(ss, 16);
      const float rs = rsqrtf(ss * (1.0f / 128.0f) + NORM_EPS); const f32x4 g = pg.kva;
#pragma unroll
      for (int e = 0; e < 4; ++e) v[1][e] *= rs * g[e]; }
    float okr[8];
#pragma unroll
    for (int e = 0; e < 4; ++e) { const float pe = __shfl_xor(v[2][e], 4); okr[2 * e] = v[2][e] * ckr[e] - pe * skr[e]; okr[2 * e + 1] = pe * ckr[e] + v[2][e] * skr[e]; }
    head_compute<1, true>(v[3], lane, pg.bq, cax, sax, QS);
    head_compute<1, true>(v[4], lane, pg.bk, cax, sax, 1.0f);
    store4(zr + 4 * lane, v[0]);
    if (h32) store4(zr + 256 + 4 * lane, v[1]);
    if (lane < 4) { const u32x4 w = pack8(okr); bf16_t* kr = a.ka + (size_t)row * 384 + 64 + 8 * lane;
#pragma unroll
        for (int h = 0; h < 4; ++h) *(u32x4*)(kr + h * 96) = w; }
    store4(zr + ZC_B + 4 * lane, v[3]);
    if (h32) store4(zr + ZC_B + 256 + 4 * lane, v[4]);
}

struct RowsArgs {
    const float* xin; const bf16_t* xin_bf; float* xout; const bf16_t* tsrc; const bf16_t* y; const int* tokrow; const float* gpost;
    bf16_t* hout; const float* gnext; bf16_t* xbout;
    const float* router_b; int* ti_e; int* ti_p0; int* ti_p1; float* ti_g0; float* ti_g1; int do_router; int h_fp8; unsigned char* hout8; unsigned char* xb8out;
};
__device__ __forceinline__ void rows_load(const RowsArgs a, int row, int lane, f32x4 (&x)[4], float (&tv)[4][4]) {
    if (a.xin != nullptr) { const f32x4* xr = (const f32x4*)(a.xin + (size_t)row * DM) + lane;
#pragma unroll
        for (int j = 0; j < 4; ++j) x[j] = xr[64 * j]; }
    else {
#pragma unroll
        for (int j = 0; j < 4; ++j) { float v[4]; load4(a.xin_bf + (size_t)row * DM + 256 * j + 4 * lane, v); x[j] = (f32x4){v[0], v[1], v[2], v[3]}; } }
    if (a.y == nullptr) {
#pragma unroll
        for (int j = 0; j < 4; ++j) load4(a.tsrc + (size_t)row * DM + 256 * j + 4 * lane, tv[j]);
    } else {
        const int r0 = a.tokrow[2 * row], r1 = a.tokrow[2 * row + 1];
#pragma unroll
        for (int j = 0; j < 4; ++j) { float p[4], q[4]; load4(a.y + (size_t)r0 * DM + 256 * j + 4 * lane, p); load4(a.y + (size_t)r1 * DM + 256 * j + 4 * lane, q);
#pragma unroll
            for (int e = 0; e < 4; ++e) tv[j][e] = p[e] + q[e]; }
    }
}
struct RowGains { f32x4 gp[4], gn[4]; };
__device__ __forceinline__ RowGains rows_gains(const RowsArgs a, int lane) { RowGains g;
#pragma unroll
    for (int j = 0; j < 4; ++j) { g.gp[j] = *((const f32x4*)a.gpost + 64 * j + lane); g.gn[j] = (a.gnext != nullptr) ? *((const f32x4*)a.gnext + 64 * j + lane) : (f32x4){0.f, 0.f, 0.f, 0.f}; }
    return g; }
__device__ __forceinline__ void rows_finish(const RowsArgs a, const RowGains& rg, int row, int lane, f32x4 (&x)[4], float (&tv)[4][4], LAS float* wr_lds, LAS int* cnt_lds) {
    float ss = 0.f;
#pragma unroll
    for (int j = 0; j < 4; ++j) ss += (tv[j][0] * tv[j][0] + tv[j][1] * tv[j][1]) + (tv[j][2] * tv[j][2] + tv[j][3] * tv[j][3]);
    const float rs = rsqrtf(wave_sum(ss) * (1.0f / DM) + NORM_EPS);
    float s2 = 0.f;
#pragma unroll
    for (int j = 0; j < 4; ++j) { const f32x4 g = rg.gp[j];
#pragma unroll
        for (int e = 0; e < 4; ++e) { x[j][e] += tv[j][e] * rs * g[e]; s2 += x[j][e] * x[j][e]; } }
    if (a.xout != nullptr) { f32x4* xo = (f32x4*)(a.xout + (size_t)row * DM) + lane;
#pragma unroll
        for (int j = 0; j < 4; ++j) xo[64 * j] = x[j]; }
    if (a.xbout != nullptr) {
#pragma unroll
        for (int j = 0; j < 4; ++j) { const float v[4] = {x[j][0], x[j][1], x[j][2], x[j][3]}; store4(a.xbout + (size_t)row * DM + 256 * j + 4 * lane, v);
            if (a.xb8out != nullptr) *(unsigned*)(a.xb8out + (size_t)row * DM + 256 * j + 4 * lane) = cvt4_fp8(v[0], v[1], v[2], v[3]); }
    }
    if (a.hout != nullptr) {
        const float rs2 = rsqrtf(wave_sum(s2) * (1.0f / DM) + NORM_EPS);
        float lg[NE];
#pragma unroll
        for (int e = 0; e < NE; ++e) lg[e] = 0.f;
#pragma unroll
        for (int j = 0; j < 4; ++j) { const f32x4 g = rg.gn[j]; float v[4];
#pragma unroll
            for (int e = 0; e < 4; ++e) v[e] = x[j][e] * rs2 * g[e];
            if (a.h_fp8) *(unsigned*)((unsigned char*)a.hout + (size_t)row * DM + 256 * j + 4 * lane) = cvt4_fp8(v[0], v[1], v[2], v[3]);
            else store4(a.hout + (size_t)row * DM + 256 * j + 4 * lane, v);
            if (a.hout8 != nullptr) *(unsigned*)(a.hout8 + (size_t)row * DM + 256 * j + 4 * lane) = cvt4_fp8(v[0], v[1], v[2], v[3]);
            if (a.do_router) {
#pragma unroll
                for (int e = 0; e < 4; ++e) { const LAS f32x4* w = (const LAS f32x4*)wr_lds + (j * 8 + e * 2) * 64 + lane; const f32x4 w0 = w[0], w1 = w[64];
                    lg[0] += v[e] * w0[0]; lg[1] += v[e] * w0[1]; lg[2] += v[e] * w0[2]; lg[3] += v[e] * w0[3]; lg[4] += v[e] * w1[0]; lg[5] += v[e] * w1[1]; lg[6] += v[e] * w1[2]; lg[7] += v[e] * w1[3]; } } }
        if (a.do_router) {
#pragma unroll
            for (int e = 0; e < NE; ++e) lg[e] = wave_sum(lg[e]) + a.router_b[e];
            int e0 = 0; float v0 = lg[0];
#pragma unroll
            for (int e = 1; e < NE; ++e) if (lg[e] > v0) { v0 = lg[e]; e0 = e; }
            int e1 = -1; float v1 = -INFINITY;
#pragma unroll
            for (int e = 0; e < NE; ++e) if (e != e0 && lg[e] > v1) { v1 = lg[e]; e1 = e; }
            const float ex = __expf(v1 - v0), g0 = 1.0f / (1.0f + ex), g1 = ex * g0;
            if (lane == 0) { const int p0 = __hip_atomic_fetch_add(cnt_lds + e0, 1, __ATOMIC_RELAXED, __HIP_MEMORY_SCOPE_WORKGROUP), p1 = __hip_atomic_fetch_add(cnt_lds + e1, 1, __ATOMIC_RELAXED, __HIP_MEMORY_SCOPE_WORKGROUP);
                a.ti_e[row] = e0 | (e1 << 8) | ((int)blockIdx.x << 16); a.ti_p0[row] = p0; a.ti_p1[row] = p1; a.ti_g0[row] = g0; a.ti_g1[row] = g1; }
        }
    }
}

constexpr int NWAVES = 8;
constexpr int RING_BYTES = 131072, LDSCTL_OFF = RING_BYTES, MISC_OFF = LDSCTL_OFF + 320, LDS_BYTES = 149504;
constexpr int PH_STRIDE = 25, N_PHASES = 1 + PH_STRIDE * DEPTH;
struct Params { const float* in[27]; float* out; unsigned char* ws; int ph_lo, ph_hi; };

#define IN(k) (lo <= (k) && (k) < hi)
#ifndef SEAMREP
#define SEAMREP 1
#endif
#define SEAM(k) do { if (lo <= (k) && (k) + 1 < hi) { for (int sr_ = 0; sr_ < SEAMREP; ++sr_) xcd_barrier(bar); } } while (0)
#define PH_IDS int tid = threadIdx.x; asm volatile("" : "+v"(tid)); const int lane = tid & 63, wave = __builtin_amdgcn_readfirstlane(tid >> 6), gw = bx * NWAVES + wave; (void)lane; (void)wave; (void)gw;
constexpr int I_IN1 = 16 * 117, I_IN2 = 16 * 128, I_WB = 512, I_WO = 512, I_PG = 512, I_WP = 128, I_UQ = 48, I_UKV = 32;
constexpr int IL = I_IN1 + I_IN2 + I_WB + I_WO + I_PG + I_WP + I_UQ + I_UKV, I_F = 2048, I_UQOFF = IL - I_UQ - I_UKV;
constexpr int W_EARLY = I_IN1 + I_UQ + I_UKV, W_L0REST = IL - W_EARLY, W_ALL = 2 * IL + 3 * I_F;
constexpr int I_E = 16 * 112, MOE_ITEMS = NE * 3 * I_E;
__device__ __forceinline__ void w_layer_item(const Params& P, unsigned char* ws, LAS float* scr, int l, int r, int lane) {
    if (r < I_IN1) { if (l == FP8_IN_LAYER) tr_item8(P.in[2] + (size_t)l * DM * IN_COLS, IN_COLS, ZN, ws + WS_WIN + l * WIN_L, DM, 0, 1, 32.0f, scr, r, lane, 2);
                     else tr_item(P.in[2] + (size_t)l * DM * IN_COLS, IN_COLS, 0, ZN, (bf16_t*)(ws + WS_WIN + l * WIN_L), DM, 0, 1, 3, scr, r, lane); return; } r -= I_IN1;
    if (r < I_IN2) { if (gate_fp8(l)) tr_item8(P.in[2] + (size_t)l * DM * IN_COLS + ZN, IN_COLS, 4096, ws + WS_WG + l * WG_L, DM, 0, 1, 32.0f, scr, r, lane, 1);
                     else tr_item(P.in[2] + (size_t)l * DM * IN_COLS, IN_COLS, ZN, 4096, (bf16_t*)(ws + WS_WG + l * WG_L), DM, 0, 1, 2, scr, r, lane); return; } r -= I_IN2;
    if (r < I_WB) { const int n = r >> 7; tr_item(P.in[10] + (size_t)(l * 4 + n) * 256 * DM, DM, 0, DM, (bf16_t*)(ws + WS_WB + l * WB_L), 256, n * DM, 1, 0, scr, r & 127, lane); return; } r -= I_WB;
    if (r < I_WO) { tr_item(P.in[11] + (size_t)l * DM * DM, DM, 0, DM, (bf16_t*)(ws + WS_WOUT + l * WOUT_L), DM, 0, 1, 0, scr, r, lane); return; } r -= I_WO;
    if (r < I_PG) { if (FP8_PLE) tr_item8(P.in[25] + (size_t)l * DM * DM, DM, DM, ws + WS_WPG + l * WPG_L, DM, 0, 1, 32.0f, scr, r, lane); else tr_item(P.in[25] + (size_t)l * DM * DM, DM, 0, DM, (bf16_t*)(ws + WS_WPG + l * WPG_L), DM, 0, 1, 0, scr, r, lane); return; } r -= I_PG;
    if (r < I_WP) { tr_item(P.in[24] + (size_t)l * 256 * DM, DM, 0, DM, (bf16_t*)(ws + WS_WP + l * WP_L), 256, 0, 1, 0, scr, r, lane); return; } r -= I_WP;
    if (r < I_UQ) { tr_item(P.in[5] + (size_t)l * 256 * 384, 384, 0, 384, (bf16_t*)(ws + WS_WUQ + l * WUQ_L), 256, 0, 1, 1, scr, r, lane); return; } r -= I_UQ;
    tr_item(P.in[6] + (size_t)l * 128 * 512, 512, 0, 512, (bf16_t*)(ws + WS_WUKV + l * WUKV_L), 256, 0, 1, 0, scr, r, lane);
}
__device__ __forceinline__ void w_item(const Params& P, unsigned char* ws, LAS float* scr, int it, int lane) {
    if (it < W_EARLY) { w_layer_item(P, ws, scr, 0, it < I_IN1 ? it : I_UQOFF + (it - I_IN1), lane); return; }
    it -= W_EARLY;
    if (it < W_L0REST) { w_layer_item(P, ws, scr, 0, I_IN1 + it, lane); return; }
    it -= W_L0REST;
    if (it < IL) { w_layer_item(P, ws, scr, 1, it, lane); return; }
    it -= IL;
    if (it < I_F) { tr_item(P.in[16], DFF, 0, DFF, (bf16_t*)(ws + WS_FGU), DM, 0, 2, 0, scr, it, lane); return; } it -= I_F;
    if (it < I_F) { tr_item(P.in[17], DFF, 0, DFF, (bf16_t*)(ws + WS_FGU), DM, 1, 2, 0, scr, it, lane); return; } it -= I_F;
    if (FP8_DENSE_DOWN) tr_item8(P.in[18], DM, DM, ws + WS_FD, DFF, 0, 1, 64.0f, scr, it, lane); else tr_item(P.in[18], DM, 0, DM, (bf16_t*)(ws + WS_FD), DFF, 0, 1, 0, scr, it, lane);
}
__device__ __forceinline__ unsigned char* moe_gu_ptr(const Params& P, unsigned char* ws, int e) { return e < MOE_ESPLIT ? (unsigned char*)P.out + MOEW_GU + (size_t)e * MGU_E : ws + WS_MGU_HI + (size_t)(e - MOE_ESPLIT) * MGU_E; }
__device__ __forceinline__ void moe_load(const Params& P, int lj, int it, int lane, f32x4 (&v)[8]) {
    const int e = it / (3 * I_E); int r = it - e * (3 * I_E);
    if (r < I_E) { tr_load(P.in[21] + ((size_t)lj * NE + e) * DM * MFF, MFF, MFF, r, lane, v); return; } r -= I_E;
    if (r < I_E) { tr_load(P.in[22] + ((size_t)lj * NE + e) * DM * MFF, MFF, MFF, r, lane, v); return; } r -= I_E;
    tr_load(P.in[23] + ((size_t)lj * NE + e) * MFF * DM, DM, DM, r, lane, v);
}
__device__ __forceinline__ void moe_finish(const Params& P, unsigned char* ws, LAS float* scr, int it, int lane, const f32x4 (&v)[8]) {
    const int e = it / (3 * I_E); int r = it - e * (3 * I_E);
    if (r < I_E) { tr_finish8(v, MFF, moe_gu_ptr(P, ws, e), DM, 0, 2, 32.0f, scr, r, lane); return; } r -= I_E;
    if (r < I_E) { tr_finish8(v, MFF, moe_gu_ptr(P, ws, e), DM, 1, 2, 32.0f, scr, r, lane); return; } r -= I_E;
    tr_finish8(v, DM, (unsigned char*)P.out + MOEW_MD + (size_t)e * MD_E, MFF, 0, 1, 64.0f, scr, r, lane);
}
__device__ __forceinline__ void moe_item(const Params& P, unsigned char* ws, LAS float* scr, int lj, int it, int lane) {
    const int e = it / (3 * I_E); int r = it - e * (3 * I_E);
    if (r < I_E) { tr_item8(P.in[21] + ((size_t)lj * NE + e) * DM * MFF, MFF, MFF, moe_gu_ptr(P, ws, e), DM, 0, 2, 32.0f, scr, r, lane); return; } r -= I_E;
    if (r < I_E) { tr_item8(P.in[22] + ((size_t)lj * NE + e) * DM * MFF, MFF, MFF, moe_gu_ptr(P, ws, e), DM, 1, 2, 32.0f, scr, r, lane); return; } r -= I_E;
    tr_item8(P.in[23] + ((size_t)lj * NE + e) * MFF * DM, DM, DM, (unsigned char*)P.out + MOEW_MD + (size_t)e * MD_E, MFF, 0, 1, 64.0f, scr, r, lane);
}

template <int l>
__device__ __forceinline__ void layer_body(const Params P, LAS unsigned char* lds, const XcdBarrier bar, const int lo, const int hi, const int G, const int bx, const int vcu, const int NGW, unsigned char* ws_in, unsigned* ctl) {
    unsigned char* ws = ws_in;
    const float* c16 = (const float*)(ws + WS_COS16); const float* s16 = (const float*)(ws + WS_SIN16);
    const float* c32 = (const float*)(ws + WS_COS32); const float* s32 = (const float*)(ws + WS_SIN32);
    bf16_t* const H = (bf16_t*)(ws + WS_H); bf16_t* const Z = (bf16_t*)(ws + WS_Z);
    bf16_t* const QA = (bf16_t*)(ws + WS_QA); bf16_t* const KA = (bf16_t*)(ws + WS_KA); bf16_t* const VA = (bf16_t*)(ws + WS_VA);
    bf16_t* const OCAT = (bf16_t*)(ws + WS_OCAT);
    bf16_t* const PB = (bf16_t*)(ws + WS_PB); bf16_t* const MERGED = (bf16_t*)(ws + WS_MERGED); bf16_t* const MIX = (bf16_t*)(ws + WS_MIX); bf16_t* const H2 = (bf16_t*)(ws + WS_H2);
    bf16_t* const HID = (bf16_t*)(ws + WS_HID); bf16_t* const FB = (bf16_t*)(ws + WS_FB); bf16_t* const XB = (bf16_t*)(ws + WS_XB); bf16_t* const PP = (bf16_t*)(ws + WS_PP);
    bf16_t* const PBF = (bf16_t*)(ws + WS_PBF);
    bf16_t* const MGU = (bf16_t*)(ws + WS_MGU); bf16_t* const MD = (bf16_t*)(ws + WS_MD); bf16_t* const Y = (bf16_t*)(ws + WS_Y); bf16_t* const XG = (bf16_t*)(ws + WS_XG); bf16_t* const HIDC = (bf16_t*)(ws + WS_HIDC);
    int* const rowtok = (int*)(ws + WS_ROWTOK); int* const tokrow = (int*)(ws + WS_TOKROW); float* const rowg = (float*)(ws + WS_ROWG); int* const wgbase = (int*)(ws + WS_WGBASE);
    int* const ti_e = (int*)(ws + WS_TI_E); int* const ti_p0 = (int*)(ws + WS_TI_P0); int* const ti_p1 = (int*)(ws + WS_TI_P1); float* const ti_g0 = (float*)(ws + WS_TI_G0); float* const ti_g1 = (float*)(ws + WS_TI_G1);

        const int pb = 1 + PH_STRIDE * l; constexpr bool moe = (l & 1) != 0; constexpr int lj = l >> 1;
        const bf16_t* Win_t = (const bf16_t*)(ws + WS_WIN + l * WIN_L); const bf16_t* Wg_t = (const bf16_t*)(ws + WS_WG + l * WG_L);
        const bf16_t* Wb_t = (const bf16_t*)(ws + WS_WB + l * WB_L); const bf16_t* Wout_t = (const bf16_t*)(ws + WS_WOUT + l * WOUT_L);
        const bf16_t* Wpg_t = (const bf16_t*)(ws + WS_WPG + l * WPG_L); const bf16_t* Wp_t = (const bf16_t*)(ws + WS_WP + l * WP_L);
        const bf16_t* Wuq_t = (const bf16_t*)(ws + WS_WUQ + l * WUQ_L); const bf16_t* Wukv_t = (const bf16_t*)(ws + WS_WUKV + l * WUKV_L);

        constexpr int CQ = moe ? 4 : 1, CTOT = moe ? MOE_ITEMS : (l == 0 ? W_ALL - W_EARLY : 0), TQ = moe ? 3 : 8;
        const int m1rem = ((M / 256) * (ZP / 256)) % G, tailw = m1rem ? (G - m1rem) * NWAVES : 0;
        const int CT_A = (tailw * TQ * CQ < CTOT) ? CTOT - tailw * TQ * CQ : 0;
        if (PHEN(1) && IN(pb + 0)) DUPREP(1) {
            if constexpr (l == FP8_IN_LAYER) { pg8::Gemm g{(const bf16_t*)(ws + WS_H8), Win_t, DM, DM, DM}; pg8::GridOrder S{M / 256, ZP / 256, G, bx, DM, DM, 1}; pg8::Epi8<FIn> E{{Z, c32, s32, 1.0f / 32.0f}}; pg8::gemm_phase<pg8::Epi8<FIn>, pg8::GridOrder, true>(lds, g, S, E); }
            else { pg8::Gemm g{H, Win_t, DM, DM, DM}; pg8::GridOrder S{M / 256, ZP / 256, G, bx, DM, DM, 2}; pg8::Epi8<FIn> E{{Z, c32, s32, 1.0f}}; pg8::gemm_phase(lds, g, S, E); }
            if (rep_ == 0 && m1rem != 0 && bx >= m1rem && CTOT > 0) { PH_IDS
                LAS float* tscr = (LAS float*)(lds + wave * 16384); const int tw = (bx - m1rem) * NWAVES + wave;
                for (int b = 0; b < TQ; ++b) {
                    if constexpr (moe) { f32x4 cv_[CQ][8];
#pragma unroll
                        for (int k_ = 0; k_ < CQ; ++k_) { const int it_ = CT_A + (b * CQ + k_) * tailw + tw; moe_load(P, lj, it_ < CTOT ? it_ : CTOT - 1, lane, cv_[k_]); }
#pragma unroll
                        for (int k_ = 0; k_ < CQ; ++k_) { const int it_ = CT_A + (b * CQ + k_) * tailw + tw; if (it_ < CTOT) moe_finish(P, ws, tscr, it_, lane, cv_[k_]); } }
                    else { const int it_ = CT_A + b * tailw + tw; if (it_ < CTOT) w_item(P, ws, tscr, W_EARLY + it_, lane); } } } }
        SEAM(pb + 0);
        if (PHEN(2) && IN(pb + 1)) { PH_IDS
            const PostArgs a{Z, KA, c16, s16, P.in[3] + l * 256, P.in[4] + l * 128, P.in[7] + l * 64, P.in[8] + l * 64};
            const PostGains pg = post_gains(a, lane);
            for (int row = gw; row < M; row += 2 * NGW) { const int row2 = row + NGW; const bool two = row2 < M;
                PostRegs pa, pb; post_load(a, M - 1 - row, lane, pa); if (two) post_load(a, M - 1 - row2, lane, pb);
                post_finish(a, pg, M - 1 - row, lane, pa); if (two) post_finish(a, pg, M - 1 - row2, lane, pb); }
        }
        SEAM(pb + 1);
        if (PHEN(3) && IN(pb + 2)) DUPREP(3) {
            { pg8::Gemm g{Z, Wuq_t, ZP, 256, 256}; pg8::GridOrder S{M / 256, 2, G, bx, ZP, 256, 2}; pg8::Epi8<FUq> E{{QA, c16, s16, 0.10206207261596577f * LOG2E}}; pg8::gemm_phase(lds, g, S, E); }
            { pg8::Gemm g{Z + 256, Wukv_t, ZP, 256, 256}; pg8::GridOrder S{M / 256, 2, G, bx, ZP, 256, 2}; pg8::Epi8<FUkv> E{{KA, VA}}; pg8::gemm_phase(lds, g, S, E); }
        }
        SEAM(pb + 2);
        if (PHEN(4) && IN(pb + 3)) { PH_IDS DUPREP(4) {
            LAS float* cscr = (LAS float*)(lds + wave * 16384); int cslot = 0;
#define CONV_SLOT() do { if (rep_ == 0 && (cslot == 0 || cslot * CQ * NGW < CT_A)) { \
                if constexpr (moe) { f32x4 cv_[CQ][8]; \
                    _Pragma("unroll") for (int k_ = 0; k_ < CQ; ++k_) { const int it_ = (cslot * CQ + k_) * NGW + gw; moe_load(P, lj, it_ < CT_A ? it_ : (CT_A > 0 ? CT_A - 1 : 0), lane, cv_[k_]); } \
                    _Pragma("unroll") for (int k_ = 0; k_ < CQ; ++k_) { const int it_ = (cslot * CQ + k_) * NGW + gw; if (it_ < CT_A) moe_finish(P, ws, cscr, it_, lane, cv_[k_]); } } \
                else { const int it_ = cslot * NGW + gw; if (it_ < CT_A) w_item(P, ws, cscr, W_EARLY + it_, lane); } \
                if (cslot == 0) { const int gt_ = bx * (NWAVES * 64) + tid, NGT_ = G * NWAVES * 64; const float* pl_ = P.in[1] + (size_t)l * M * 256;        \
                    for (int i_ = gt_; i_ < M * 256 / 8; i_ += NGT_) { const f32x4 a0 = *((const f32x4*)pl_ + 2 * i_), a1 = *((const f32x4*)pl_ + 2 * i_ + 1); const float v_[8] = {a0[0], a0[1], a0[2], a0[3], a1[0], a1[1], a1[2], a1[3]}; *((u32x4*)PBF + i_) = pack8(v_); } } \
                ++cslot; __syncthreads(); } } while (0)
            for (int id = vcu; id < 512; id += G) {
                const int bh = id >> 5, qb = id & 31, b = bh >> 2, h = bh & 3; const size_t r0 = (size_t)b * SEQ;
                AttnDesc d; d.Q = QA + r0 * 384 + h * 96; d.K = KA + r0 * 384 + h * 96; d.V = VA + r0 * 256 + h * 64; d.O = OCAT + r0 * DM + h * 64; d.lse = nullptr;
                d.qs = 384; d.ks = 384; d.vs = 256; d.os = DM; d.lss = 0; d.q0 = qb * 256; d.L = SEQ; d.band = -1; d.m0 = -1e30f; d.l0 = 0.f;
                attn_dense<96>(lds, d); CONV_SLOT(); }
            for (int id = vcu; id < 512; id += G) {
                const int bh = id >> 5, qb = id & 31, b = bh >> 2, h = bh & 3; const size_t r0 = (size_t)b * SEQ;
                AttnDesc d; d.lse = nullptr; d.lss = 0; d.m0 = -1e30f; d.l0 = 0.f;
                d.Q = Z + r0 * ZP + ZC_B + h * 64; d.K = Z + r0 * ZP + ZC_B + 256 + (h >> 1) * 64; d.V = Z + r0 * ZP + ZC_B + 384 + (h >> 1) * 64; d.O = OCAT + r0 * DM + 256 + h * 64;
                d.qs = ZP; d.ks = ZP; d.vs = ZP; d.os = DM; d.q0 = qb * 256; d.L = SEQ; d.band = -1;
                attn_dense<64>(lds, d); CONV_SLOT(); }
            for (int id = vcu + 512; id < 2560; id += G) {
                AttnDesc d; d.lse = nullptr; d.lss = 0; d.m0 = -1e30f; d.l0 = 0.f;
                if (id < 512) { const int bh = id >> 5, qb = id & 31, b = bh >> 2, h = bh & 3; const size_t r0 = (size_t)b * SEQ;
                    d.Q = Z + r0 * ZP + ZC_B + h * 64; d.K = Z + r0 * ZP + ZC_B + 256 + (h >> 1) * 64; d.V = Z + r0 * ZP + ZC_B + 384 + (h >> 1) * 64; d.O = OCAT + r0 * DM + 256 + h * 64;
                    d.qs = ZP; d.ks = ZP; d.vs = ZP; d.os = DM; d.q0 = qb * 256; d.L = SEQ; d.band = -1; }
                else if (id < 2048) { const int cid = id - 512, gi = cid >> 9, rem = cid & 511, b = rem >> 7, h = (rem >> 5) & 3, blk = rem & 31;
                    const int dsh = 2 * gi, dil = 1 << dsh, ls = SEQ >> dsh, bpc = ls >> 8, cls = blk / bpc, ub = blk - cls * bpc; const size_t r0 = (size_t)b * SEQ + cls;
                    const bf16_t* zb = Z + r0 * ZP + ZC_C + gi * 768 + h * 64;
                    d.Q = zb; d.K = zb + 256; d.V = zb + 512; d.O = (bf16_t*)(ws + WS_OCG + gi * OCG_G) + r0 * 256 + h * 64; d.lse = (float*)(ws + WS_LG + gi * LG_G) + r0 * 4 + h;
                    d.qs = dil * ZP; d.ks = dil * ZP; d.vs = dil * ZP; d.os = dil * 256; d.lss = dil * 4; d.q0 = ub * 256; d.L = ls; d.band = 64; }
                else { const int did = id - 2048, bh = did >> 5, qb = did & 31, b = bh >> 2, h = bh & 3; const size_t r0 = (size_t)b * SEQ;
                    d.Q = Z + r0 * ZP + ZC_D + h * 64; d.K = Z + r0 * ZP + ZC_D + 256 + (h >> 1) * 64; d.V = Z + r0 * ZP + ZC_D + 384 + (h >> 1) * 64; d.O = OCAT + r0 * DM + 768 + h * 64;
                    d.qs = ZP; d.ks = ZP; d.vs = ZP; d.os = DM; d.q0 = qb * 256; d.L = SEQ; d.band = 128; d.m0 = P.in[9][l * 4 + h] * LOG2E; d.l0 = 1.f; }
                attn_unit<64>(lds, d); CONV_SLOT(); }
            while (rep_ == 0 && (cslot == 0 || cslot * CQ * NGW < CT_A)) CONV_SLOT();
#undef CONV_SLOT
        } }
        SEAM(pb + 3);
        if (PHEN(5) && IN(pb + 4)) { PH_IDS DUPREP(5) {
            for (int row0 = gw; row0 < M; row0 += 4 * NGW) { const int hd = lane >> 4;
                float L[4][3]; u32x2 vr[4][3];
#pragma unroll
                for (int k = 0; k < 4; ++k) { const int row = row0 + k * NGW < M ? row0 + k * NGW : row0;
#pragma unroll
                    for (int g = 0; g < 3; ++g) { L[k][g] = ((const float*)(ws + WS_LG + g * LG_G))[(size_t)row * 4 + hd]; vr[k][g] = *(const u32x2*)((const bf16_t*)(ws + WS_OCG + g * OCG_G) + (size_t)row * 256 + 4 * lane); } }
#pragma unroll
                for (int k = 0; k < 4; ++k) { const int row = row0 + k * NGW; if (row < M) {
                    const float mx = fmaxf(L[k][0], fmaxf(L[k][1], L[k][2])); float w[3], sw = 0.f, o[4] = {0.f, 0.f, 0.f, 0.f};
#pragma unroll
                    for (int g = 0; g < 3; ++g) { w[g] = __builtin_amdgcn_exp2f(L[k][g] - mx); sw += w[g]; }
                    const float inv = 1.0f / sw;
#pragma unroll
                    for (int g = 0; g < 3; ++g) { const float v[4] = {bf_lo(vr[k][g].x), bf_hi(vr[k][g].x), bf_lo(vr[k][g].y), bf_hi(vr[k][g].y)};
#pragma unroll
                        for (int e = 0; e < 4; ++e) o[e] += w[g] * inv * v[e]; }
                    store4(OCAT + (size_t)row * DM + 512 + 4 * lane, o); } } }
        } }
        SEAM(pb + 4);
        if (PHEN(6) && IN(pb + 5)) DUPREP(6) { pg8::Gemm g{OCAT, Wb_t, DM, 256, 256}; pg8::BranchOrder S{G, bx}; pg8::Epi8<FStoreP> E{{PB}}; pg8::gemm_phase(lds, g, S, E); }
        SEAM(pb + 5);
        if (PHEN(7) && IN(pb + 6)) DUPREP(7) {
            if constexpr (gate_fp8(l)) { pg8::Gemm g{(const bf16_t*)(ws + WS_H8), Wg_t, DM, DM, DM}; pg8::GridOrder S{M / 256, 16, G, bx, DM, DM, 1, 1}; pg8::Epi8<FGate> E{{PB, MERGED, 1.0f / 32.0f}}; pg8::gemm_phase<pg8::Epi8<FGate>, pg8::GridOrder, true>(lds, g, S, E); }
            else { pg8::Gemm g{H, Wg_t, DM, DM, DM}; pg8::GridOrder S{M / 256, 16, G, bx, DM, DM, 2}; pg8::Epi8<FGate> E{{PB, MERGED, 1.0f}}; pg8::gemm_phase(lds, g, S, E); } }
        SEAM(pb + 6);
        const bool fuse = (G % 8 == 0);
        if (PHEN(8) && IN(pb + 7)) DUPREP(8) { pg8::Gemm g{MERGED, Wout_t, DM, DM, DM};
            if (fuse && !moe) { pg8::PanelOrder S{G, vcu, DM, DM, 2}; pg8::Epi8<FMixRes<l == 0>> E{{ws, P.in[0], (bf16_t*)P.out, P.in[13] + l * DM, P.in[14] + l * DM, l * 5 + 0}}; pg8::gemm_phase(lds, g, S, E); }
            else { pg8::GridOrder S{M / 256, 4, G, bx, DM, DM, 2}; pg8::Epi8<FStore> E{{MIX, DM}}; pg8::gemm_phase(lds, g, S, E); } }
        SEAM(pb + 7);
        if (PHEN(9) && IN(pb + 8) && !(fuse && !moe)) { PH_IDS
            LAS float* wr_lds = (LAS float*)lds; LAS int* cnt_lds = (LAS int*)(lds + RING_BYTES - 64);
            if (moe) { for (int i = tid; i < DM * NE; i += NWAVES * 64) { const int c = i >> 3, x = i & 7, j = c >> 8, ln = (c >> 2) & 63, e = c & 3;
                           wr_lds[(((j * 8 + e * 2 + (x >> 2)) * 64 + ln) << 2) + (x & 3)] = P.in[19][(size_t)lj * DM * NE + i]; }
                       if (tid < NE) cnt_lds[tid] = 0; __syncthreads(); }
            RowsArgs a; a.xb8out = nullptr; a.xin = (l == 0) ? P.in[0] : nullptr; a.xin_bf = (const bf16_t*)P.out; a.xout = nullptr; a.tsrc = MIX; a.y = nullptr; a.tokrow = nullptr; a.gpost = P.in[13] + l * DM;
            a.hout = H2; a.gnext = P.in[14] + l * DM; a.xbout = (bf16_t*)P.out; a.router_b = P.in[20] + lj * NE; a.ti_e = ti_e; a.ti_p0 = ti_p0; a.ti_p1 = ti_p1; a.ti_g0 = ti_g0; a.ti_g1 = ti_g1; a.do_router = moe ? 1 : 0; a.hout8 = nullptr; a.h_fp8 = moe ? 1 : 0;
            DUPREP(9) { if (rep_) { a.xbout = (bf16_t*)(ws + 325 * MiB); a.hout = (bf16_t*)(ws + 325 * MiB); a.do_router = 0; }
            const RowGains rg = rows_gains(a, lane);
            for (int row = gw; row < M; row += 2 * NGW) { const int row2 = row + NGW; const bool two = row2 < M;
                f32x4 xa[4], xb2[4]; float ta[4][4], tb[4][4];
                rows_load(a, row, lane, xa, ta); if (two) rows_load(a, row2, lane, xb2, tb);
                rows_finish(a, rg, row, lane, xa, ta, wr_lds, cnt_lds); if (two) rows_finish(a, rg, row2, lane, xb2, tb, wr_lds, cnt_lds); } }
            if (moe) {
                __syncthreads();
                if (tid < NE) { const int c = cnt_lds[tid]; wgbase[bx * NE + tid] = (int)atomicAdd(ctl + CW_CNT + 64 * tid, (unsigned)c); }
                __syncthreads();
            }
        }
        if (!(fuse && !moe)) SEAM(pb + 8);
        if (!moe) {
            if (PHEN(10) && IN(pb + 9)) DUPREP(10) { pg8::Gemm g{H2, (const bf16_t*)(ws + WS_FGU), DM, DM, DM}; pg8::GridOrder S{M / 256, 2 * DFF / 256, G, bx, DM, DM, 2}; if constexpr (FP8_DENSE_DOWN) { pg8::Epi8<FSilu8> E{{(unsigned char*)HID, DFF, 1.0f}}; pg8::gemm_phase(lds, g, S, E); } else { pg8::Epi8<FSilu> E{{HID, DFF}}; pg8::gemm_phase(lds, g, S, E); } }
            SEAM(pb + 9);
            if (PHEN(11) && IN(pb + 10)) DUPREP(11) {
                { pg8::Gemm g{HID, (const bf16_t*)(ws + WS_FD), DFF, DFF, DFF};
                  constexpr int esz = FP8_DENSE_DOWN ? 1 : 2; constexpr float dsc = FP8_DENSE_DOWN ? 1.0f / 64.0f : 1.0f;
                  if (fuse) { pg8::PanelOrder S{G, vcu, DFF, DFF, esz}; pg8::Epi8<FFfnRes> E{{ws, (const bf16_t*)P.out, P.in[15] + l * DM, l * 5 + 2, dsc}}; pg8::gemm_phase<pg8::Epi8<FFfnRes>, pg8::PanelOrder, FP8_DENSE_DOWN>(lds, g, S, E); }
                  else { pg8::GridOrder S{M / 256, 4, G, bx, DFF, DFF, esz}; pg8::Epi8<FStoreS> E{{FB, DM, dsc}}; pg8::gemm_phase<pg8::Epi8<FStoreS>, pg8::GridOrder, FP8_DENSE_DOWN>(lds, g, S, E); } }
                { pg8::Gemm g{PBF, Wp_t, 256, 256, 256}; pg8::GridOrder S{M / 256, 4, G, bx, 256, 256, 2}; pg8::Epi8<FStore> E{{PP, DM}}; pg8::gemm_phase(lds, g, S, E); }
            }
            SEAM(pb + 10);
        } else {
            int tend[NE]; { int acc = 0;
#pragma unroll
                for (int e = 0; e < NE; ++e) { acc += (__builtin_amdgcn_readfirstlane((int)__hip_atomic_load(ctl + CW_CNT + 64 * e, __ATOMIC_RELAXED, __HIP_MEMORY_SCOPE_AGENT)) + 255) >> 8; tend[e] = acc; } }
            const int NT = tend[NE - 1];
            for (int c = 0; c < MOE_NCH; ++c) {
                int nT = (c == 0) ? (NT < MOE_C0 ? NT : MOE_C0) : NT - MOE_C0; nT = nT > MOE_CH ? MOE_CH : (nT < 0 ? 0 : nT);
                if (c == 0) {
                    if (PHEN(13) && IN(pb + 10 + 3 * c)) { PH_IDS
                        for (int tok = bx * (NWAVES * 64) + tid; tok < M; tok += G * (NWAVES * 64)) { const int info = ti_e[tok], e0 = info & 255, e1 = (info >> 8) & 255, wg = info >> 16; int s0 = 0, s1 = 0;
#pragma unroll
                            for (int j = 0; j < NE - 1; ++j) { if (e0 > j) s0 = tend[j] * 256; if (e1 > j) s1 = tend[j] * 256; }
                            const int r0 = s0 + wgbase[wg * NE + e0] + ti_p0[tok], r1 = s1 + wgbase[wg * NE + e1] + ti_p1[tok];
                            rowg[r0] = ti_g0[tok]; rowg[r1] = ti_g1[tok]; tokrow[2 * tok] = r0; tokrow[2 * tok + 1] = r1; rowtok[r0] = tok; rowtok[r1] = tok; }
                    }
                    SEAM(pb + 10 + 3 * c);
                }
                if (PHEN(14) && IN(pb + 11 + 3 * c)) DUPREP(14) {
                    pg8::Gemm g{H2, (const bf16_t*)((unsigned char*)P.out + MOEW_GU), DM, DM, DM, rowtok}; pg8::MoeOrder S; S.nT = nT; S.tile0 = c * MOE_C0; S.nN = 2 * MFF / 256; S.G = G; S.c = bx; S.lda = DM; S.ldb = DM; S.esz = 1; S.estride = (long)MGU_E;
                    S.esplit = MOE_ESPLIT; S.edelta = (long)((ws + WS_MGU_HI) - ((unsigned char*)P.out + MOEW_GU + (size_t)MOE_ESPLIT * MGU_E));
#pragma unroll
                    for (int e = 0; e < NE; ++e) S.tend[e] = tend[e];
                    pg8::Epi8<FSilu8> E{{(unsigned char*)HIDC, MFF, 1.0f / 32.0f}}; pg8::gemm_phase<pg8::Epi8<FSilu8>, pg8::MoeOrder, true, true>(lds, g, S, E);
                }
                SEAM(pb + 11 + 3 * c);
                if (PHEN(15) && IN(pb + 12 + 3 * c)) DUPREP(15) {
                    { pg8::Gemm g{HIDC, (const bf16_t*)((unsigned char*)P.out + MOEW_MD), MFF, MFF, MFF}; pg8::MoeOrder S; S.nT = nT; S.tile0 = c * MOE_C0; S.nN = 4; S.G = G; S.c = bx; S.lda = MFF; S.ldb = MFF; S.esz = 1; S.estride = (long)MD_E; S.rev = 1;
#pragma unroll
                      for (int e = 0; e < NE; ++e) S.tend[e] = tend[e];
                      pg8::Epi8<FRowScale> E{{Y, rowg, 1.0f / 64.0f}}; pg8::gemm_phase<pg8::Epi8<FRowScale>, pg8::MoeOrder, true>(lds, g, S, E); }
                    if (c == MOE_NCH - 1) {
                        int nskip = (nT * 4) % G; if (nskip > G / 4) nskip = 0;
                        if (bx >= nskip) { pg8::Gemm g{PBF, Wp_t, 256, 256, 256}; pg8::GridOrder S{M / 256, 4, G - nskip, bx - nskip, 256, 256, 2}; pg8::Epi8<FStore> E{{PP, DM}}; pg8::gemm_phase(lds, g, S, E); } }
                }
                SEAM(pb + 12 + 3 * c);
            }
        }
        if (PHEN(16) && IN(pb + 22) && !(fuse && !moe)) { PH_IDS
            RowsArgs a; a.xb8out = FP8_PLE ? ws + (moe ? WS_XB8_MOE : WS_XB8_DENSE) : nullptr; a.xin = nullptr; a.xin_bf = (const bf16_t*)P.out; a.xout = nullptr; a.tsrc = FB; a.y = moe ? Y : nullptr; a.tokrow = tokrow; a.gpost = P.in[15] + l * DM;
            a.hout = nullptr; a.gnext = nullptr; a.xbout = XB; a.router_b = nullptr; a.ti_e = nullptr; a.ti_p0 = nullptr; a.ti_p1 = nullptr; a.ti_g0 = nullptr; a.ti_g1 = nullptr; a.do_router = 0; a.h_fp8 = 0; a.hout8 = nullptr;
            DUPREP(16) { if (rep_) { a.xbout = (bf16_t*)(ws + 157 * MiB); }
            const RowGains rg = rows_gains(a, lane);
            for (int row = gw; row < M; row += 2 * NGW) { const int row2 = row + NGW; const bool two = row2 < M;
                f32x4 xa[4], xb2[4]; float ta[4][4], tb[4][4];
                rows_load(a, row, lane, xa, ta); if (two) rows_load(a, row2, lane, xb2, tb);
                rows_finish(a, rg, row, lane, xa, ta, (LAS float*)lds, (LAS int*)lds); if (two) rows_finish(a, rg, row2, lane, xb2, tb, (LAS float*)lds, (LAS int*)lds); } }
        }
        if (!(fuse && !moe)) SEAM(pb + 22);
        if (PHEN(17) && IN(pb + 23)) {
            pg8::Gemm g{FP8_PLE ? (const bf16_t*)(ws + (moe ? WS_XB8_MOE : WS_XB8_DENSE)) : XB, Wpg_t, DM, DM, DM}; constexpr int esz = FP8_PLE ? 1 : 2; constexpr float gsc = FP8_PLE ? 1.0f / 32.0f : 1.0f;
            if (fuse && l + 1 == DEPTH) { pg8::PanelOrder S{G, vcu, DM, DM, esz}; pg8::Epi8<FPleOut> E{{ws, P.in[26] + l * DM, P.out, l * 5 + 3, gsc}}; pg8::gemm_phase<pg8::Epi8<FPleOut>, pg8::PanelOrder, FP8_PLE>(lds, g, S, E); }
            else if (fuse) { constexpr bool h8only = (l + 1 == FP8_IN_LAYER) && gate_fp8(l + 1);
                using EP = pg8::Epi8<FPleRes<!h8only, (l + 1 == FP8_IN_LAYER) || gate_fp8(l + 1)>>;
                pg8::PanelOrder S{G, vcu, DM, DM, esz}; EP E{{ws, (bf16_t*)P.out, P.in[26] + l * DM, P.in[12] + (l + 1 < DEPTH ? l + 1 : l) * DM, l * 5 + 3, gsc}}; pg8::gemm_phase<EP, pg8::PanelOrder, FP8_PLE>(lds, g, S, E); }
            else { pg8::GridOrder S{M / 256, 4, G, bx, DM, DM, esz}; pg8::Epi8<FPle> E{{PP, gsc}}; pg8::gemm_phase<pg8::Epi8<FPle>, pg8::GridOrder, FP8_PLE>(lds, g, S, E); } }
        if (!fuse) SEAM(pb + 23);
        if (PHEN(18) && IN(pb + 24) && !fuse) { PH_IDS
            const bool more = (l + 1 < DEPTH);
            RowsArgs a; a.xb8out = nullptr; a.xin = nullptr; a.xin_bf = XB; a.xout = more ? nullptr : P.out; a.tsrc = PP; a.y = nullptr; a.tokrow = nullptr; a.gpost = P.in[26] + l * DM;
            a.hout = more ? H : nullptr; a.gnext = more ? P.in[12] + (l + 1) * DM : nullptr; a.xbout = more ? (bf16_t*)P.out : nullptr; a.router_b = nullptr; a.ti_e = nullptr; a.ti_p0 = nullptr; a.ti_p1 = nullptr; a.ti_g0 = nullptr; a.ti_g1 = nullptr; a.do_router = 0; a.h_fp8 = 0; a.hout8 = (more && l + 1 == FP8_IN_LAYER) ? ws + WS_H8 : nullptr;
            DUPREP(18) { if (rep_) { if (a.xbout) a.xbout = (bf16_t*)(ws + 157 * MiB); if (a.hout) a.hout = (bf16_t*)(ws + 157 * MiB); if (a.xout) a.xout = (float*)(ws + 157 * MiB); }
            const RowGains rg = rows_gains(a, lane);
            for (int row = gw; row < M; row += 2 * NGW) { const int row2 = row + NGW; const bool two = row2 < M;
                f32x4 xa[4], xb2[4]; float ta[4][4], tb[4][4];
                rows_load(a, row, lane, xa, ta); if (two) rows_load(a, row2, lane, xb2, tb);
                rows_finish(a, rg, row, lane, xa, ta, (LAS float*)lds, (LAS int*)lds); if (two) rows_finish(a, rg, row2, lane, xb2, tb, (LAS float*)lds, (LAS int*)lds); } }
        }
        if (l + 1 < DEPTH) SEAM(pb + 24);
    }

__global__ void __launch_bounds__(NWAVES * 64, 2) fwd_kernel(Params P) {
    extern __shared__ __attribute__((aligned(16))) unsigned char lds_raw[];
    LAS unsigned char* lds = (LAS unsigned char*)lds_raw;
    volatile LAS unsigned* MISC = (volatile LAS unsigned*)(lds + MISC_OFF);
    const int tid0 = threadIdx.x;
    const int G = gridDim.x, bx = blockIdx.x;
    const int vcu = (G % 8 == 0) ? (bx % 8) * (G / 8) + bx / 8 : bx;
    const int NGW = G * NWAVES;
    unsigned char* ws = P.ws;
    unsigned* ctl = (unsigned*)(ws + WS_CTL);
    for (int u = tid0; u < (LDS_BYTES - LDSCTL_OFF) / 4; u += NWAVES * 64) ((LAS unsigned*)(lds + LDSCTL_OFF))[u] = 0u;
    __syncthreads();
    XcdBarrier bar; bar.bar = ctl + CW_BAR; bar.x = 0; bar.st = nullptr;
    if (!MK_PER_PHASE) bar = xcd_barrier_post(ctl + CW_BAR, MISC + 8);
    const int lo = P.ph_lo, hi = P.ph_hi;

    const float* c16 = (const float*)(ws + WS_COS16); const float* s16 = (const float*)(ws + WS_SIN16);
    const float* c32 = (const float*)(ws + WS_COS32); const float* s32 = (const float*)(ws + WS_SIN32);
    bf16_t* const H = (bf16_t*)(ws + WS_H); bf16_t* const Z = (bf16_t*)(ws + WS_Z);
    bf16_t* const QA = (bf16_t*)(ws + WS_QA); bf16_t* const KA = (bf16_t*)(ws + WS_KA); bf16_t* const VA = (bf16_t*)(ws + WS_VA);
    bf16_t* const OCAT = (bf16_t*)(ws + WS_OCAT);
    bf16_t* const PB = (bf16_t*)(ws + WS_PB); bf16_t* const MERGED = (bf16_t*)(ws + WS_MERGED); bf16_t* const MIX = (bf16_t*)(ws + WS_MIX); bf16_t* const H2 = (bf16_t*)(ws + WS_H2);
    bf16_t* const HID = (bf16_t*)(ws + WS_HID); bf16_t* const FB = (bf16_t*)(ws + WS_FB); bf16_t* const XB = (bf16_t*)(ws + WS_XB); bf16_t* const PP = (bf16_t*)(ws + WS_PP);
    bf16_t* const PBF = (bf16_t*)(ws + WS_PBF);
    bf16_t* const MGU = (bf16_t*)(ws + WS_MGU); bf16_t* const MD = (bf16_t*)(ws + WS_MD); bf16_t* const Y = (bf16_t*)(ws + WS_Y); bf16_t* const XG = (bf16_t*)(ws + WS_XG); bf16_t* const HIDC = (bf16_t*)(ws + WS_HIDC);
    int* const rowtok = (int*)(ws + WS_ROWTOK); int* const tokrow = (int*)(ws + WS_TOKROW); float* const rowg = (float*)(ws + WS_ROWG); int* const wgbase = (int*)(ws + WS_WGBASE);
    int* const ti_e = (int*)(ws + WS_TI_E); int* const ti_p0 = (int*)(ws + WS_TI_P0); int* const ti_p1 = (int*)(ws + WS_TI_P1); float* const ti_g0 = (float*)(ws + WS_TI_G0); float* const ti_g1 = (float*)(ws + WS_TI_G1);

    if (PHEN(0) && IN(0)) DUPREP(0) { PH_IDS
        LAS float* scr = (LAS float*)(lds + wave * 16384);
        for (int it = gw; it < W_EARLY; it += NGW) w_item(P, ws, scr, it, lane);
        const int gt = bx * (NWAVES * 64) + tid, NGT = G * NWAVES * 64; const u32x4 z4 = {0u, 0u, 0u, 0u};
        for (int i = gt; i < 2 * 96 * 128; i += NGT) { const int l = i / (96 * 128), j = i - l * (96 * 128); if (l == FP8_IN_LAYER) { if (j < 96 * 64) *((u32x4*)(ws + WS_WIN + l * WIN_L + (size_t)ZN * DM) + j) = z4; } else *((u32x4*)(ws + WS_WIN + l * WIN_L + (size_t)ZN * DM * 2) + j) = z4; }
        for (int i = gt; i < 2 * 128 * 32; i += NGT) { const int l = i / (128 * 32), j = i - l * (128 * 32); *((u32x4*)(ws + WS_WUQ + l * WUQ_L + (size_t)384 * 256 * 2) + j) = z4; }
        for (int i = gt; i < 2 * 512 * 16; i += NGT) { const int l = i / (512 * 16), j = i - l * (512 * 16), row = j >> 4, ch = j & 15; *((u32x4*)(ws + WS_WUKV + l * WUKV_L + (size_t)row * 512 + 256) + ch) = z4; }
        for (int i = gt; i < SEQ * 48; i += NGT) {
            const int pos = i / 48, q = i - pos * 48; const bool t16 = q < 16; const int fi = t16 ? q : q - 16;
            const float inv = __builtin_amdgcn_exp2f(-(float)fi * (t16 ? (1.0f / 16.0f) : (1.0f / 32.0f)) * 13.287712379549449f);
            const float ang = (float)pos * inv; const double rev = (double)ang * 0.15915494309189535; const float fr = (float)(rev - __builtin_rint(rev));
            const float cs = __builtin_amdgcn_cosf(fr), sn = __builtin_amdgcn_sinf(fr);
            if (t16) { ((float*)(ws + WS_COS16))[pos * 16 + fi] = cs; ((float*)(ws + WS_SIN16))[pos * 16 + fi] = sn; }
            else { ((float*)(ws + WS_COS32))[pos * 32 + fi] = cs; ((float*)(ws + WS_SIN32))[pos * 32 + fi] = sn; } }
        f32x4 g0_[4];
#pragma unroll
        for (int j = 0; j < 4; ++j) g0_[j] = *((const f32x4*)P.in[12] + 64 * j + lane);
        for (int row0 = gw; row0 < M; row0 += 4 * NGW) {
            f32x4 v[4][4];
#pragma unroll
            for (int k = 0; k < 4; ++k) { const int row = row0 + k * NGW < M ? row0 + k * NGW : row0; const f32x4* xr = (const f32x4*)(P.in[0] + (size_t)row * DM) + lane;
#pragma unroll
                for (int j = 0; j < 4; ++j) v[k][j] = xr[64 * j]; }
#pragma unroll
            for (int k = 0; k < 4; ++k) { const int row = row0 + k * NGW; if (row < M) { float ss = 0.f;
#pragma unroll
                for (int j = 0; j < 4; ++j) ss += (v[k][j][0] * v[k][j][0] + v[k][j][1] * v[k][j][1]) + (v[k][j][2] * v[k][j][2] + v[k][j][3] * v[k][j][3]);
                const float rs = rsqrtf(wave_sum(ss) * (1.0f / DM) + NORM_EPS);
#pragma unroll
                for (int j = 0; j < 4; ++j) { const f32x4 g = g0_[j]; const float o[4] = {v[k][j][0] * rs * g[0], v[k][j][1] * rs * g[1], v[k][j][2] * rs * g[2], v[k][j][3] * rs * g[3]};
                    store4(H + (size_t)row * DM + 256 * j + 4 * lane, o);
                    if (FP8_GATE0) *(unsigned*)(ws + WS_H8 + (size_t)row * DM + 256 * j + 4 * lane) = cvt4_fp8(o[0], o[1], o[2], o[3]); } } } }
    }
    SEAM(0);

    layer_body<0>(P, lds, bar, lo, hi, G, bx, vcu, NGW, ws, ctl);
    layer_body<1>(P, lds, bar, lo, hi, G, bx, vcu, NGW, ws, ctl);
#undef IN
#undef SEAM
}

extern "C" void kernel_launch(void* const* d_in, const int* in_sizes, int n_in, void* d_out, int out_size, void* d_ws, size_t ws_size, hipStream_t stream) {
    static int grid = 0;
    if (grid == 0) {
        if (n_in != 27 || out_size != M * DM || ws_size < WS_END) { fprintf(stderr, "kernel_launch: unexpected shapes (n_in %d, out %d, ws %zu < %zu)\n", n_in, out_size, ws_size, (size_t)WS_END); grid = -1; return; }
        int dev = 0, cus = 0, per_cu = 0;
        if (hipGetDevice(&dev) != hipSuccess || hipDeviceGetAttribute(&cus, hipDeviceAttributeMultiprocessorCount, dev) != hipSuccess) { grid = -1; return; }
        if (hipFuncSetAttribute((const void*)fwd_kernel, hipFuncAttributeMaxDynamicSharedMemorySize, LDS_BYTES) != hipSuccess) { fprintf(stderr, "kernel_launch: hipFuncSetAttribute failed\n"); grid = -1; return; }
        if (hipOccupancyMaxActiveBlocksPerMultiprocessor(&per_cu, (const void*)fwd_kernel, NWAVES * 64, LDS_BYTES) != hipSuccess || per_cu < 1) { fprintf(stderr, "kernel_launch: occupancy query says %d\n", per_cu); per_cu = 1; }
        (void)hipGetLastError();
        grid = cus;
    }
    if (grid < 0) return;
    (void)hipMemsetAsync((char*)d_ws + WS_CTL, 0, CTL_ZERO_BYTES, stream);
    Params p{};
    for (int i = 0; i < 27; ++i) p.in[i] = (const float*)d_in[i];
    p.out = (float*)d_out; p.ws = (unsigned char*)d_ws;
#if MK_PER_PHASE
    for (int k = 0; k < N_PHASES; ++k) { p.ph_lo = k; p.ph_hi = k + 1; hipLaunchKernelGGL(fwd_kernel, dim3(grid), dim3(NWAVES * 64), LDS_BYTES, stream, p); }
#else
    p.ph_lo = 0; p.ph_hi = N_PHASES;
    hipLaunchKernelGGL(fwd_kernel, dim3(grid), dim3(NWAVES * 64), LDS_BYTES, stream, p);
#endif
}
```
